# Optimizing an MI355X kernel written in HIP

```python
import math
import jax, jax.numpy as jnp
from jax import lax
import numpy as np

D_MODEL = 2048
BATCH = 4
SEQ = 2048
DEPTH = 4

N_MIXERS = 3
D_INNER = D_MODEL
DIFF_HEADS = 8
DIFF_QK_DIM = D_INNER // (2 * DIFF_HEADS)
DIFF_V_DIM = 2 * DIFF_QK_DIM
MOBA_HEADS = 16
MOBA_HEAD_DIM = D_INNER // MOBA_HEADS
MOBA_BLOCK = 256
MOBA_TOPK = 3
MOBA_Q_CHUNK = 32
FOX_HEADS = 16
FOX_HEAD_DIM = D_INNER // FOX_HEADS
FORGET_W_SCALE = 0.1
FORGET_B_MIN = 2.0
FORGET_B_MAX = 5.0
REL_BUCKETS = 32
REL_MAX_DIST = 128
REL_HEADS = 16
Q_BLOCK = 128
LN_EPS = 1e-5
RMS_EPS = 1e-5
NEG = -1e30
DN_ALPHA = (2.0 * DEPTH) ** 0.25
DN_BETA = (8.0 * DEPTH) ** -0.25

kernel_name = "hybrid_diff_moba_fox_deepnorm"


def layer_norm(x, g, b):
    xf = x.astype(jnp.float32)
    mu = jnp.mean(xf, axis=-1, keepdims=True)
    var = jnp.mean(jnp.square(xf - mu), axis=-1, keepdims=True)
    return ((xf - mu) * lax.rsqrt(var + LN_EPS) * g + b).astype(x.dtype)


def rms_norm(x, g):
    xf = x.astype(jnp.float32)
    return (xf * lax.rsqrt(jnp.mean(jnp.square(xf), axis=-1, keepdims=True) + RMS_EPS) * g).astype(x.dtype)


def t5_bucket(dist):
    n = jnp.maximum(dist, 0)
    max_exact = REL_BUCKETS // 2
    nf = jnp.maximum(n, 1).astype(jnp.float32)
    large = max_exact + (jnp.log(nf / max_exact) / math.log(REL_MAX_DIST / max_exact)
                         * (REL_BUCKETS - max_exact)).astype(jnp.int32)
    large = jnp.minimum(large, REL_BUCKETS - 1)
    return jnp.where(n < max_exact, n, large)


def rel_bias_dense(table, q_pos, k_pos):
    return jnp.moveaxis(table[t5_bucket(q_pos[:, None] - k_pos[None, :])], -1, 0).astype(jnp.float32)


def split_heads(t, n_heads):
    B, S, _ = t.shape
    return t.reshape(B, S, n_heads, -1).transpose(0, 2, 1, 3)


def merge_blocks(o):
    nb, B, H, Qb, d = o.shape
    return o.transpose(1, 0, 3, 2, 4).reshape(B, nb * Qb, H * d)


def diff_attention(u, w_in, w_out, lam_q1, lam_k1, lam_q2, lam_k2, subln_g, rel_table, layer_idx):
    B, S, _ = u.shape
    E = D_INNER
    proj = u @ w_in
    q = split_heads(proj[..., :E], 2 * DIFF_HEADS)
    k = split_heads(proj[..., E:2 * E], 2 * DIFF_HEADS)
    v = split_heads(proj[..., 2 * E:3 * E], DIFF_HEADS)
    z = proj[..., 3 * E:4 * E]
    lam_init = 0.8 - 0.6 * math.exp(-0.3 * layer_idx)
    lam = (jnp.exp(jnp.sum((lam_q1 * lam_k1).astype(jnp.float32)))
           - jnp.exp(jnp.sum((lam_q2 * lam_k2).astype(jnp.float32))) + lam_init)
    scale = DIFF_QK_DIM ** -0.5
    nb = S // Q_BLOCK
    k_pos = jnp.arange(S)
    q_blocks = q.reshape(B, 2 * DIFF_HEADS, nb, Q_BLOCK, DIFF_QK_DIM).transpose(2, 0, 1, 3, 4)

    def block(args):
        q_blk, start = args
        q_pos = start + jnp.arange(Q_BLOCK)
        logits = (jnp.einsum('bhqd,bhsd->bhqs', q_blk, k).astype(jnp.float32) * scale
                  + rel_bias_dense(rel_table, q_pos, k_pos)[None])
        logits = jnp.where(k_pos[None, :] <= q_pos[:, None], logits, NEG)
        p = jax.nn.softmax(logits, axis=-1).reshape(B, DIFF_HEADS, 2, Q_BLOCK, S)
        a = p[:, :, 0] - lam * p[:, :, 1]
        return jnp.einsum('bhqs,bhsd->bhqd', a.astype(v.dtype), v)

    o = lax.map(block, (q_blocks, jnp.arange(nb) * Q_BLOCK))
    o = rms_norm(o, subln_g) * (1.0 - lam_init)
    o = merge_blocks(o)
    return (o * jax.nn.silu(z)) @ w_out


def moba_attention(u, w_in, w_out, rel_table):
    B, S, _ = u.shape
    E, H, d = D_INNER, MOBA_HEADS, MOBA_HEAD_DIM
    proj = u @ w_in
    q = split_heads(proj[..., :E], H)
    k = split_heads(proj[..., E:2 * E], H)
    v = split_heads(proj[..., 2 * E:3 * E], H)
    z = proj[..., 3 * E:4 * E]
    n_kb = -(-S // MOBA_BLOCK)
    pad = n_kb * MOBA_BLOCK - S
    k_blocks = jnp.pad(k, ((0, 0), (0, 0), (0, pad), (0, 0))).reshape(B, H, n_kb, MOBA_BLOCK, d)
    v_blocks = jnp.pad(v, ((0, 0), (0, 0), (0, pad), (0, 0))).reshape(B, H, n_kb, MOBA_BLOCK, d)
    k_mean = jnp.mean(k_blocks.astype(jnp.float32), axis=3)
    top_k = max(1, min(MOBA_TOPK, n_kb - 1))
    scale = d ** -0.5
    bi = jnp.arange(B)[:, None, None, None]
    hi = jnp.arange(H)[None, :, None, None]
    hi5 = jnp.arange(H)[None, :, None, None, None]
    n_chunks = S // MOBA_Q_CHUNK
    q_chunks = q.reshape(B, H, n_chunks, MOBA_Q_CHUNK, d).transpose(2, 0, 1, 3, 4)
    blk_off = jnp.arange(MOBA_BLOCK)

    def chunk(args):
        q_blk, start = args
        q_pos = start + jnp.arange(MOBA_Q_CHUNK)
        own = start // MOBA_BLOCK
        gate = jnp.einsum('bhqd,bhnd->bhqn', q_blk.astype(jnp.float32), k_mean)
        gate = jnp.where(jnp.arange(n_kb) < own, gate, NEG)
        _, sel = lax.top_k(gate, top_k)
        sel_valid = sel < own
        k_sel = k_blocks[bi, hi, sel]
        v_sel = v_blocks[bi, hi, sel]
        sel_pos = sel[..., None] * MOBA_BLOCK + blk_off
        logit_sel = jnp.einsum('bhqd,bhqkcd->bhqkc', q_blk, k_sel).astype(jnp.float32) * scale
        logit_sel = logit_sel + rel_table[t5_bucket(q_pos[None, None, :, None, None] - sel_pos), hi5].astype(jnp.float32)
        logit_sel = jnp.where(sel_valid[..., None], logit_sel, NEG)
        k_own = lax.dynamic_index_in_dim(k_blocks, own, axis=2, keepdims=False)
        v_own = lax.dynamic_index_in_dim(v_blocks, own, axis=2, keepdims=False)
        own_pos = own * MOBA_BLOCK + blk_off
        logit_own = (jnp.einsum('bhqd,bhcd->bhqc', q_blk, k_own).astype(jnp.float32) * scale
                     + rel_bias_dense(rel_table, q_pos, own_pos)[None])
        logit_own = jnp.where(own_pos[None, :] <= q_pos[:, None], logit_own, NEG)
        n_sel = top_k * MOBA_BLOCK
        logits = jnp.concatenate([logit_sel.reshape(B, H, MOBA_Q_CHUNK, n_sel), logit_own], axis=-1)
        p = jax.nn.softmax(logits, axis=-1)
        p_sel = p[..., :n_sel].reshape(B, H, MOBA_Q_CHUNK, top_k, MOBA_BLOCK).astype(v.dtype)
        p_own = p[..., n_sel:].astype(v.dtype)
        return (jnp.einsum('bhqkc,bhqkcd->bhqd', p_sel, v_sel)
                + jnp.einsum('bhqc,bhcd->bhqd', p_own, v_own))

    o = merge_blocks(lax.map(chunk, (q_chunks, jnp.arange(n_chunks) * MOBA_Q_CHUNK)))
    return (o * jax.nn.silu(z)) @ w_out


def forgetting_attention(u, w_in, w_out, b_f):
    B, S, _ = u.shape
    E, H, d = D_INNER, FOX_HEADS, FOX_HEAD_DIM
    proj = u @ w_in
    q = split_heads(proj[..., :E], H)
    k = split_heads(proj[..., E:2 * E], H)
    v = split_heads(proj[..., 2 * E:3 * E], H)
    z = proj[..., 3 * E:4 * E]
    log_f = jax.nn.log_sigmoid((proj[..., 4 * E:] + b_f).astype(jnp.float32))
    cum = jnp.cumsum(log_f, axis=1).transpose(0, 2, 1)
    scale = d ** -0.5
    nb = S // Q_BLOCK
    k_pos = jnp.arange(S)
    q_blocks = q.reshape(B, H, nb, Q_BLOCK, d).transpose(2, 0, 1, 3, 4)
    c_blocks = cum.reshape(B, H, nb, Q_BLOCK).transpose(2, 0, 1, 3)

    def block(args):
        q_blk, c_blk, start = args
        q_pos = start + jnp.arange(Q_BLOCK)
        logits = (jnp.einsum('bhqd,bhsd->bhqs', q_blk, k).astype(jnp.float32) * scale
                  + c_blk[..., :, None] - cum[..., None, :])
        logits = jnp.where(k_pos[None, :] <= q_pos[:, None], logits, NEG)
        p = jax.nn.softmax(logits, axis=-1)
        return jnp.einsum('bhqs,bhsd->bhqd', p.astype(v.dtype), v)

    o = merge_blocks(lax.map(block, (q_blocks, c_blocks, jnp.arange(nb) * Q_BLOCK)))
    return (o * jax.nn.silu(z)) @ w_out


def setup_inputs(seed: int = 0) -> dict:
    key = jax.random.key(seed)
    ks = iter(jax.random.split(key, 32))
    f32 = jnp.float32
    s_in = D_MODEL ** -0.5

    def in_proj(k, extra_cols=0):
        scales = jnp.concatenate([
            jnp.full((2 * D_INNER,), s_in, f32),
            jnp.full((D_INNER,), DN_BETA * s_in, f32),
            jnp.full((D_INNER,), s_in, f32),
            jnp.full((extra_cols,), FORGET_W_SCALE * s_in, f32)])
        return jax.random.normal(k, (D_MODEL, 4 * D_INNER + extra_cols), f32) * scales

    def out_proj(k):
        return jax.random.normal(k, (D_INNER, D_MODEL), f32) * (DN_BETA * D_INNER ** -0.5)

    def gain(k, n):
        return 1.0 + 0.02 * jax.random.normal(k, (n,), f32)

    def small(k, n, s=0.02):
        return s * jax.random.normal(k, (n,), f32)

    p = {}
    p["x"] = jax.random.normal(next(ks), (BATCH, SEQ, D_MODEL), f32)
    p["rel_bias"] = 0.5 * jax.random.normal(next(ks), (REL_BUCKETS, REL_HEADS), f32)
    for i in (0,):
        pass
    p["w_in_0"] = in_proj(next(ks))
    p["lam_q1_0"] = small(next(ks), DIFF_QK_DIM, 0.1)
    p["lam_k1_0"] = small(next(ks), DIFF_QK_DIM, 0.1)
    p["lam_q2_0"] = small(next(ks), DIFF_QK_DIM, 0.1)
    p["lam_k2_0"] = small(next(ks), DIFF_QK_DIM, 0.1)
    p["subln_g_0"] = gain(next(ks), DIFF_V_DIM)
    p["w_out_0"] = out_proj(next(ks))
    p["ln_g_0"] = gain(next(ks), D_MODEL)
    p["ln_b_0"] = small(next(ks), D_MODEL)
    p["w_in_1"] = in_proj(next(ks))
    p["w_out_1"] = out_proj(next(ks))
    p["ln_g_1"] = gain(next(ks), D_MODEL)
    p["ln_b_1"] = small(next(ks), D_MODEL)
    p["w_in_2"] = in_proj(next(ks), FOX_HEADS)
    p["b_f_2"] = jax.random.uniform(next(ks), (FOX_HEADS,), f32, FORGET_B_MIN, FORGET_B_MAX)
    p["w_out_2"] = out_proj(next(ks))
    p["ln_g_2"] = gain(next(ks), D_MODEL)
    p["ln_b_2"] = small(next(ks), D_MODEL)
    p["w_in_3"] = in_proj(next(ks))
    p["lam_q1_3"] = small(next(ks), DIFF_QK_DIM, 0.1)
    p["lam_k1_3"] = small(next(ks), DIFF_QK_DIM, 0.1)
    p["lam_q2_3"] = small(next(ks), DIFF_QK_DIM, 0.1)
    p["lam_k2_3"] = small(next(ks), DIFF_QK_DIM, 0.1)
    p["subln_g_3"] = gain(next(ks), DIFF_V_DIM)
    p["w_out_3"] = out_proj(next(ks))
    p["ln_g_3"] = gain(next(ks), D_MODEL)
    p["ln_b_3"] = small(next(ks), D_MODEL)
    return p


def reference(x, rel_bias,
              w_in_0, lam_q1_0, lam_k1_0, lam_q2_0, lam_k2_0, subln_g_0, w_out_0, ln_g_0, ln_b_0,
              w_in_1, w_out_1, ln_g_1, ln_b_1,
              w_in_2, b_f_2, w_out_2, ln_g_2, ln_b_2,
              w_in_3, lam_q1_3, lam_k1_3, lam_q2_3, lam_k2_3, subln_g_3, w_out_3, ln_g_3, ln_b_3):
    layers = [
        (w_in_0, w_out_0, (lam_q1_0, lam_k1_0, lam_q2_0, lam_k2_0, subln_g_0), ln_g_0, ln_b_0),
        (w_in_1, w_out_1, (), ln_g_1, ln_b_1),
        (w_in_2, w_out_2, (b_f_2,), ln_g_2, ln_b_2),
        (w_in_3, w_out_3, (lam_q1_3, lam_k1_3, lam_q2_3, lam_k2_3, subln_g_3), ln_g_3, ln_b_3),
    ]
    h = x
    for i in range(DEPTH):
        w_in, w_out, extra, g, b = layers[i]
        kind = i % N_MIXERS
        if kind == 0:
            y = diff_attention(h, w_in, w_out, *extra, rel_bias, i)
        elif kind == 1:
            y = moba_attention(h, w_in, w_out, rel_bias)
        else:
            y = forgetting_attention(h, w_in, w_out, *extra)
        h = layer_norm(DN_ALPHA * h + y, g, b)
    return h
```

```cpp
#include <hip/hip_runtime.h>
#include <cstdint>
#include <cstdio>

typedef unsigned short bf16_t;
typedef float f32x4 __attribute__((ext_vector_type(4)));
typedef unsigned u32x4 __attribute__((ext_vector_type(4)));

constexpr int NB = 4, S = 2048, D = 2048, M = NB * S, E = 2048, NH = 16, HD = 128;
constexpr int NPROJ = 4 * E;
constexpr float SCALE = 0.08838834764831845f;
constexpr float LN_EPS = 1e-5f, RMS_EPS = 1e-5f;
constexpr float DN_ALPHA = 1.681792830507429f;
constexpr float NEGF = -1e30f;

constexpr size_t MiB = 1u << 20;
constexpr size_t WS_CTL = 0;
constexpr size_t WS_WIN = 1 * MiB;
constexpr size_t WS_WOUT = WS_WIN + 128 * MiB;
constexpr size_t WS_HB = WS_WOUT + 32 * MiB;
constexpr size_t WS_Q = WS_HB + 32 * MiB;
constexpr size_t WS_K = WS_Q + 32 * MiB;
constexpr size_t WS_V = WS_K + 32 * MiB;
constexpr size_t WS_Z = WS_V + 32 * MiB;
constexpr size_t WS_G = WS_Z + 32 * MiB;
constexpr size_t WS_SMALL = WS_G + 32 * MiB;
constexpr size_t WS_STATS = WS_SMALL;
constexpr size_t WS_KPART = WS_STATS + 64 * 1024;
constexpr size_t WS_LOGF = WS_KPART + 512 * 1024;
constexpr size_t WS_CUM = WS_LOGF + 512 * 1024;
constexpr size_t WS_WF = WS_CUM + 512 * 1024;
constexpr size_t WS_END = WS_WF + 64 * 1024;

__device__ __forceinline__ float bf2f(bf16_t v) { return __uint_as_float((unsigned)v << 16); }
__device__ __forceinline__ bf16_t f2bf(float f) { unsigned u = __float_as_uint(f); return (bf16_t)((u + 0x7fffu + ((u >> 16) & 1u)) >> 16); }
__device__ __forceinline__ float siluf(float z) { return z / (1.f + __expf(-z)); }

__device__ __forceinline__ int t5_bucket(int d) {
    if (d < 16) return d;
    if (d >= 113) return 31;
    int b = 16;
    b += (d >= 19); b += (d >= 21); b += (d >= 24); b += (d >= 27); b += (d >= 31); b += (d >= 35); b += (d >= 40); b += (d >= 46);
    b += (d >= 52); b += (d >= 59); b += (d >= 67); b += (d >= 77); b += (d >= 87); b += (d >= 99);
    return b;
}

__global__ __launch_bounds__(256) void transpose_cvt(const float* __restrict__ W, int K, int ldw, int c0, int ncols, bf16_t* __restrict__ WT) {
    __shared__ float tile[64][65];
    const int nb = (ncols + 63) / 64;
    const int kb = blockIdx.x / nb, cb = blockIdx.x % nb, k0 = kb * 64, n0 = cb * 64;
    const int tx = threadIdx.x & 63, ty = threadIdx.x >> 6;
    for (int i = ty; i < 64; i += 4) { const int n = n0 + tx; tile[i][tx] = (n < ncols) ? W[(size_t)(k0 + i) * ldw + c0 + n] : 0.f; }
    __syncthreads();
    for (int i = ty; i < 64; i += 4) { const int n = n0 + i; if (n < ncols) WT[(size_t)n * K + k0 + tx] = f2bf(tile[tx][i]); }
}
__global__ __launch_bounds__(256) void cvt_bf16(const float* __restrict__ x, bf16_t* __restrict__ o, size_t n) {
    size_t i = ((size_t)blockIdx.x * 256 + threadIdx.x) * 4;
    for (; i < n; i += (size_t)gridDim.x * 1024) { const f32x4 v = *(const f32x4*)(x + i); *(uint2*)(o + i) = make_uint2(f2bf(v.x) | ((unsigned)f2bf(v.y) << 16), f2bf(v.z) | ((unsigned)f2bf(v.w) << 16)); }
}

template <class Epi>
__global__ __launch_bounds__(256) void gemm_naive(const bf16_t* __restrict__ A, const bf16_t* __restrict__ BT, int Mm, int Nn, int K, int pad_, Epi epi) {
    __shared__ float As[64][33], Bs[64][33];
    const int nbn = Nn / 64, m0 = (blockIdx.x / nbn) * 64, n0 = (blockIdx.x % nbn) * 64;
    const int tid = threadIdx.x, lr = tid >> 2, lc = (tid & 3) * 8, ty = tid >> 4, tx = tid & 15;
    float acc[4][4];
#pragma unroll
    for (int i = 0; i < 4; ++i)
#pragma unroll
        for (int j = 0; j < 4; ++j) acc[i][j] = 0.f;
    for (int k0 = 0; k0 < K; k0 += 32) {
        const u32x4 av = *(const u32x4*)(A + (size_t)(m0 + lr) * K + k0 + lc);
        const u32x4 bv = *(const u32x4*)(BT + (size_t)(n0 + lr) * K + k0 + lc);
#pragma unroll
        for (int j = 0; j < 4; ++j) { As[lr][lc + 2 * j] = __uint_as_float(av[j] << 16); As[lr][lc + 2 * j + 1] = __uint_as_float(av[j] & 0xffff0000u);
                                      Bs[lr][lc + 2 * j] = __uint_as_float(bv[j] << 16); Bs[lr][lc + 2 * j + 1] = __uint_as_float(bv[j] & 0xffff0000u); }
        __syncthreads();
#pragma unroll 8
        for (int k = 0; k < 32; ++k) {
            float a[4], b[4];
#pragma unroll
            for (int i = 0; i < 4; ++i) { a[i] = As[ty * 4 + i][k]; b[i] = Bs[tx * 4 + i][k]; }
#pragma unroll
            for (int i = 0; i < 4; ++i)
#pragma unroll
                for (int j = 0; j < 4; ++j) acc[i][j] = fmaf(a[i], b[j], acc[i][j]);
        }
        __syncthreads();
    }
#pragma unroll
    for (int i = 0; i < 4; ++i)
#pragma unroll
        for (int j = 0; j < 4; ++j) epi(m0 + ty * 4 + i, n0 + tx * 4 + j, acc[i][j]);
}

struct EpiInProj {
    bf16_t *Q, *K, *V, *Z;
    __device__ __forceinline__ void operator()(int m, int n, float v) const {
        const int sec = n >> 11, c = n & 2047;
        if (sec == 3) { Z[(size_t)m * E + c] = f2bf(v); return; }
        bf16_t* dst = sec == 0 ? Q : (sec == 1 ? K : V);
        const int b = m / S, s = m % S, h = c >> 7, d = c & 127;
        dst[((size_t)(b * NH + h) * S + s) * HD + d] = f2bf(v);
    }
};
struct EpiOutProj {
    float* T; const float* x; const float* stats; const float* g; const float* bta; int layer; int pad;
    __device__ __forceinline__ void operator()(int m, int n, float v) const {
        const size_t idx = (size_t)m * D + n; float h;
        if (layer == 0) h = x[idx];
        else h = (T[idx] - stats[2 * m]) * stats[2 * m + 1] * g[n] + bta[n];
        T[idx] = DN_ALPHA * h + v;
    }
};

__global__ __launch_bounds__(256) void ln_rows(float* T, const float* __restrict__ g, const float* __restrict__ bta, float* stats, bf16_t* HB, int final_layer) {
    __shared__ float red[8];
    const int m = blockIdx.x, tid = threadIdx.x;
    float* row = T + (size_t)m * D;
    f32x4 v0 = *(const f32x4*)(row + tid * 4), v1 = *(const f32x4*)(row + 1024 + tid * 4);
    float s = (v0.x + v0.y) + (v0.z + v0.w) + (v1.x + v1.y) + (v1.z + v1.w);
    for (int o = 32; o; o >>= 1) s += __shfl_xor(s, o);
    if ((tid & 63) == 0) red[tid >> 6] = s;
    __syncthreads();
    const float mean = (red[0] + red[1] + red[2] + red[3]) * (1.f / D);
    __syncthreads();
    v0 = v0 - mean; v1 = v1 - mean;
    float q = (v0.x * v0.x + v0.y * v0.y) + (v0.z * v0.z + v0.w * v0.w) + (v1.x * v1.x + v1.y * v1.y) + (v1.z * v1.z + v1.w * v1.w);
    for (int o = 32; o; o >>= 1) q += __shfl_xor(q, o);
    if ((tid & 63) == 0) red[tid >> 6] = q;
    __syncthreads();
    const float rstd = rsqrtf((red[0] + red[1] + red[2] + red[3]) * (1.f / D) + LN_EPS);
    if (tid == 0) { stats[2 * m] = mean; stats[2 * m + 1] = rstd; }
    const f32x4 g0 = *(const f32x4*)(g + tid * 4), g1 = *(const f32x4*)(g + 1024 + tid * 4), b0 = *(const f32x4*)(bta + tid * 4), b1 = *(const f32x4*)(bta + 1024 + tid * 4);
    const f32x4 o0 = v0 * rstd * g0 + b0, o1 = v1 * rstd * g1 + b1;
    if (final_layer) { *(f32x4*)(row + tid * 4) = o0; *(f32x4*)(row + 1024 + tid * 4) = o1; }
    else { bf16_t* hr = HB + (size_t)m * D;
        *(uint2*)(hr + tid * 4) = make_uint2(f2bf(o0.x) | ((unsigned)f2bf(o0.y) << 16), f2bf(o0.z) | ((unsigned)f2bf(o0.w) << 16));
        *(uint2*)(hr + 1024 + tid * 4) = make_uint2(f2bf(o1.x) | ((unsigned)f2bf(o1.y) << 16), f2bf(o1.z) | ((unsigned)f2bf(o1.w) << 16)); }
}

__global__ __launch_bounds__(128) void kmean_naive(const bf16_t* __restrict__ Kb, float* kpart) {
    const int bh = blockIdx.x >> 3, n = blockIdx.x & 7, d = threadIdx.x;
    const bf16_t* p = Kb + ((size_t)bh * S + n * 256) * HD + d; float s = 0.f;
    for (int i = 0; i < 256; ++i) s += bf2f(p[(size_t)i * HD]);
    kpart[(size_t)(bh * 8 + n) * HD + d] = s; kpart[(size_t)NB * NH * 8 * HD + (size_t)(bh * 8 + n) * HD + d] = 0.f;
}
__global__ __launch_bounds__(256) void logf_naive(const bf16_t* __restrict__ HB, const bf16_t* __restrict__ WfT, const float* __restrict__ bf, float* logf) {
    const int gid = blockIdx.x * 256 + threadIdx.x, m = gid >> 4, j = gid & 15;
    const bf16_t* a = HB + (size_t)m * D; const bf16_t* w = WfT + (size_t)j * D; float s = 0.f;
    for (int k = 0; k < D; ++k) s = fmaf(bf2f(a[k]), bf2f(w[k]), s);
    const float xx = s + bf[j];
    logf[gid] = fminf(xx, 0.f) - log1pf(__expf(-fabsf(xx)));
}
__global__ void cum_naive(const float* __restrict__ logf, float* cum) {
    const int bh = blockIdx.x * blockDim.x + threadIdx.x; if (bh >= NB * NH) return;
    const int b = bh / NH, h = bh % NH; float c = 0.f;
    for (int s = 0; s < S; ++s) { c += logf[(size_t)(b * S + s) * NH + h]; cum[(size_t)bh * S + s] = c; }
}

constexpr int SC_LD = 2064;
template <int MODE>
__global__ __launch_bounds__(256) void attn_naive(const bf16_t* __restrict__ Qb, const bf16_t* __restrict__ Kb, const bf16_t* __restrict__ Vb, const bf16_t* __restrict__ Zb,
                                                  bf16_t* __restrict__ G, const float* __restrict__ rel, const float* __restrict__ kpart, const float* __restrict__ cum,
                                                  const float* lq1, const float* lk1, const float* lq2, const float* lk2, const float* __restrict__ subg, float lam_init) {
    extern __shared__ __attribute__((aligned(16))) float sm[];
    float* sc = sm;
    float* qs = sm + 16 * SC_LD;
    float* misc = qs + 16 * 128;
    const int tid = threadIdx.x, row = tid >> 4, sub = tid & 15;
    constexpr int QPB = MODE == 0 ? 8 : 16, NHB = MODE == 0 ? 8 : 16;
    const int nqt = S / QPB;
    const int qt = blockIdx.x % nqt, hh = (blockIdx.x / nqt) % NHB, b = blockIdx.x / (nqt * NHB);
    const int t0 = qt * QPB, nkeys = t0 + QPB;
    const int qi = MODE == 0 ? (row & 7) : row, comp = MODE == 0 ? (row >> 3) : 0;
    const int hq = MODE == 0 ? 2 * hh + comp : hh;
    const int t = t0 + qi;
    for (int i = tid; i < 16 * 128; i += 256) { const int r = i >> 7, d = i & 127; const int rq = MODE == 0 ? (r & 7) : r, rh = MODE == 0 ? 2 * hh + (r >> 3) : hh;
        qs[i] = bf2f(Qb[((size_t)(b * NH + rh) * S + t0 + rq) * HD + d]); }
    float lam = 0.f;
    if (MODE == 0) { if (tid < 64) { float a = lq1[tid] * lk1[tid] + lq1[tid + 64] * lk1[tid + 64], c = lq2[tid] * lk2[tid] + lq2[tid + 64] * lk2[tid + 64];
            for (int o = 32; o; o >>= 1) { a += __shfl_xor(a, o); c += __shfl_xor(c, o); }
            if (tid == 0) misc[0] = __expf(a) - __expf(c) + lam_init; } }
    __syncthreads();
    if (MODE == 0) lam = misc[0];
    unsigned selbits = 0u; const int own = t0 >> 8;
    if (MODE == 1) {
        if (tid < 16) { float gate[8]; unsigned sb = 0u;
#pragma unroll
            for (int n = 0; n < 8; ++n) { float gsum = 0.f;
                if (n < own) { const float* k0 = kpart + (size_t)((b * NH + hh) * 8 + n) * HD; const float* k1 = k0 + (size_t)NB * NH * 8 * HD;
                    for (int d = 0; d < 128; ++d) gsum = fmaf(qs[tid * 128 + d], (k0[d] + k1[d]) * (1.f / 256.f), gsum); }
                gate[n] = n < own ? gsum : NEGF; }
#pragma unroll
            for (int k = 0; k < 3; ++k) { int best = -1; float bv = 0.f;
#pragma unroll
                for (int n = 0; n < 8; ++n) if (!((sb >> n) & 1u) && (best < 0 || gate[n] > bv)) { best = n; bv = gate[n]; }
                sb |= 1u << best; }
            misc[16 + tid] = __uint_as_float(sb & ((1u << own) - 1u)); }
        __syncthreads();
        selbits = __float_as_uint(misc[16 + row]);
    }
    const float cq = MODE == 2 ? cum[(size_t)(b * NH + hh) * S + t] : 0.f;
    for (int s = sub; s < nkeys; s += 16) {
        const bf16_t* kr = Kb + ((size_t)(b * NH + hq) * S + s) * HD; float dot = 0.f;
        for (int d = 0; d < 128; d += 8) { const u32x4 kv = *(const u32x4*)(kr + d); const float* qq = qs + row * 128 + d;
#pragma unroll
            for (int j = 0; j < 4; ++j) { dot = fmaf(qq[2 * j], __uint_as_float(kv[j] << 16), dot); dot = fmaf(qq[2 * j + 1], __uint_as_float(kv[j] & 0xffff0000u), dot); } }
        float lg = dot * SCALE; bool ok = s <= t;
        if (MODE == 0 || MODE == 1) lg += rel[t5_bucket(t - s > 0 ? t - s : 0) * 16 + hq];
        if (MODE == 1) { const int blk = s >> 8; if (blk != own) ok = (selbits >> blk) & 1u; }
        if (MODE == 2) lg += cq - cum[(size_t)(b * NH + hh) * S + s];
        sc[row * SC_LD + s] = ok ? lg : NEGF;
    }
    __syncthreads();
    float mx = NEGF;
    for (int s = sub; s < nkeys; s += 16) mx = fmaxf(mx, sc[row * SC_LD + s]);
    for (int o = 8; o; o >>= 1) mx = fmaxf(mx, __shfl_xor(mx, o));
    float sum = 0.f;
    for (int s = sub; s < nkeys; s += 16) { const float p = __expf(sc[row * SC_LD + s] - mx); sc[row * SC_LD + s] = p; sum += p; }
    for (int o = 8; o; o >>= 1) sum += __shfl_xor(sum, o);
    const float inv = 1.f / sum;
    for (int s = sub; s < nkeys; s += 16) sc[row * SC_LD + s] *= inv;
    __syncthreads();
    if (MODE == 0) {
        const int q2 = tid >> 5, dl = tid & 31, d0 = dl * 8;
        const int vh = 2 * hh + (d0 >> 7), dd = d0 & 127;
        float o[8];
#pragma unroll
        for (int j = 0; j < 8; ++j) o[j] = 0.f;
        for (int s = 0; s < nkeys; ++s) { const float a = sc[q2 * SC_LD + s] - lam * sc[(8 + q2) * SC_LD + s];
            const u32x4 vv = *(const u32x4*)(Vb + ((size_t)(b * NH + vh) * S + s) * HD + dd);
#pragma unroll
            for (int j = 0; j < 4; ++j) { o[2 * j] = fmaf(a, __uint_as_float(vv[j] << 16), o[2 * j]); o[2 * j + 1] = fmaf(a, __uint_as_float(vv[j] & 0xffff0000u), o[2 * j + 1]); } }
        float ss = 0.f;
#pragma unroll
        for (int j = 0; j < 8; ++j) ss += o[j] * o[j];
        for (int off = 16; off; off >>= 1) ss += __shfl_xor(ss, off);
        const float r = rsqrtf(ss * (1.f / 256.f) + RMS_EPS) * (1.f - lam_init);
        const size_t gi = (size_t)(b * S + t0 + q2) * E + hh * 256 + d0;
        const u32x4 zv = *(const u32x4*)(Zb + gi); u32x4 ov;
#pragma unroll
        for (int j = 0; j < 4; ++j) { const float z0 = __uint_as_float(zv[j] << 16), z1 = __uint_as_float(zv[j] & 0xffff0000u);
            const float a0 = o[2 * j] * r * subg[d0 + 2 * j] * siluf(z0), a1 = o[2 * j + 1] * r * subg[d0 + 2 * j + 1] * siluf(z1);
            ov[j] = f2bf(a0) | ((unsigned)f2bf(a1) << 16); }
        *(u32x4*)(G + gi) = ov;
    } else {
        const int d0 = sub * 8; float o[8];
#pragma unroll
        for (int j = 0; j < 8; ++j) o[j] = 0.f;
        for (int s = 0; s < nkeys; ++s) { const float a = sc[row * SC_LD + s];
            const u32x4 vv = *(const u32x4*)(Vb + ((size_t)(b * NH + hh) * S + s) * HD + d0);
#pragma unroll
            for (int j = 0; j < 4; ++j) { o[2 * j] = fmaf(a, __uint_as_float(vv[j] << 16), o[2 * j]); o[2 * j + 1] = fmaf(a, __uint_as_float(vv[j] & 0xffff0000u), o[2 * j + 1]); } }
        const size_t gi = (size_t)(b * S + t) * E + hh * 128 + d0;
        const u32x4 zv = *(const u32x4*)(Zb + gi); u32x4 ov;
#pragma unroll
        for (int j = 0; j < 4; ++j) { const float z0 = __uint_as_float(zv[j] << 16), z1 = __uint_as_float(zv[j] & 0xffff0000u);
            ov[j] = f2bf(o[2 * j] * siluf(z0)) | ((unsigned)f2bf(o[2 * j + 1] * siluf(z1)) << 16); }
        *(u32x4*)(G + gi) = ov;
    }
}

extern "C" void kernel_launch(void* const* d_in, const int* in_sizes, int n_in, void* d_out, int out_size, void* d_ws, size_t ws_size, hipStream_t stream) {
    if (n_in != 29 || ws_size < WS_END || out_size != M * D) { fprintf(stderr, "kernel_launch: unexpected shapes n_in=%d ws=%zu out=%d\n", n_in, ws_size, out_size); return; }
    unsigned char* ws = (unsigned char*)d_ws;
    const float* x = (const float*)d_in[0]; const float* rel = (const float*)d_in[1];
    const int i_win[4] = {2, 11, 15, 20}, i_wout[4] = {8, 12, 17, 26}, i_g[4] = {9, 13, 18, 27}, i_b[4] = {10, 14, 19, 28};
    bf16_t* HB = (bf16_t*)(ws + WS_HB); bf16_t* Qb = (bf16_t*)(ws + WS_Q); bf16_t* Kb = (bf16_t*)(ws + WS_K); bf16_t* Vb = (bf16_t*)(ws + WS_V);
    bf16_t* Zb = (bf16_t*)(ws + WS_Z); bf16_t* G = (bf16_t*)(ws + WS_G); float* stats = (float*)(ws + WS_STATS); float* kpart = (float*)(ws + WS_KPART);
    float* logf = (float*)(ws + WS_LOGF); float* cum = (float*)(ws + WS_CUM); bf16_t* WfT = (bf16_t*)(ws + WS_WF); float* T = (float*)d_out;
    static bool attr = false;
    const int ATT_LDS = (16 * SC_LD + 16 * 128 + 64) * 4;
    if (!attr) { attr = true;
        (void)hipFuncSetAttribute((const void*)attn_naive<0>, hipFuncAttributeMaxDynamicSharedMemorySize, ATT_LDS);
        (void)hipFuncSetAttribute((const void*)attn_naive<1>, hipFuncAttributeMaxDynamicSharedMemorySize, ATT_LDS);
        (void)hipFuncSetAttribute((const void*)attn_naive<2>, hipFuncAttributeMaxDynamicSharedMemorySize, ATT_LDS); }
    for (int l = 0; l < 4; ++l) {
        const int ldw = (l == 2) ? NPROJ + 16 : NPROJ;
        transpose_cvt<<<(D / 64) * (NPROJ / 64), 256, 0, stream>>>((const float*)d_in[i_win[l]], D, ldw, 0, NPROJ, (bf16_t*)(ws + WS_WIN + (size_t)l * 32 * MiB));
        transpose_cvt<<<(E / 64) * (D / 64), 256, 0, stream>>>((const float*)d_in[i_wout[l]], E, D, 0, D, (bf16_t*)(ws + WS_WOUT + (size_t)l * 8 * MiB));
    }
    transpose_cvt<<<(D / 64) * 1, 256, 0, stream>>>((const float*)d_in[15], D, NPROJ + 16, NPROJ, 16, WfT);
    cvt_bf16<<<2048, 256, 0, stream>>>(x, HB, (size_t)M * D);
    for (int l = 0; l < 4; ++l) {
        const bf16_t* WinT = (const bf16_t*)(ws + WS_WIN + (size_t)l * 32 * MiB); const bf16_t* WoutT = (const bf16_t*)(ws + WS_WOUT + (size_t)l * 8 * MiB);
        gemm_naive<EpiInProj><<<(M / 64) * (NPROJ / 64), 256, 0, stream>>>(HB, WinT, M, NPROJ, D, 0, EpiInProj{Qb, Kb, Vb, Zb});
        if (l == 0 || l == 3) {
            const int base = (l == 0) ? 3 : 21; const float lam_init = (l == 0) ? 0.2f : (0.8f - 0.6f * 0.40656965974059917f);
            attn_naive<0><<<NB * 8 * (S / 8), 256, ATT_LDS, stream>>>(Qb, Kb, Vb, Zb, G, rel, nullptr, nullptr, (const float*)d_in[base], (const float*)d_in[base + 1], (const float*)d_in[base + 2],
                                                                    (const float*)d_in[base + 3], (const float*)d_in[base + 4], lam_init);
        } else if (l == 1) {
            kmean_naive<<<NB * NH * 8, 128, 0, stream>>>(Kb, kpart);
            attn_naive<1><<<NB * NH * (S / 16), 256, ATT_LDS, stream>>>(Qb, Kb, Vb, Zb, G, rel, kpart, nullptr, nullptr, nullptr, nullptr, nullptr, nullptr, 0.f);
        } else {
            logf_naive<<<M * 16 / 256, 256, 0, stream>>>(HB, WfT, (const float*)d_in[16], logf);
            cum_naive<<<1, 64, 0, stream>>>(logf, cum);
            attn_naive<2><<<NB * NH * (S / 16), 256, ATT_LDS, stream>>>(Qb, Kb, Vb, Zb, G, rel, nullptr, cum, nullptr, nullptr, nullptr, nullptr, nullptr, 0.f);
        }
        gemm_naive<EpiOutProj><<<(M / 64) * (D / 64), 256, 0, stream>>>(G, WoutT, M, D, E, 0, EpiOutProj{T, x, stats, l ? (const float*)d_in[i_g[l - 1]] : nullptr, l ? (const float*)d_in[i_b[l - 1]] : nullptr, l, 0});
        ln_rows<<<M, 256, 0, stream>>>(T, (const float*)d_in[i_g[l]], (const float*)d_in[i_b[l]], stats, HB, l == 3);
    }
}
```

```cpp
#include <hip/hip_runtime.h>
#include <hip/hip_cooperative_groups.h>
#include <cstdint>
#include <cstdio>
namespace cg = cooperative_groups;

typedef unsigned short h16_t;
typedef float f32x4 __attribute__((ext_vector_type(4)));
typedef float f32x2 __attribute__((ext_vector_type(2)));
typedef unsigned u32x4 __attribute__((ext_vector_type(4)));
typedef _Float16 f16x8 __attribute__((ext_vector_type(8)));
typedef _Float16 f16x2 __attribute__((ext_vector_type(2)));
#define LAS __attribute__((address_space(3)))

constexpr int NB = 4, S = 2048, D = 2048, M = NB * S, E = 2048, NH = 16, HD = 128;
constexpr int NPROJ = 4 * E;
constexpr float SCALE = 0.08838834764831845f;
constexpr float LN_EPS = 1e-5f, RMS_EPS = 1e-5f;
constexpr float DN_ALPHA = 1.681792830507429f;
constexpr float NEGF = -1e30f;
constexpr int NTHREADS = 512, NWAVES = 8;
constexpr int LDS_BYTES = 147456;

constexpr size_t MiB = 1u << 20;
constexpr size_t WS_CTL = 0;
constexpr size_t WS_WIN = 1 * MiB;
constexpr size_t WS_WOUT = WS_WIN + 128 * MiB;
constexpr size_t WS_HB = WS_WOUT + 32 * MiB;
constexpr size_t WS_Q = WS_HB + 32 * MiB;
constexpr size_t WS_K = WS_Q + 32 * MiB;
constexpr size_t WS_V = WS_K + 32 * MiB;
constexpr size_t WS_Z = WS_V + 32 * MiB;
constexpr size_t WS_G = WS_Z + 32 * MiB;
constexpr size_t WS_SMALL = WS_G + 32 * MiB;
constexpr size_t WS_STATS = WS_SMALL;
constexpr size_t WS_KPART = WS_STATS + 64 * 1024;
constexpr size_t WS_LOGF = WS_KPART + 512 * 1024;
constexpr size_t WS_CUM = WS_LOGF + 512 * 1024;
constexpr size_t WS_WF = WS_CUM + 512 * 1024;
constexpr size_t WS_END = WS_WF + 64 * 1024;

__device__ __forceinline__ float h2f(h16_t v) { return (float)__builtin_bit_cast(_Float16, v); }
__device__ __forceinline__ h16_t f2h(float f) { return __builtin_bit_cast(h16_t, (_Float16)f); }
__device__ __forceinline__ float lo16(unsigned u) { return h2f((h16_t)(u & 0xffffu)); }
__device__ __forceinline__ float hi16(unsigned u) { return h2f((h16_t)(u >> 16)); }
__device__ __forceinline__ unsigned pk2(float lo, float hi) { f32x2 v = {lo, hi}; return __builtin_bit_cast(unsigned, __builtin_convertvector(v, f16x2)); }
__device__ __forceinline__ float siluf(float z) { return z / (1.f + __expf(-z)); }

__device__ __forceinline__ int t5_bucket(int d) {
    if (d < 16) return d;
    if (d >= 113) return 31;
    int b = 16;
    b += (d >= 19); b += (d >= 21); b += (d >= 24); b += (d >= 27); b += (d >= 31); b += (d >= 35); b += (d >= 40); b += (d >= 46);
    b += (d >= 52); b += (d >= 59); b += (d >= 67); b += (d >= 77); b += (d >= 87); b += (d >= 99);
    return b;
}

namespace pg8 {
constexpr int BM = 256, BK = 64, HALF = 128, HTB = HALF * BK * 2, STAGE_BYTES = 8 * HTB, NXCD = 8, WGM = 8;
__host__ __device__ __forceinline__ int lds_byte(int r, int c) { const int st = (r >> 4) * 2 + (c >> 5), rr = r & 15, cc = c & 31, ob = rr * 64 + cc * 2; return st * 1024 + (ob ^ (((ob >> 9) & 1) << 5)); }
__host__ __device__ __forceinline__ void stage_rc(int b, int& R, int& C) { const int st = b / 1024, sb = b % 1024, swz = sb ^ (((sb >> 9) & 1) << 5); R = (st >> 1) * 16 + swz / 64; C = (st & 1) * 32 + (swz % 64) / 2; }
__host__ __device__ __forceinline__ int perm32(int rho) { const int n = rho >> 4, i = rho & 15; return 8 * (i >> 2) + 4 * n + (i & 3); }
struct Unit { int pm, pn; };
struct Gemm { const h16_t* A; const h16_t* Bt; int M, N, K; };
struct StaticOrder {
    int nM, nN, nwg, G, c;
    __host__ __device__ void init(int M_, int N_, int G_, int c_) { nM = M_ / BM; nN = N_ / BM; nwg = nM * nN; G = G_; c = c_; }
    __host__ __device__ bool next(int i, Unit& u) const {
        const long L = (long)i * G + c; if (L >= nwg) return false;
        int wgid = (int)L; { const int q = nwg / NXCD, r = nwg % NXCD, xcd = wgid % NXCD, off = wgid / NXCD; wgid = (xcd < r ? xcd * (q + 1) : r * (q + 1) + (xcd - r) * q) + off; }
        const int nig = WGM * nN, gid = wgid / nig, fm = gid * WGM, gsz = (nM - fm) < WGM ? (nM - fm) : WGM;
        u.pm = fm + ((wgid % nig) % gsz); u.pn = (wgid % nig) / gsz; return true;
    }
    __device__ __forceinline__ void a_ready(const Unit&) const {}
    __device__ __forceinline__ void done(const Unit&) const {}
};

template <class Epi, class Sched, bool ALIGN_EPI = false, bool SP2 = false>
__device__ __forceinline__ void gemm_phase(LAS unsigned char* lds, const Gemm g, const Sched& S, const Epi& E, const int tid) {
    const int wid = __builtin_amdgcn_readfirstlane(tid >> 6), lane = tid & 63, wr = wid >> 2, wc = wid & 3, fr = lane & 15, fq = lane >> 4;
    const int K = g.K, nt = K / BK;
    unsigned voffA[2], voffB[2];
#pragma unroll
    for (int i = 0; i < 2; ++i) { int R, C; stage_rc(tid * 16 + i * 8192, R, C); const int Rb = Epi::PERM ? ((R & ~31) + perm32(R & 31)) : R;
        voffA[i] = (unsigned)(R * K + C) * 2u; voffB[i] = (unsigned)(Rb * K + C) * 2u; }
    const size_t kstep = (size_t)(BK * 2);
    const size_t hstep = (size_t)HALF * K * 2;
    const size_t tstep = 2 * hstep;
    const unsigned ldsw = (unsigned)wid * 1024u;
    const int aoff = lds_byte(wr * 64 + fr, fq * 8), boff = lds_byte(wc * 32 + fr, fq * 8);
#define PG8_SA(b, h) (((b) * 2 + (h)) * HTB)
#define PG8_SB(b, h) ((4 + (b) * 2 + (h)) * HTB)
#define PG8_STAGE(bufoff, gbase, voff) do { _Pragma("unroll") for (int _i = 0; _i < 2; ++_i) \
        __builtin_amdgcn_global_load_lds((const unsigned*)((const char*)(gbase) + (voff)[_i]), (LAS unsigned*)(lds + (bufoff) + ldsw + _i * 8192), 16, 0, 0); } while (0)
#define PG8_LDA(dst, b, h) do { _Pragma("unroll") for (int m = 0; m < 4; ++m) _Pragma("unroll") for (int k = 0; k < 2; ++k) dst[m][k] = *(const LAS f16x8*)(lds + PG8_SA(b, h) + aoff + m * 2048 + k * 1024); } while (0)
#define PG8_LDB(dst, b, h) do { _Pragma("unroll") for (int n = 0; n < 2; ++n) _Pragma("unroll") for (int k = 0; k < 2; ++k) dst[n][k] = *(const LAS f16x8*)(lds + PG8_SB(b, h) + boff + n * 2048 + k * 1024); } while (0)
#define PG8_MMA(ai, bj, At, Bt) do { __builtin_amdgcn_s_setprio(1); _Pragma("unroll") for (int m = 0; m < 4; ++m) _Pragma("unroll") for (int n = 0; n < 2; ++n) _Pragma("unroll") for (int k = 0; k < 2; ++k) \
        acc[ai][bj][m][n] = __builtin_amdgcn_mfma_f32_16x16x32_f16(Bt[n][k], At[m][k], acc[ai][bj][m][n], 0, 0, 0); __builtin_amdgcn_s_setprio(0); } while (0)
#define PG8_WAIT_V(n) asm volatile("s_waitcnt vmcnt(" #n ")" ::: "memory")
#define PG8_WAIT_L(n) asm volatile("s_waitcnt lgkmcnt(" #n ")" ::: "memory")
#define PG8_BAR __builtin_amdgcn_s_barrier()
#define PG8_SCHED __builtin_amdgcn_sched_barrier(0)
    Unit cur, nxt; int ui = 0;
    if (!S.next(0, cur)) return;
    f32x4 acc[2][2][4][2];
#pragma unroll
    for (int a = 0; a < 2; ++a)
#pragma unroll
        for (int b = 0; b < 2; ++b)
#pragma unroll
            for (int m = 0; m < 4; ++m)
#pragma unroll
                for (int n = 0; n < 2; ++n) acc[a][b][m][n] = (f32x4){0.f, 0.f, 0.f, 0.f};
    f16x8 At[4][2], B0[2][2], B1[2][2];
    const char* cA = (const char*)g.A + (size_t)cur.pm * tstep; const char* cB = (const char*)g.Bt + (size_t)cur.pn * tstep;
    S.a_ready(cur);
    if constexpr (SP2) {
        PG8_STAGE(PG8_SB(0, 0), cB, voffB); PG8_STAGE(PG8_SB(0, 1), cB + hstep, voffB); PG8_STAGE(PG8_SA(0, 0), cA, voffA); PG8_STAGE(PG8_SA(0, 1), cA + hstep, voffA);
        if (wr == 1) PG8_BAR;
        PG8_WAIT_V(2); PG8_BAR;
        PG8_STAGE(PG8_SB(1, 0), cB + kstep, voffB); PG8_STAGE(PG8_SA(1, 0), cA + kstep, voffA); PG8_STAGE(PG8_SB(1, 1), cB + hstep + kstep, voffB);
        PG8_WAIT_V(6); PG8_BAR;
    } else {
        PG8_STAGE(PG8_SB(0, 0), cB, voffB); PG8_STAGE(PG8_SA(0, 0), cA, voffA); PG8_STAGE(PG8_SB(0, 1), cB + hstep, voffB); PG8_STAGE(PG8_SA(0, 1), cA + hstep, voffA);
        if (wr == 1) PG8_BAR;
        PG8_WAIT_V(4); PG8_BAR;
        PG8_STAGE(PG8_SB(1, 0), cB + kstep, voffB); PG8_STAGE(PG8_SA(1, 0), cA + kstep, voffA); PG8_STAGE(PG8_SB(1, 1), cB + hstep + kstep, voffB);
        PG8_WAIT_V(6); PG8_BAR;
    }
    for (;;) {
        const bool has_next = S.next(ui + 1, nxt);
        const char* nA = has_next ? (const char*)g.A + (size_t)nxt.pm * tstep : cA; const char* nB = has_next ? (const char*)g.Bt + (size_t)nxt.pn * tstep : cB;
        for (int t = 0; t < nt; t += 2) {
            const bool last = (t == nt - 2);
            const char* a1 = cA + (size_t)(t + 1) * kstep;
            const char* a2 = last ? nA : cA + (size_t)(t + 2) * kstep; const char* b2 = last ? nB : cB + (size_t)(t + 2) * kstep;
            const char* a3 = a2 + kstep; const char* b3 = b2 + kstep;
            if (last && has_next) S.a_ready(nxt);
            if constexpr (SP2) {
            PG8_LDB(B0, 0, 0); PG8_LDB(B1, 0, 1); PG8_SCHED; PG8_LDA(At, 0, 0); PG8_STAGE(PG8_SA(1, 1), a1 + hstep, voffA);
            PG8_WAIT_V(8); PG8_WAIT_L(0); PG8_BAR; PG8_MMA(0, 0, At, B0); PG8_MMA(0, 1, At, B1); PG8_BAR; PG8_SCHED;
            PG8_LDA(At, 0, 1); PG8_STAGE(PG8_SB(0, 0), b2, voffB); PG8_STAGE(PG8_SB(0, 1), b2 + hstep, voffB); PG8_STAGE(PG8_SA(0, 0), a2, voffA);
            PG8_WAIT_V(8); PG8_WAIT_L(0); PG8_BAR; PG8_MMA(1, 0, At, B0); PG8_MMA(1, 1, At, B1); PG8_BAR; PG8_SCHED;
            PG8_LDB(B0, 1, 0); PG8_LDB(B1, 1, 1); PG8_SCHED; PG8_LDA(At, 1, 0); PG8_STAGE(PG8_SA(0, 1), a2 + hstep, voffA);
            PG8_WAIT_V(8); PG8_WAIT_L(0); PG8_BAR; PG8_MMA(0, 0, At, B0); PG8_MMA(0, 1, At, B1); PG8_BAR; PG8_SCHED;
            PG8_LDA(At, 1, 1); PG8_STAGE(PG8_SB(1, 0), b3, voffB); PG8_STAGE(PG8_SB(1, 1), b3 + hstep, voffB); PG8_STAGE(PG8_SA(1, 0), a3, voffA);
            PG8_WAIT_V(8); PG8_WAIT_L(0); PG8_BAR; PG8_MMA(1, 0, At, B0); PG8_MMA(1, 1, At, B1); PG8_BAR; PG8_SCHED;
            } else {
            PG8_LDB(B0, 0, 0); PG8_SCHED; PG8_LDA(At, 0, 0); PG8_STAGE(PG8_SA(1, 1), a1 + hstep, voffA);
            PG8_WAIT_L(8); PG8_BAR; PG8_WAIT_L(0); PG8_MMA(0, 0, At, B0); PG8_BAR; PG8_SCHED;
            PG8_LDB(B1, 0, 1); PG8_STAGE(PG8_SB(0, 0), b2, voffB);
            PG8_BAR; PG8_WAIT_L(0); PG8_MMA(0, 1, At, B1); PG8_BAR;
            PG8_LDA(At, 0, 1); PG8_STAGE(PG8_SA(0, 0), a2, voffA);
            PG8_BAR; PG8_WAIT_L(0); PG8_MMA(1, 0, At, B0); PG8_BAR; PG8_SCHED;
            PG8_STAGE(PG8_SB(0, 1), b2 + hstep, voffB);
            PG8_WAIT_V(6); PG8_BAR; PG8_MMA(1, 1, At, B1); PG8_BAR;
            PG8_LDB(B0, 1, 0); PG8_SCHED; PG8_LDA(At, 1, 0); PG8_STAGE(PG8_SA(0, 1), a2 + hstep, voffA);
            PG8_WAIT_L(8); PG8_BAR; PG8_WAIT_L(0); PG8_MMA(0, 0, At, B0); PG8_BAR; PG8_SCHED;
            PG8_LDB(B1, 1, 1); PG8_STAGE(PG8_SB(1, 0), b3, voffB);
            PG8_BAR; PG8_WAIT_L(0); PG8_MMA(0, 1, At, B1); PG8_BAR;
            PG8_LDA(At, 1, 1); PG8_STAGE(PG8_SA(1, 0), a3, voffA);
            PG8_BAR; PG8_WAIT_L(0); PG8_MMA(1, 0, At, B0); PG8_BAR; PG8_SCHED;
            PG8_STAGE(PG8_SB(1, 1), b3 + hstep, voffB);
            PG8_WAIT_V(6); PG8_BAR; PG8_MMA(1, 1, At, B1); PG8_BAR;
            }
        }
        if constexpr (ALIGN_EPI) { if (wr == 0) PG8_BAR; }
        E(acc, cur, wr, wc, fr, fq); S.done(cur);
        if (!has_next) break;
#pragma unroll
        for (int a = 0; a < 2; ++a)
#pragma unroll
            for (int b = 0; b < 2; ++b)
#pragma unroll
                for (int m = 0; m < 4; ++m)
#pragma unroll
                    for (int n = 0; n < 2; ++n) acc[a][b][m][n] = (f32x4){0.f, 0.f, 0.f, 0.f};
        cur = nxt; cA = nA; cB = nB; ++ui;
        if constexpr (ALIGN_EPI) { if (wr == 1) PG8_BAR; }
    }
    PG8_WAIT_V(0);
    if constexpr (!ALIGN_EPI) { if (wr == 0) PG8_BAR; }
    PG8_BAR;
#undef PG8_SA
#undef PG8_SB
#undef PG8_STAGE
#undef PG8_LDA
#undef PG8_LDB
#undef PG8_MMA
#undef PG8_WAIT_V
#undef PG8_WAIT_L
#undef PG8_BAR
#undef PG8_SCHED
}
}

struct EpiQKVZ {
    static constexpr bool PERM = true;
    h16_t *Q, *K, *V, *Z; float* kpart;
    __device__ __forceinline__ void operator()(const f32x4 (&acc)[2][2][4][2], const pg8::Unit& u, int wr, int wc, int fr, int fq) const {
        const int colt = u.pn * 256, sec = colt >> 11, cbase = colt & 2047;
        const int row0 = u.pm * 256 + wr * 64 + fr;
        h16_t* dst = sec == 0 ? Q : (sec == 1 ? K : (sec == 2 ? V : Z));
#pragma unroll
        for (int ai = 0; ai < 2; ++ai)
#pragma unroll
            for (int m = 0; m < 4; ++m) { const int r = row0 + ai * 128 + m * 16, b = r >> 11, s = r & 2047;
#pragma unroll
                for (int bj = 0; bj < 2; ++bj) { const f32x4 v0 = acc[ai][bj][m][0], v1 = acc[ai][bj][m][1];
                    u32x4 w; w.x = pk2(v0[0], v0[1]); w.y = pk2(v0[2], v0[3]); w.z = pk2(v1[0], v1[1]); w.w = pk2(v1[2], v1[3]);
                    const int c = cbase + bj * 128 + wc * 32 + 8 * fq;
                    h16_t* p = (sec == 3) ? dst + (size_t)r * E + c : dst + ((size_t)(b * NH + (c >> 7)) * S + s) * HD + (c & 127);
                    *(u32x4*)p = w; } }
        if (kpart != nullptr && sec == 1) {
            const int b = u.pm >> 3, nblk = u.pm & 7;
#pragma unroll
            for (int bj = 0; bj < 2; ++bj) { f32x4 s0 = {0.f, 0.f, 0.f, 0.f}, s1 = {0.f, 0.f, 0.f, 0.f};
#pragma unroll
                for (int ai = 0; ai < 2; ++ai)
#pragma unroll
                    for (int m = 0; m < 4; ++m) { s0 += acc[ai][bj][m][0]; s1 += acc[ai][bj][m][1]; }
#pragma unroll
                for (int o = 1; o < 16; o <<= 1)
#pragma unroll
                    for (int e = 0; e < 4; ++e) { s0[e] += __shfl_xor(s0[e], o); s1[e] += __shfl_xor(s1[e], o); }
                if (fr == 0) { const int c = cbase + bj * 128 + wc * 32 + 8 * fq;
                    float* p = kpart + (size_t)wr * NB * NH * 8 * HD + ((size_t)(b * NH + (c >> 7)) * 8 + nblk) * HD + (c & 127);
                    *(f32x4*)p = s0; *(f32x4*)(p + 4) = s1; } }
        }
    }
};
struct EpiResid {
    static constexpr bool PERM = false;
    float* T; const float* x; const float* stats; const float* g; const float* bta; int layer;
    __device__ __forceinline__ void operator()(const f32x4 (&acc)[2][2][4][2], const pg8::Unit& u, int wr, int wc, int fr, int fq) const {
        const int col0 = u.pn * 256 + wc * 32 + 4 * fq, row0 = u.pm * 256 + wr * 64 + fr;
        f32x4 gv[2][2], bv[2][2];
        if (layer) {
#pragma unroll
            for (int bj = 0; bj < 2; ++bj)
#pragma unroll
                for (int n = 0; n < 2; ++n) { gv[bj][n] = *(const f32x4*)(g + col0 + bj * 128 + n * 16); bv[bj][n] = *(const f32x4*)(bta + col0 + bj * 128 + n * 16); } }
#pragma unroll
        for (int ai = 0; ai < 2; ++ai)
#pragma unroll
            for (int m = 0; m < 4; ++m) { const int r = row0 + ai * 128 + m * 16; float mean = 0.f, rstd = 1.f;
                if (layer) { const f32x2 st = *(const f32x2*)(stats + 2 * r); mean = st.x; rstd = st.y; }
#pragma unroll
                for (int bj = 0; bj < 2; ++bj)
#pragma unroll
                    for (int n = 0; n < 2; ++n) { const size_t idx = (size_t)r * D + col0 + bj * 128 + n * 16; f32x4 h;
                        if (layer) h = (*(const f32x4*)(T + idx) - mean) * rstd * gv[bj][n] + bv[bj][n]; else h = *(const f32x4*)(x + idx);
                        *(f32x4*)(T + idx) = DN_ALPHA * h + acc[ai][bj][m][n]; }
                asm volatile("" ::: "memory"); }
    }
};

struct Ctx { int tid, lane, wave, G, bid; unsigned char* lds; };

__device__ __forceinline__ void transpose_phase(const Ctx& c, const float* __restrict__ W, int ldw, int c0, int ncols, h16_t* __restrict__ WT) {
    float (*tile)[65] = (float (*)[65])(c.lds + (c.tid >> 8) * (64 * 65 * 4));
    const int nb = (ncols + 63) / 64, ntiles = (D / 64) * nb, t2 = c.tid & 255, tx = t2 & 63, ty = t2 >> 6;
    for (int it = c.bid * 2; it < ntiles; it += c.G * 2) {
        const int tl = it + (c.tid >> 8); const bool act = tl < ntiles;
        const int kb = tl / nb, cb = tl % nb, k0 = kb * 64, n0 = cb * 64;
        if (act) for (int i = ty; i < 64; i += 4) { const int n = n0 + tx; tile[i][tx] = (n < ncols) ? W[(size_t)(k0 + i) * ldw + c0 + n] : 0.f; }
        __syncthreads();
        if (act) for (int i = ty; i < 64; i += 4) { const int n = n0 + i; if (n < ncols) WT[(size_t)n * D + k0 + tx] = f2h(tile[tx][i]); }
        __syncthreads();
    }
}
__device__ __forceinline__ void cvt_phase(const Ctx& c, const float* __restrict__ x, h16_t* __restrict__ o, size_t n) {
    for (size_t i = ((size_t)c.bid * NTHREADS + c.tid) * 4; i < n; i += (size_t)c.G * NTHREADS * 4) { const f32x4 v = *(const f32x4*)(x + i); *(uint2*)(o + i) = make_uint2(pk2(v.x, v.y), pk2(v.z, v.w)); }
}
__device__ __forceinline__ float wave_sum(float v) {
#pragma unroll
    for (int o = 1; o < 64; o <<= 1) v += __shfl_xor(v, o);
    return v;
}
__device__ __forceinline__ void ln_phase(const Ctx& c, float* T, const float* __restrict__ g, const float* __restrict__ bta, float* stats, h16_t* HB, bool final_layer) {
    const int gw = c.bid * NWAVES + c.wave, NGW = c.G * NWAVES;
    for (int m = gw; m < M; m += NGW) {
        float* row = T + (size_t)m * D; f32x4 v[8]; float s = 0.f;
#pragma unroll
        for (int j = 0; j < 8; ++j) { v[j] = *(const f32x4*)(row + (64 * j + c.lane) * 4); s += (v[j].x + v[j].y) + (v[j].z + v[j].w); }
        const float mean = wave_sum(s) * (1.f / D); float q = 0.f;
#pragma unroll
        for (int j = 0; j < 8; ++j) { v[j] = v[j] - mean; q += (v[j].x * v[j].x + v[j].y * v[j].y) + (v[j].z * v[j].z + v[j].w * v[j].w); }
        const float rstd = rsqrtf(wave_sum(q) * (1.f / D) + LN_EPS);
        if (c.lane == 0) { stats[2 * m] = mean; stats[2 * m + 1] = rstd; }
#pragma unroll
        for (int j = 0; j < 8; ++j) { const int col = (64 * j + c.lane) * 4; const f32x4 o = v[j] * rstd * *(const f32x4*)(g + col) + *(const f32x4*)(bta + col);
            if (final_layer) *(f32x4*)(row + col) = o; else *(uint2*)(HB + (size_t)m * D + col) = make_uint2(pk2(o.x, o.y), pk2(o.z, o.w)); }
    }
}
__device__ __forceinline__ void logf_phase(const Ctx& c, const h16_t* __restrict__ HB, const h16_t* __restrict__ WfT, const float* __restrict__ bf, float* logf) {
    for (int rb = c.bid; rb < M / 32; rb += c.G) {
        const int m = rb * 32 + (c.tid >> 4), j = c.tid & 15;
        const h16_t* a = HB + (size_t)m * D; const h16_t* w = WfT + (size_t)j * D; float s = 0.f;
        for (int k = 0; k < D; k += 8) { const u32x4 av = *(const u32x4*)(a + k), wv = *(const u32x4*)(w + k);
#pragma unroll
            for (int e = 0; e < 4; ++e) { s = fmaf(lo16(av[e]), lo16(wv[e]), s); s = fmaf(hi16(av[e]), hi16(wv[e]), s); } }
        const float xx = s + bf[j];
        logf[(size_t)m * 16 + j] = fminf(xx, 0.f) - log1pf(__expf(-fabsf(xx)));
    }
}
__device__ __forceinline__ void cum_phase(const Ctx& c, const float* __restrict__ logf, float* cum) {
    float* wtot = (float*)c.lds;
    for (int bh = c.bid; bh < NB * NH; bh += c.G) {
        const int b = bh / NH, h = bh % NH; float v[4];
#pragma unroll
        for (int e = 0; e < 4; ++e) v[e] = logf[(size_t)(b * S + 4 * c.tid + e) * NH + h];
        v[1] += v[0]; v[2] += v[1]; v[3] += v[2];
        float incl = v[3];
#pragma unroll
        for (int o = 1; o < 64; o <<= 1) { const float t = __shfl_up(incl, o); if (c.lane >= o) incl += t; }
        if (c.lane == 63) wtot[c.wave] = incl;
        __syncthreads();
        float off = incl - v[3];
        for (int w = 0; w < c.wave; ++w) off += wtot[w];
        f32x4 o4 = {v[0] + off, v[1] + off, v[2] + off, v[3] + off};
        *(f32x4*)(cum + (size_t)bh * S + 4 * c.tid) = o4;
        __syncthreads();
    }
}

constexpr int SC_LD = 2064;
struct AttnArgs { const h16_t *Qb, *Kb, *Vb, *Zb; h16_t* G; const float *rel, *kpart, *cum, *lq1, *lk1, *lq2, *lk2, *subg; float lam_init; };
template <int MODE>
__device__ __forceinline__ void attn_naive_phase(const Ctx& c, const AttnArgs& A) {
    float* sc = (float*)c.lds; float* qs = sc + 16 * SC_LD; float* misc = qs + 16 * 128;
    const int tid = c.tid; const bool act = tid < 256; const int row = (tid >> 4) & 15, sub = tid & 15;
    constexpr int QPB = MODE == 0 ? 8 : 16, NHB = MODE == 0 ? 8 : 16;
    const int nqt = S / QPB, nvb = NB * NHB * nqt;
    for (int vb = c.bid; vb < nvb; vb += c.G) {
        const int qt = vb % nqt, hh = (vb / nqt) % NHB, b = vb / (nqt * NHB);
        const int t0 = qt * QPB, nkeys = t0 + QPB;
        const int qi = MODE == 0 ? (row & 7) : row, comp = MODE == 0 ? (row >> 3) : 0;
        const int hq = MODE == 0 ? 2 * hh + comp : hh;
        const int t = t0 + qi;
        if (act) for (int i = tid; i < 16 * 128; i += 256) { const int r = i >> 7, d = i & 127; const int rq = MODE == 0 ? (r & 7) : r, rh = MODE == 0 ? 2 * hh + (r >> 3) : hh;
            qs[i] = h2f(A.Qb[((size_t)(b * NH + rh) * S + t0 + rq) * HD + d]); }
        float lam = 0.f;
        if (MODE == 0) { if (tid < 64) { float a = A.lq1[tid] * A.lk1[tid] + A.lq1[tid + 64] * A.lk1[tid + 64], cc = A.lq2[tid] * A.lk2[tid] + A.lq2[tid + 64] * A.lk2[tid + 64];
                for (int o = 32; o; o >>= 1) { a += __shfl_xor(a, o); cc += __shfl_xor(cc, o); }
                if (tid == 0) misc[0] = __expf(a) - __expf(cc) + A.lam_init; } }
        __syncthreads();
        if (MODE == 0) lam = misc[0];
        unsigned selbits = 0u; const int own = t0 >> 8;
        if (MODE == 1) {
            if (tid < 16) { float gate[8]; unsigned sb = 0u;
#pragma unroll
                for (int n = 0; n < 8; ++n) { float gsum = 0.f;
                    if (n < own) { const float* k0 = A.kpart + (size_t)((b * NH + hh) * 8 + n) * HD; const float* k1 = k0 + (size_t)NB * NH * 8 * HD;
                        for (int d = 0; d < 128; ++d) gsum = fmaf(qs[tid * 128 + d], (k0[d] + k1[d]) * (1.f / 256.f), gsum); }
                    gate[n] = n < own ? gsum : NEGF; }
#pragma unroll
                for (int k = 0; k < 3; ++k) { int best = -1; float bv = 0.f;
#pragma unroll
                    for (int n = 0; n < 8; ++n) if (!((sb >> n) & 1u) && (best < 0 || gate[n] > bv)) { best = n; bv = gate[n]; }
                    sb |= 1u << best; }
                misc[16 + tid] = __uint_as_float(sb & ((1u << own) - 1u)); }
            __syncthreads();
            selbits = __float_as_uint(misc[16 + row]);
        }
        if (act) {
            const float cq = MODE == 2 ? A.cum[(size_t)(b * NH + hh) * S + t] : 0.f;
            for (int s = sub; s < nkeys; s += 16) {
                const h16_t* kr = A.Kb + ((size_t)(b * NH + hq) * S + s) * HD; float dot = 0.f;
                for (int d = 0; d < 128; d += 8) { const u32x4 kv = *(const u32x4*)(kr + d); const float* qq = qs + row * 128 + d;
#pragma unroll
                    for (int j = 0; j < 4; ++j) { dot = fmaf(qq[2 * j], lo16(kv[j]), dot); dot = fmaf(qq[2 * j + 1], hi16(kv[j]), dot); } }
                float lg = dot * SCALE; bool ok = s <= t;
                if (MODE == 0 || MODE == 1) lg += A.rel[t5_bucket(t - s > 0 ? t - s : 0) * 16 + hq];
                if (MODE == 1) { const int blk = s >> 8; if (blk != own) ok = (selbits >> blk) & 1u; }
                if (MODE == 2) lg += cq - A.cum[(size_t)(b * NH + hh) * S + s];
                sc[row * SC_LD + s] = ok ? lg : NEGF;
            }
        }
        __syncthreads();
        if (act) {
            float mx = NEGF;
            for (int s = sub; s < nkeys; s += 16) mx = fmaxf(mx, sc[row * SC_LD + s]);
            for (int o = 8; o; o >>= 1) mx = fmaxf(mx, __shfl_xor(mx, o));
            float sum = 0.f;
            for (int s = sub; s < nkeys; s += 16) { const float p = __expf(sc[row * SC_LD + s] - mx); sc[row * SC_LD + s] = p; sum += p; }
            for (int o = 8; o; o >>= 1) sum += __shfl_xor(sum, o);
            const float inv = 1.f / sum;
            for (int s = sub; s < nkeys; s += 16) sc[row * SC_LD + s] *= inv;
        }
        __syncthreads();
        if (act) {
            if (MODE == 0) {
                const int q2 = tid >> 5, dl = tid & 31, d0 = dl * 8;
                const int vh = 2 * hh + (d0 >> 7), dd = d0 & 127;
                float o[8];
#pragma unroll
                for (int j = 0; j < 8; ++j) o[j] = 0.f;
                for (int s = 0; s < nkeys; ++s) { const float a = sc[q2 * SC_LD + s] - lam * sc[(8 + q2) * SC_LD + s];
                    const u32x4 vv = *(const u32x4*)(A.Vb + ((size_t)(b * NH + vh) * S + s) * HD + dd);
#pragma unroll
                    for (int j = 0; j < 4; ++j) { o[2 * j] = fmaf(a, lo16(vv[j]), o[2 * j]); o[2 * j + 1] = fmaf(a, hi16(vv[j]), o[2 * j + 1]); } }
                float ss = 0.f;
#pragma unroll
                for (int j = 0; j < 8; ++j) ss += o[j] * o[j];
                for (int off = 16; off; off >>= 1) ss += __shfl_xor(ss, off);
                const float r = rsqrtf(ss * (1.f / 256.f) + RMS_EPS) * (1.f - A.lam_init);
                const size_t gi = (size_t)(b * S + t0 + q2) * E + hh * 256 + d0;
                const u32x4 zv = *(const u32x4*)(A.Zb + gi); u32x4 ov;
#pragma unroll
                for (int j = 0; j < 4; ++j) { const float a0 = o[2 * j] * r * A.subg[d0 + 2 * j] * siluf(lo16(zv[j])), a1 = o[2 * j + 1] * r * A.subg[d0 + 2 * j + 1] * siluf(hi16(zv[j]));
                    ov[j] = pk2(a0, a1); }
                *(u32x4*)(A.G + gi) = ov;
            } else {
                const int d0 = sub * 8; float o[8];
#pragma unroll
                for (int j = 0; j < 8; ++j) o[j] = 0.f;
                for (int s = 0; s < nkeys; ++s) { const float a = sc[row * SC_LD + s];
                    const u32x4 vv = *(const u32x4*)(A.Vb + ((size_t)(b * NH + hh) * S + s) * HD + d0);
#pragma unroll
                    for (int j = 0; j < 4; ++j) { o[2 * j] = fmaf(a, lo16(vv[j]), o[2 * j]); o[2 * j + 1] = fmaf(a, hi16(vv[j]), o[2 * j + 1]); } }
                const size_t gi = (size_t)(b * S + t) * E + hh * 128 + d0;
                const u32x4 zv = *(const u32x4*)(A.Zb + gi); u32x4 ov;
#pragma unroll
                for (int j = 0; j < 4; ++j) ov[j] = pk2(o[2 * j] * siluf(lo16(zv[j])), o[2 * j + 1] * siluf(hi16(zv[j])));
                *(u32x4*)(A.G + gi) = ov;
            }
        }
        __syncthreads();
    }
}

struct Args { const float* in[29]; float* out; unsigned char* ws; int ph_lo, ph_hi; };
static_assert(sizeof(Args) == 31 * 8 + 8, "Args has no padding");

__global__ void __launch_bounds__(NTHREADS, 2) mega_fwd(Args args) {
    extern __shared__ __attribute__((aligned(16))) unsigned char lds[];
    cg::grid_group grid = cg::this_grid();
    unsigned char* ws = args.ws;
    const float* x = args.in[0]; const float* rel = args.in[1];
    h16_t* HB = (h16_t*)(ws + WS_HB); h16_t* Qb = (h16_t*)(ws + WS_Q); h16_t* Kb = (h16_t*)(ws + WS_K); h16_t* Vb = (h16_t*)(ws + WS_V);
    h16_t* Zb = (h16_t*)(ws + WS_Z); h16_t* Gb = (h16_t*)(ws + WS_G); float* stats = (float*)(ws + WS_STATS); float* kpart = (float*)(ws + WS_KPART);
    float* logf = (float*)(ws + WS_LOGF); float* cum = (float*)(ws + WS_CUM); h16_t* WfT = (h16_t*)(ws + WS_WF); float* T = args.out;
    int ph = 0;
#define PHASE_BEGIN if (ph >= args.ph_lo && ph < args.ph_hi) { Ctx c; c.tid = threadIdx.x; asm volatile("" : "+v"(c.tid)); c.lane = c.tid & 63; c.wave = __builtin_amdgcn_readfirstlane(c.tid >> 6); c.G = gridDim.x; c.bid = blockIdx.x; c.lds = lds;
#define PHASE_END(dosync_) if ((dosync_) && ph + 1 < args.ph_hi) grid.sync(); } ++ph;

    PHASE_BEGIN
    {
        const int i_win[4] = {2, 11, 15, 20}, i_wout[4] = {8, 12, 17, 26};
#pragma unroll
        for (int l = 0; l < 4; ++l) {
            transpose_phase(c, args.in[i_win[l]], (l == 2) ? NPROJ + 16 : NPROJ, 0, NPROJ, (h16_t*)(ws + WS_WIN + (size_t)l * 32 * MiB));
            transpose_phase(c, args.in[i_wout[l]], D, 0, D, (h16_t*)(ws + WS_WOUT + (size_t)l * 8 * MiB));
        }
        transpose_phase(c, args.in[15], NPROJ + 16, NPROJ, 16, WfT);
        cvt_phase(c, x, HB, (size_t)M * D);
    }
    PHASE_END(true)

#pragma unroll 1
    for (int l = 0; l < 4; ++l) {
        const int i_g[4] = {9, 13, 18, 27}, i_b[4] = {10, 14, 19, 28};
        const h16_t* WinT = (const h16_t*)(ws + WS_WIN + (size_t)l * 32 * MiB); const h16_t* WoutT = (const h16_t*)(ws + WS_WOUT + (size_t)l * 8 * MiB);
        PHASE_BEGIN
        {
            if (l == 2) logf_phase(c, HB, WfT, args.in[16], logf);
            pg8::Gemm g{HB, WinT, M, NPROJ, D}; pg8::StaticOrder So; So.init(M, NPROJ, c.G, c.bid);
            EpiQKVZ Ep{Qb, Kb, Vb, Zb, l == 1 ? kpart : nullptr};
            pg8::gemm_phase<EpiQKVZ, pg8::StaticOrder, true, true>((LAS unsigned char*)lds, g, So, Ep, c.tid);
        }
        PHASE_END(true)
        PHASE_BEGIN
        if (l == 2) cum_phase(c, logf, cum);
        PHASE_END(l == 2)
        PHASE_BEGIN
        {
            AttnArgs A{Qb, Kb, Vb, Zb, Gb, rel, kpart, cum, nullptr, nullptr, nullptr, nullptr, nullptr, 0.f};
            if (l == 0 || l == 3) { const int base = (l == 0) ? 3 : 21; A.lq1 = args.in[base]; A.lk1 = args.in[base + 1]; A.lq2 = args.in[base + 2]; A.lk2 = args.in[base + 3]; A.subg = args.in[base + 4];
                A.lam_init = (l == 0) ? 0.2f : (0.8f - 0.6f * 0.40656965974059917f);
                attn_naive_phase<0>(c, A); }
            else if (l == 1) attn_naive_phase<1>(c, A);
            else attn_naive_phase<2>(c, A);
        }
        PHASE_END(true)
        PHASE_BEGIN
        {
            pg8::Gemm g{Gb, WoutT, M, D, E}; pg8::StaticOrder So; So.init(M, D, c.G, c.bid);
            EpiResid Ep{T, x, stats, l ? args.in[i_g[l - 1]] : nullptr, l ? args.in[i_b[l - 1]] : nullptr, l};
            pg8::gemm_phase<EpiResid, pg8::StaticOrder, false, true>((LAS unsigned char*)lds, g, So, Ep, c.tid);
        }
        PHASE_END(true)
        PHASE_BEGIN
        ln_phase(c, T, args.in[i_g[l]], args.in[i_b[l]], stats, HB, l == 3);
        PHASE_END(true)
    }
}

extern "C" void kernel_launch(void* const* d_in, const int* in_sizes, int n_in, void* d_out, int out_size, void* d_ws, size_t ws_size, hipStream_t stream) {
    static int grid = 0;
    if (grid == 0) {
        if (n_in != 29 || ws_size < WS_END || out_size != M * D) { fprintf(stderr, "kernel_launch: unexpected shapes n_in=%d ws=%zu out=%d\n", n_in, ws_size, out_size); grid = -1; return; }
        int dev = 0, cus = 0, per_cu = 0;
        (void)hipGetDevice(&dev); (void)hipDeviceGetAttribute(&cus, hipDeviceAttributeMultiprocessorCount, dev);
        if (hipFuncSetAttribute((const void*)mega_fwd, hipFuncAttributeMaxDynamicSharedMemorySize, LDS_BYTES) != hipSuccess) { fprintf(stderr, "kernel_launch: hipFuncSetAttribute failed\n"); grid = -1; return; }
        if (hipOccupancyMaxActiveBlocksPerMultiprocessor(&per_cu, (const void*)mega_fwd, NTHREADS, LDS_BYTES) != hipSuccess || per_cu < 1) { fprintf(stderr, "kernel_launch: occupancy query says %d\n", per_cu); per_cu = 1; }
        (void)hipGetLastError();
        grid = cus > 0 ? cus : 256;
    }
    if (grid < 0) return;
    Args a{};
    for (int i = 0; i < 29; ++i) a.in[i] = (const float*)d_in[i];
    a.out = (float*)d_out; a.ws = (unsigned char*)d_ws; a.ph_lo = 0; a.ph_hi = 1000;
    void* kargs[] = {&a};
    hipError_t e = hipLaunchCooperativeKernel((const void*)mega_fwd, dim3(grid), dim3(NTHREADS), kargs, LDS_BYTES, stream);
    if (e != hipSuccess) fprintf(stderr, "kernel_launch: cooperative launch failed: %s (grid %d)\n", hipGetErrorString(e), grid);
}
```

```cpp
#include <hip/hip_runtime.h>
#include <hip/hip_cooperative_groups.h>
#include <cstdint>
#include <cstdio>
namespace cg = cooperative_groups;

typedef unsigned short h16_t;
typedef float f32x4 __attribute__((ext_vector_type(4)));
typedef float f32x2 __attribute__((ext_vector_type(2)));
typedef unsigned u32x4 __attribute__((ext_vector_type(4)));
typedef _Float16 f16x8 __attribute__((ext_vector_type(8)));
typedef _Float16 f16x2 __attribute__((ext_vector_type(2)));
#define LAS __attribute__((address_space(3)))

constexpr int NB = 4, S = 2048, D = 2048, M = NB * S, E = 2048, NH = 16, HD = 128;
constexpr int NPROJ = 4 * E;
constexpr float SCALE = 0.08838834764831845f;
constexpr float LN_EPS = 1e-5f, RMS_EPS = 1e-5f;
constexpr float DN_ALPHA = 1.681792830507429f;
constexpr float NEGF = -1e30f;
constexpr int NTHREADS = 512, NWAVES = 8;
constexpr int LDS_BYTES = 147456;

constexpr size_t MiB = 1u << 20;
constexpr size_t WS_CTL = 0;
constexpr size_t WS_WIN = 1 * MiB;
constexpr size_t WS_WOUT = WS_WIN + 128 * MiB;
constexpr size_t WS_HB = WS_WOUT + 32 * MiB;
constexpr size_t WS_Q = WS_HB + 32 * MiB;
constexpr size_t WS_K = WS_Q + 32 * MiB;
constexpr size_t WS_V = WS_K + 32 * MiB;
constexpr size_t WS_Z = WS_V + 32 * MiB;
constexpr size_t WS_G = WS_Z + 32 * MiB;
constexpr size_t WS_SMALL = WS_G + 32 * MiB;
constexpr size_t WS_STATS = WS_SMALL;
constexpr size_t WS_KPART = WS_STATS + 64 * 1024;
constexpr size_t WS_LOGF = WS_KPART + 512 * 1024;
constexpr size_t WS_CUM = WS_LOGF + 512 * 1024;
constexpr size_t WS_WF = WS_CUM + 512 * 1024;
constexpr size_t WS_END = WS_WF + 64 * 1024;

__device__ __forceinline__ float h2f(h16_t v) { return (float)__builtin_bit_cast(_Float16, v); }
__device__ __forceinline__ h16_t f2h(float f) { return __builtin_bit_cast(h16_t, (_Float16)f); }
__device__ __forceinline__ float lo16(unsigned u) { return h2f((h16_t)(u & 0xffffu)); }
__device__ __forceinline__ float hi16(unsigned u) { return h2f((h16_t)(u >> 16)); }
__device__ __forceinline__ unsigned pk2(float lo, float hi) { f32x2 v = {lo, hi}; return __builtin_bit_cast(unsigned, __builtin_convertvector(v, f16x2)); }
__device__ __forceinline__ float siluf(float z) { return z / (1.f + __expf(-z)); }

__device__ __forceinline__ int t5_bucket(int d) {
    if (d < 16) return d;
    if (d >= 113) return 31;
    int b = 16;
    b += (d >= 19); b += (d >= 21); b += (d >= 24); b += (d >= 27); b += (d >= 31); b += (d >= 35); b += (d >= 40); b += (d >= 46);
    b += (d >= 52); b += (d >= 59); b += (d >= 67); b += (d >= 77); b += (d >= 87); b += (d >= 99);
    return b;
}

namespace pg8 {
constexpr int BM = 256, BK = 64, HALF = 128, HTB = HALF * BK * 2, STAGE_BYTES = 8 * HTB, NXCD = 8, WGM = 8;
__host__ __device__ __forceinline__ int lds_byte(int r, int c) { const int st = (r >> 4) * 2 + (c >> 5), rr = r & 15, cc = c & 31, ob = rr * 64 + cc * 2; return st * 1024 + (ob ^ (((ob >> 9) & 1) << 5)); }
__host__ __device__ __forceinline__ void stage_rc(int b, int& R, int& C) { const int st = b / 1024, sb = b % 1024, swz = sb ^ (((sb >> 9) & 1) << 5); R = (st >> 1) * 16 + swz / 64; C = (st & 1) * 32 + (swz % 64) / 2; }
__host__ __device__ __forceinline__ int perm32(int rho) { const int n = rho >> 4, i = rho & 15; return 8 * (i >> 2) + 4 * n + (i & 3); }
struct Unit { int pm, pn; };
struct Gemm { const h16_t* A; const h16_t* Bt; int M, N, K; };
struct StaticOrder {
    int nM, nN, nwg, G, c;
    __host__ __device__ void init(int M_, int N_, int G_, int c_) { nM = M_ / BM; nN = N_ / BM; nwg = nM * nN; G = G_; c = c_; }
    __host__ __device__ bool next(int i, Unit& u) const {
        const long L = (long)i * G + c; if (L >= nwg) return false;
        int wgid = (int)L; { const int q = nwg / NXCD, r = nwg % NXCD, xcd = wgid % NXCD, off = wgid / NXCD; wgid = (xcd < r ? xcd * (q + 1) : r * (q + 1) + (xcd - r) * q) + off; }
        const int nig = WGM * nN, gid = wgid / nig, fm = gid * WGM, gsz = (nM - fm) < WGM ? (nM - fm) : WGM;
        u.pm = fm + ((wgid % nig) % gsz); u.pn = (wgid % nig) / gsz; return true;
    }
    __device__ __forceinline__ void a_ready(const Unit&) const {}
    __device__ __forceinline__ void done(const Unit&) const {}
};

template <class Epi, class Sched, bool ALIGN_EPI = false, bool SP2 = false>
__device__ __forceinline__ void gemm_phase(LAS unsigned char* lds, const Gemm g, const Sched& S, const Epi& E, const int tid) {
    const int wid = __builtin_amdgcn_readfirstlane(tid >> 6), lane = tid & 63, wr = wid >> 2, wc = wid & 3, fr = lane & 15, fq = lane >> 4;
    const int K = g.K, nt = K / BK;
    unsigned voffA[2], voffB[2];
#pragma unroll
    for (int i = 0; i < 2; ++i) { int R, C; stage_rc(tid * 16 + i * 8192, R, C); const int Rb = Epi::PERM ? ((R & ~31) + perm32(R & 31)) : R;
        voffA[i] = (unsigned)(R * K + C) * 2u; voffB[i] = (unsigned)(Rb * K + C) * 2u; }
    const size_t kstep = (size_t)(BK * 2);
    const size_t hstep = (size_t)HALF * K * 2;
    const size_t tstep = 2 * hstep;
    const unsigned ldsw = (unsigned)wid * 1024u;
    const int aoff = lds_byte(wr * 64 + fr, fq * 8), boff = lds_byte(wc * 32 + fr, fq * 8);
#define PG8_SA(b, h) (((b) * 2 + (h)) * HTB)
#define PG8_SB(b, h) ((4 + (b) * 2 + (h)) * HTB)
#define PG8_STAGE(bufoff, gbase, voff) do { _Pragma("unroll") for (int _i = 0; _i < 2; ++_i) \
        __builtin_amdgcn_global_load_lds((const unsigned*)((const char*)(gbase) + (voff)[_i]), (LAS unsigned*)(lds + (bufoff) + ldsw + _i * 8192), 16, 0, 0); } while (0)
#define PG8_LDA(dst, b, h) do { _Pragma("unroll") for (int m = 0; m < 4; ++m) _Pragma("unroll") for (int k = 0; k < 2; ++k) dst[m][k] = *(const LAS f16x8*)(lds + PG8_SA(b, h) + aoff + m * 2048 + k * 1024); } while (0)
#define PG8_LDB(dst, b, h) do { _Pragma("unroll") for (int n = 0; n < 2; ++n) _Pragma("unroll") for (int k = 0; k < 2; ++k) dst[n][k] = *(const LAS f16x8*)(lds + PG8_SB(b, h) + boff + n * 2048 + k * 1024); } while (0)
#define PG8_MMA(ai, bj, At, Bt) do { __builtin_amdgcn_s_setprio(1); _Pragma("unroll") for (int m = 0; m < 4; ++m) _Pragma("unroll") for (int n = 0; n < 2; ++n) _Pragma("unroll") for (int k = 0; k < 2; ++k) \
        acc[ai][bj][m][n] = __builtin_amdgcn_mfma_f32_16x16x32_f16(Bt[n][k], At[m][k], acc[ai][bj][m][n], 0, 0, 0); __builtin_amdgcn_s_setprio(0); } while (0)
#define PG8_WAIT_V(n) asm volatile("s_waitcnt vmcnt(" #n ")" ::: "memory")
#define PG8_WAIT_L(n) asm volatile("s_waitcnt lgkmcnt(" #n ")" ::: "memory")
#define PG8_BAR __builtin_amdgcn_s_barrier()
#define PG8_SCHED __builtin_amdgcn_sched_barrier(0)
    Unit cur, nxt; int ui = 0;
    if (!S.next(0, cur)) return;
    f32x4 acc[2][2][4][2];
#pragma unroll
    for (int a = 0; a < 2; ++a)
#pragma unroll
        for (int b = 0; b < 2; ++b)
#pragma unroll
            for (int m = 0; m < 4; ++m)
#pragma unroll
                for (int n = 0; n < 2; ++n) acc[a][b][m][n] = (f32x4){0.f, 0.f, 0.f, 0.f};
    f16x8 At[4][2], B0[2][2], B1[2][2];
    const char* cA = (const char*)g.A + (size_t)cur.pm * tstep; const char* cB = (const char*)g.Bt + (size_t)cur.pn * tstep;
    S.a_ready(cur);
    if constexpr (SP2) {
        PG8_STAGE(PG8_SB(0, 0), cB, voffB); PG8_STAGE(PG8_SB(0, 1), cB + hstep, voffB); PG8_STAGE(PG8_SA(0, 0), cA, voffA); PG8_STAGE(PG8_SA(0, 1), cA + hstep, voffA);
        if (wr == 1) PG8_BAR;
        PG8_WAIT_V(2); PG8_BAR;
        PG8_STAGE(PG8_SB(1, 0), cB + kstep, voffB); PG8_STAGE(PG8_SA(1, 0), cA + kstep, voffA); PG8_STAGE(PG8_SB(1, 1), cB + hstep + kstep, voffB);
        PG8_WAIT_V(6); PG8_BAR;
    } else {
        PG8_STAGE(PG8_SB(0, 0), cB, voffB); PG8_STAGE(PG8_SA(0, 0), cA, voffA); PG8_STAGE(PG8_SB(0, 1), cB + hstep, voffB); PG8_STAGE(PG8_SA(0, 1), cA + hstep, voffA);
        if (wr == 1) PG8_BAR;
        PG8_WAIT_V(4); PG8_BAR;
        PG8_STAGE(PG8_SB(1, 0), cB + kstep, voffB); PG8_STAGE(PG8_SA(1, 0), cA + kstep, voffA); PG8_STAGE(PG8_SB(1, 1), cB + hstep + kstep, voffB);
        PG8_WAIT_V(6); PG8_BAR;
    }
    for (;;) {
        const bool has_next = S.next(ui + 1, nxt);
        const char* nA = has_next ? (const char*)g.A + (size_t)nxt.pm * tstep : cA; const char* nB = has_next ? (const char*)g.Bt + (size_t)nxt.pn * tstep : cB;
        for (int t = 0; t < nt; t += 2) {
            const bool last = (t == nt - 2);
            const char* a1 = cA + (size_t)(t + 1) * kstep;
            const char* a2 = last ? nA : cA + (size_t)(t + 2) * kstep; const char* b2 = last ? nB : cB + (size_t)(t + 2) * kstep;
            const char* a3 = a2 + kstep; const char* b3 = b2 + kstep;
            if (last && has_next) S.a_ready(nxt);
            if constexpr (SP2) {
            PG8_LDB(B0, 0, 0); PG8_LDB(B1, 0, 1); PG8_SCHED; PG8_LDA(At, 0, 0); PG8_STAGE(PG8_SA(1, 1), a1 + hstep, voffA);
            PG8_WAIT_V(8); PG8_WAIT_L(0); PG8_BAR; PG8_MMA(0, 0, At, B0); PG8_MMA(0, 1, At, B1); PG8_BAR; PG8_SCHED;
            PG8_LDA(At, 0, 1); PG8_STAGE(PG8_SB(0, 0), b2, voffB); PG8_STAGE(PG8_SB(0, 1), b2 + hstep, voffB); PG8_STAGE(PG8_SA(0, 0), a2, voffA);
            PG8_WAIT_V(8); PG8_WAIT_L(0); PG8_BAR; PG8_MMA(1, 0, At, B0); PG8_MMA(1, 1, At, B1); PG8_BAR; PG8_SCHED;
            PG8_LDB(B0, 1, 0); PG8_LDB(B1, 1, 1); PG8_SCHED; PG8_LDA(At, 1, 0); PG8_STAGE(PG8_SA(0, 1), a2 + hstep, voffA);
            PG8_WAIT_V(8); PG8_WAIT_L(0); PG8_BAR; PG8_MMA(0, 0, At, B0); PG8_MMA(0, 1, At, B1); PG8_BAR; PG8_SCHED;
            PG8_LDA(At, 1, 1); PG8_STAGE(PG8_SB(1, 0), b3, voffB); PG8_STAGE(PG8_SB(1, 1), b3 + hstep, voffB); PG8_STAGE(PG8_SA(1, 0), a3, voffA);
            PG8_WAIT_V(8); PG8_WAIT_L(0); PG8_BAR; PG8_MMA(1, 0, At, B0); PG8_MMA(1, 1, At, B1); PG8_BAR; PG8_SCHED;
            } else {
            PG8_LDB(B0, 0, 0); PG8_SCHED; PG8_LDA(At, 0, 0); PG8_STAGE(PG8_SA(1, 1), a1 + hstep, voffA);
            PG8_WAIT_L(8); PG8_BAR; PG8_WAIT_L(0); PG8_MMA(0, 0, At, B0); PG8_BAR; PG8_SCHED;
            PG8_LDB(B1, 0, 1); PG8_STAGE(PG8_SB(0, 0), b2, voffB);
            PG8_BAR; PG8_WAIT_L(0); PG8_MMA(0, 1, At, B1); PG8_BAR;
            PG8_LDA(At, 0, 1); PG8_STAGE(PG8_SA(0, 0), a2, voffA);
            PG8_BAR; PG8_WAIT_L(0); PG8_MMA(1, 0, At, B0); PG8_BAR; PG8_SCHED;
            PG8_STAGE(PG8_SB(0, 1), b2 + hstep, voffB);
            PG8_WAIT_V(6); PG8_BAR; PG8_MMA(1, 1, At, B1); PG8_BAR;
            PG8_LDB(B0, 1, 0); PG8_SCHED; PG8_LDA(At, 1, 0); PG8_STAGE(PG8_SA(0, 1), a2 + hstep, voffA);
            PG8_WAIT_L(8); PG8_BAR; PG8_WAIT_L(0); PG8_MMA(0, 0, At, B0); PG8_BAR; PG8_SCHED;
            PG8_LDB(B1, 1, 1); PG8_STAGE(PG8_SB(1, 0), b3, voffB);
            PG8_BAR; PG8_WAIT_L(0); PG8_MMA(0, 1, At, B1); PG8_BAR;
            PG8_LDA(At, 1, 1); PG8_STAGE(PG8_SA(1, 0), a3, voffA);
            PG8_BAR; PG8_WAIT_L(0); PG8_MMA(1, 0, At, B0); PG8_BAR; PG8_SCHED;
            PG8_STAGE(PG8_SB(1, 1), b3 + hstep, voffB);
            PG8_WAIT_V(6); PG8_BAR; PG8_MMA(1, 1, At, B1); PG8_BAR;
            }
        }
        if constexpr (ALIGN_EPI) { if (wr == 0) PG8_BAR; }
        E(acc, cur, wr, wc, fr, fq); S.done(cur);
        if (!has_next) break;
#pragma unroll
        for (int a = 0; a < 2; ++a)
#pragma unroll
            for (int b = 0; b < 2; ++b)
#pragma unroll
                for (int m = 0; m < 4; ++m)
#pragma unroll
                    for (int n = 0; n < 2; ++n) acc[a][b][m][n] = (f32x4){0.f, 0.f, 0.f, 0.f};
        cur = nxt; cA = nA; cB = nB; ++ui;
        if constexpr (ALIGN_EPI) { if (wr == 1) PG8_BAR; }
    }
    PG8_WAIT_V(0);
    if constexpr (!ALIGN_EPI) { if (wr == 0) PG8_BAR; }
    PG8_BAR;
#undef PG8_SA
#undef PG8_SB
#undef PG8_STAGE
#undef PG8_LDA
#undef PG8_LDB
#undef PG8_MMA
#undef PG8_WAIT_V
#undef PG8_WAIT_L
#undef PG8_BAR
#undef PG8_SCHED
}
}

struct EpiQKVZ {
    static constexpr bool PERM = true;
    h16_t *Q, *K, *V, *Z; float* kpart;
    __device__ __forceinline__ void operator()(const f32x4 (&acc)[2][2][4][2], const pg8::Unit& u, int wr, int wc, int fr, int fq) const {
        const int colt = u.pn * 256, sec = colt >> 11, cbase = colt & 2047;
        const int row0 = u.pm * 256 + wr * 64 + fr;
        h16_t* dst = sec == 0 ? Q : (sec == 1 ? K : (sec == 2 ? V : Z));
#pragma unroll
        for (int ai = 0; ai < 2; ++ai)
#pragma unroll
            for (int m = 0; m < 4; ++m) { const int r = row0 + ai * 128 + m * 16, b = r >> 11, s = r & 2047;
#pragma unroll
                for (int bj = 0; bj < 2; ++bj) { const f32x4 v0 = acc[ai][bj][m][0], v1 = acc[ai][bj][m][1];
                    u32x4 w; w.x = pk2(v0[0], v0[1]); w.y = pk2(v0[2], v0[3]); w.z = pk2(v1[0], v1[1]); w.w = pk2(v1[2], v1[3]);
                    const int c = cbase + bj * 128 + wc * 32 + 8 * fq;
                    h16_t* p = (sec == 3) ? dst + (size_t)r * E + c : dst + ((size_t)(b * NH + (c >> 7)) * S + s) * HD + (c & 127);
                    *(u32x4*)p = w; } }
        if (kpart != nullptr && sec == 1) {
            const int b = u.pm >> 3, nblk = u.pm & 7;
#pragma unroll
            for (int bj = 0; bj < 2; ++bj) { f32x4 s0 = {0.f, 0.f, 0.f, 0.f}, s1 = {0.f, 0.f, 0.f, 0.f};
#pragma unroll
                for (int ai = 0; ai < 2; ++ai)
#pragma unroll
                    for (int m = 0; m < 4; ++m) { s0 += acc[ai][bj][m][0]; s1 += acc[ai][bj][m][1]; }
#pragma unroll
                for (int o = 1; o < 16; o <<= 1)
#pragma unroll
                    for (int e = 0; e < 4; ++e) { s0[e] += __shfl_xor(s0[e], o); s1[e] += __shfl_xor(s1[e], o); }
                if (fr == 0) { const int c = cbase + bj * 128 + wc * 32 + 8 * fq;
                    float* p = kpart + (size_t)wr * NB * NH * 8 * HD + ((size_t)(b * NH + (c >> 7)) * 8 + nblk) * HD + (c & 127);
                    *(f32x4*)p = s0; *(f32x4*)(p + 4) = s1; } }
        }
    }
};
struct EpiResid {
    static constexpr bool PERM = false;
    float* T; const float* x; const float* stats; const float* g; const float* bta; int layer;
    __device__ __forceinline__ void operator()(const f32x4 (&acc)[2][2][4][2], const pg8::Unit& u, int wr, int wc, int fr, int fq) const {
        const int col0 = u.pn * 256 + wc * 32 + 4 * fq, row0 = u.pm * 256 + wr * 64 + fr;
        f32x4 gv[2][2], bv[2][2];
        if (layer) {
#pragma unroll
            for (int bj = 0; bj < 2; ++bj)
#pragma unroll
                for (int n = 0; n < 2; ++n) { gv[bj][n] = *(const f32x4*)(g + col0 + bj * 128 + n * 16); bv[bj][n] = *(const f32x4*)(bta + col0 + bj * 128 + n * 16); } }
#pragma unroll
        for (int ai = 0; ai < 2; ++ai)
#pragma unroll
            for (int m = 0; m < 4; ++m) { const int r = row0 + ai * 128 + m * 16; float mean = 0.f, rstd = 1.f;
                if (layer) { const f32x2 st = *(const f32x2*)(stats + 2 * r); mean = st.x; rstd = st.y; }
#pragma unroll
                for (int bj = 0; bj < 2; ++bj)
#pragma unroll
                    for (int n = 0; n < 2; ++n) { const size_t idx = (size_t)r * D + col0 + bj * 128 + n * 16; f32x4 h;
                        if (layer) h = (*(const f32x4*)(T + idx) - mean) * rstd * gv[bj][n] + bv[bj][n]; else h = *(const f32x4*)(x + idx);
                        *(f32x4*)(T + idx) = DN_ALPHA * h + acc[ai][bj][m][n]; }
                asm volatile("" ::: "memory"); }
    }
};

struct Ctx { int tid, lane, wave, G, bid; unsigned char* lds; };

__device__ __forceinline__ void transpose_phase(const Ctx& c, const float* __restrict__ W, int ldw, int c0, int ncols, h16_t* __restrict__ WT) {
    float (*tile)[65] = (float (*)[65])(c.lds + (c.tid >> 8) * (64 * 65 * 4));
    const int nb = (ncols + 63) / 64, ntiles = (D / 64) * nb, t2 = c.tid & 255, tx = t2 & 63, ty = t2 >> 6;
    for (int it = c.bid * 2; it < ntiles; it += c.G * 2) {
        const int tl = it + (c.tid >> 8); const bool act = tl < ntiles;
        const int kb = tl / nb, cb = tl % nb, k0 = kb * 64, n0 = cb * 64;
        if (act) for (int i = ty; i < 64; i += 4) { const int n = n0 + tx; tile[i][tx] = (n < ncols) ? W[(size_t)(k0 + i) * ldw + c0 + n] : 0.f; }
        __syncthreads();
        if (act) for (int i = ty; i < 64; i += 4) { const int n = n0 + i; if (n < ncols) WT[(size_t)n * D + k0 + tx] = f2h(tile[tx][i]); }
        __syncthreads();
    }
}
__device__ __forceinline__ void cvt_phase(const Ctx& c, const float* __restrict__ x, h16_t* __restrict__ o, size_t n) {
    for (size_t i = ((size_t)c.bid * NTHREADS + c.tid) * 4; i < n; i += (size_t)c.G * NTHREADS * 4) { const f32x4 v = *(const f32x4*)(x + i); *(uint2*)(o + i) = make_uint2(pk2(v.x, v.y), pk2(v.z, v.w)); }
}
__device__ __forceinline__ float wave_sum(float v) {
#pragma unroll
    for (int o = 1; o < 64; o <<= 1) v += __shfl_xor(v, o);
    return v;
}
__device__ __forceinline__ void ln_phase(const Ctx& c, float* T, const float* __restrict__ g, const float* __restrict__ bta, float* stats, h16_t* HB, bool final_layer) {
    const int gw = c.bid * NWAVES + c.wave, NGW = c.G * NWAVES;
    for (int m = gw; m < M; m += NGW) {
        float* row = T + (size_t)m * D; f32x4 v[8]; float s = 0.f;
#pragma unroll
        for (int j = 0; j < 8; ++j) { v[j] = *(const f32x4*)(row + (64 * j + c.lane) * 4); s += (v[j].x + v[j].y) + (v[j].z + v[j].w); }
        const float mean = wave_sum(s) * (1.f / D); float q = 0.f;
#pragma unroll
        for (int j = 0; j < 8; ++j) { v[j] = v[j] - mean; q += (v[j].x * v[j].x + v[j].y * v[j].y) + (v[j].z * v[j].z + v[j].w * v[j].w); }
        const float rstd = rsqrtf(wave_sum(q) * (1.f / D) + LN_EPS);
        if (c.lane == 0) { stats[2 * m] = mean; stats[2 * m + 1] = rstd; }
#pragma unroll
        for (int j = 0; j < 8; ++j) { const int col = (64 * j + c.lane) * 4; const f32x4 o = v[j] * rstd * *(const f32x4*)(g + col) + *(const f32x4*)(bta + col);
            if (final_layer) *(f32x4*)(row + col) = o; else *(uint2*)(HB + (size_t)m * D + col) = make_uint2(pk2(o.x, o.y), pk2(o.z, o.w)); }
    }
}
__device__ __forceinline__ void logf_phase(const Ctx& c, const h16_t* __restrict__ HB, const h16_t* __restrict__ WfT, const float* __restrict__ bf, float* logf) {
    for (int rb = c.bid; rb < M / 32; rb += c.G) {
        const int m = rb * 32 + (c.tid >> 4), j = c.tid & 15;
        const h16_t* a = HB + (size_t)m * D; const h16_t* w = WfT + (size_t)j * D; float s = 0.f;
        for (int k = 0; k < D; k += 8) { const u32x4 av = *(const u32x4*)(a + k), wv = *(const u32x4*)(w + k);
#pragma unroll
            for (int e = 0; e < 4; ++e) { s = fmaf(lo16(av[e]), lo16(wv[e]), s); s = fmaf(hi16(av[e]), hi16(wv[e]), s); } }
        const float xx = s + bf[j];
        logf[(size_t)m * 16 + j] = fminf(xx, 0.f) - log1pf(__expf(-fabsf(xx)));
    }
}
__device__ __forceinline__ void cum_phase(const Ctx& c, const float* __restrict__ logf, float* cum) {
    float* wtot = (float*)c.lds;
    for (int bh = c.bid; bh < NB * NH; bh += c.G) {
        const int b = bh / NH, h = bh % NH; float v[4];
#pragma unroll
        for (int e = 0; e < 4; ++e) v[e] = logf[(size_t)(b * S + 4 * c.tid + e) * NH + h];
        v[1] += v[0]; v[2] += v[1]; v[3] += v[2];
        float incl = v[3];
#pragma unroll
        for (int o = 1; o < 64; o <<= 1) { const float t = __shfl_up(incl, o); if (c.lane >= o) incl += t; }
        if (c.lane == 63) wtot[c.wave] = incl;
        __syncthreads();
        float off = incl - v[3];
        for (int w = 0; w < c.wave; ++w) off += wtot[w];
        f32x4 o4 = {v[0] + off, v[1] + off, v[2] + off, v[3] + off};
        *(f32x4*)(cum + (size_t)bh * S + 4 * c.tid) = o4;
        __syncthreads();
    }
}

#ifndef FAST0
#define FAST0 1
#endif
#ifndef FAST1
#define FAST1 1
#endif
#ifndef FAST2
#define FAST2 1
#endif
constexpr int SC_LD = 2064;
struct AttnArgs { const h16_t *Qb, *Kb, *Vb, *Zb; h16_t* G; const float *rel, *kpart, *cum, *logf, *lq1, *lk1, *lq2, *lk2, *subg; float lam_init; };
template <int MODE>
__device__ __forceinline__ void attn_naive_phase(const Ctx& c, const AttnArgs& A) {
    float* sc = (float*)c.lds; float* qs = sc + 16 * SC_LD; float* misc = qs + 16 * 128;
    const int tid = c.tid; const bool act = tid < 256; const int row = (tid >> 4) & 15, sub = tid & 15;
    constexpr int QPB = MODE == 0 ? 8 : 16, NHB = MODE == 0 ? 8 : 16;
    const int nqt = S / QPB, nvb = NB * NHB * nqt;
    for (int vb = c.bid; vb < nvb; vb += c.G) {
        const int qt = vb % nqt, hh = (vb / nqt) % NHB, b = vb / (nqt * NHB);
        const int t0 = qt * QPB, nkeys = t0 + QPB;
        const int qi = MODE == 0 ? (row & 7) : row, comp = MODE == 0 ? (row >> 3) : 0;
        const int hq = MODE == 0 ? 2 * hh + comp : hh;
        const int t = t0 + qi;
        if (act) for (int i = tid; i < 16 * 128; i += 256) { const int r = i >> 7, d = i & 127; const int rq = MODE == 0 ? (r & 7) : r, rh = MODE == 0 ? 2 * hh + (r >> 3) : hh;
            qs[i] = h2f(A.Qb[((size_t)(b * NH + rh) * S + t0 + rq) * HD + d]); }
        float lam = 0.f;
        if (MODE == 0) { if (tid < 64) { float a = A.lq1[tid] * A.lk1[tid] + A.lq1[tid + 64] * A.lk1[tid + 64], cc = A.lq2[tid] * A.lk2[tid] + A.lq2[tid + 64] * A.lk2[tid + 64];
                for (int o = 32; o; o >>= 1) { a += __shfl_xor(a, o); cc += __shfl_xor(cc, o); }
                if (tid == 0) misc[0] = __expf(a) - __expf(cc) + A.lam_init; } }
        __syncthreads();
        if (MODE == 0) lam = misc[0];
        unsigned selbits = 0u; const int own = t0 >> 8;
        if (MODE == 1) {
            if (tid < 16) { float gate[8]; unsigned sb = 0u;
#pragma unroll
                for (int n = 0; n < 8; ++n) { float gsum = 0.f;
                    if (n < own) { const float* k0 = A.kpart + (size_t)((b * NH + hh) * 8 + n) * HD; const float* k1 = k0 + (size_t)NB * NH * 8 * HD;
                        for (int d = 0; d < 128; ++d) gsum = fmaf(qs[tid * 128 + d], (k0[d] + k1[d]) * (1.f / 256.f), gsum); }
                    gate[n] = n < own ? gsum : NEGF; }
#pragma unroll
                for (int k = 0; k < 3; ++k) { int best = -1; float bv = 0.f;
#pragma unroll
                    for (int n = 0; n < 8; ++n) if (!((sb >> n) & 1u) && (best < 0 || gate[n] > bv)) { best = n; bv = gate[n]; }
                    sb |= 1u << best; }
                misc[16 + tid] = __uint_as_float(sb & ((1u << own) - 1u)); }
            __syncthreads();
            selbits = __float_as_uint(misc[16 + row]);
        }
        if (act) {
            const float cq = MODE == 2 ? A.cum[(size_t)(b * NH + hh) * S + t] : 0.f;
            for (int s = sub; s < nkeys; s += 16) {
                const h16_t* kr = A.Kb + ((size_t)(b * NH + hq) * S + s) * HD; float dot = 0.f;
                for (int d = 0; d < 128; d += 8) { const u32x4 kv = *(const u32x4*)(kr + d); const float* qq = qs + row * 128 + d;
#pragma unroll
                    for (int j = 0; j < 4; ++j) { dot = fmaf(qq[2 * j], lo16(kv[j]), dot); dot = fmaf(qq[2 * j + 1], hi16(kv[j]), dot); } }
                float lg = dot * SCALE; bool ok = s <= t;
                if (MODE == 0 || MODE == 1) lg += A.rel[t5_bucket(t - s > 0 ? t - s : 0) * 16 + hq];
                if (MODE == 1) { const int blk = s >> 8; if (blk != own) ok = (selbits >> blk) & 1u; }
                if (MODE == 2) lg += cq - A.cum[(size_t)(b * NH + hh) * S + s];
                sc[row * SC_LD + s] = ok ? lg : NEGF;
            }
        }
        __syncthreads();
        if (act) {
            float mx = NEGF;
            for (int s = sub; s < nkeys; s += 16) mx = fmaxf(mx, sc[row * SC_LD + s]);
            for (int o = 8; o; o >>= 1) mx = fmaxf(mx, __shfl_xor(mx, o));
            float sum = 0.f;
            for (int s = sub; s < nkeys; s += 16) { const float p = __expf(sc[row * SC_LD + s] - mx); sc[row * SC_LD + s] = p; sum += p; }
            for (int o = 8; o; o >>= 1) sum += __shfl_xor(sum, o);
            const float inv = 1.f / sum;
            for (int s = sub; s < nkeys; s += 16) sc[row * SC_LD + s] *= inv;
        }
        __syncthreads();
        if (act) {
            if (MODE == 0) {
                const int q2 = tid >> 5, dl = tid & 31, d0 = dl * 8;
                const int vh = 2 * hh + (d0 >> 7), dd = d0 & 127;
                float o[8];
#pragma unroll
                for (int j = 0; j < 8; ++j) o[j] = 0.f;
                for (int s = 0; s < nkeys; ++s) { const float a = sc[q2 * SC_LD + s] - lam * sc[(8 + q2) * SC_LD + s];
                    const u32x4 vv = *(const u32x4*)(A.Vb + ((size_t)(b * NH + vh) * S + s) * HD + dd);
#pragma unroll
                    for (int j = 0; j < 4; ++j) { o[2 * j] = fmaf(a, lo16(vv[j]), o[2 * j]); o[2 * j + 1] = fmaf(a, hi16(vv[j]), o[2 * j + 1]); } }
                float ss = 0.f;
#pragma unroll
                for (int j = 0; j < 8; ++j) ss += o[j] * o[j];
                for (int off = 16; off; off >>= 1) ss += __shfl_xor(ss, off);
                const float r = rsqrtf(ss * (1.f / 256.f) + RMS_EPS) * (1.f - A.lam_init);
                const size_t gi = (size_t)(b * S + t0 + q2) * E + hh * 256 + d0;
                const u32x4 zv = *(const u32x4*)(A.Zb + gi); u32x4 ov;
#pragma unroll
                for (int j = 0; j < 4; ++j) { const float a0 = o[2 * j] * r * A.subg[d0 + 2 * j] * siluf(lo16(zv[j])), a1 = o[2 * j + 1] * r * A.subg[d0 + 2 * j + 1] * siluf(hi16(zv[j]));
                    ov[j] = pk2(a0, a1); }
                *(u32x4*)(A.G + gi) = ov;
            } else {
                const int d0 = sub * 8; float o[8];
#pragma unroll
                for (int j = 0; j < 8; ++j) o[j] = 0.f;
                for (int s = 0; s < nkeys; ++s) { const float a = sc[row * SC_LD + s];
                    const u32x4 vv = *(const u32x4*)(A.Vb + ((size_t)(b * NH + hh) * S + s) * HD + d0);
#pragma unroll
                    for (int j = 0; j < 4; ++j) { o[2 * j] = fmaf(a, lo16(vv[j]), o[2 * j]); o[2 * j + 1] = fmaf(a, hi16(vv[j]), o[2 * j + 1]); } }
                const size_t gi = (size_t)(b * S + t) * E + hh * 128 + d0;
                const u32x4 zv = *(const u32x4*)(A.Zb + gi); u32x4 ov;
#pragma unroll
                for (int j = 0; j < 4; ++j) ov[j] = pk2(o[2 * j] * siluf(lo16(zv[j])), o[2 * j + 1] * siluf(hi16(zv[j])));
                *(u32x4*)(A.G + gi) = ov;
            }
        }
        __syncthreads();
    }
}

namespace att {
typedef short s16x4 __attribute__((ext_vector_type(4)));
typedef float f32x16 __attribute__((ext_vector_type(16)));
constexpr int QBLK = 32, KVBLK = 64, SHM = KVBLK * HD * 2;
constexpr float THR = 8.f;
constexpr int L_V = 0, L_K = 2 * SHM;
#define KSWZ(row, colB) ((row) * 256 + ((colB) ^ (((row) & 7) << 4)))
#define SBAR() __builtin_amdgcn_sched_barrier(0)
__device__ __forceinline__ int v_st(int k, int c) { const int kk = (k & ~0xC) | ((k & 4) << 1) | ((k & 8) >> 1); return ((kk >> 3) * 4 + (c >> 5)) * 512 + ((kk & 7) * 32 + (c & 31)) * 2; }
__device__ __forceinline__ int v_rd_base(int lane) { return ((lane & 3) << 3) | (((lane >> 2) & 3) << 6) | (((lane >> 4) & 1) << 5) | (((lane >> 5) & 1) << 8); }
constexpr int v_rd_off(int d0, int ks, int half) { return d0 * 512 + ks * 4096 + half * 2048; }
__device__ __forceinline__ int crow(int r, int hi) { return (r & 3) + 8 * (r >> 2) + 4 * hi; }
__device__ __forceinline__ f16x8 ld8(const h16_t* p) { return *reinterpret_cast<const f16x8*>(p); }

template <int NCOMP> struct Lay {
    static constexpr int WS = L_K + 2 * NCOMP * SHM;
    static constexpr int OST = WS + NWAVES * 512;
    static constexpr int TAB = OST + (NCOMP == 1 ? 8 : 4) * 8192;
    static constexpr int MISC = TAB, LUT = TAB + 256, BIG = LUT + 2 * 352 * 4, END = BIG + 8192;
};
static_assert(Lay<1>::END <= LDS_BYTES && Lay<2>::END <= LDS_BYTES, "attention LDS map");

__device__ __forceinline__ void mask_tile(f32x16& p0, f32x16& p1, int dq) {
    const float NEG = -__builtin_inff();
#pragma unroll
    for (int r = 0; r < 16; ++r) { const int cc = (r & 3) + 8 * (r >> 2); if (dq - cc < 0) p0[r] = NEG; if (dq - cc - 32 < 0) p1[r] = NEG; }
}
__device__ __forceinline__ void bias_mask_tile(f32x16& p0, f32x16& p1, int dq, const float* lut) {
    const float NEG = -__builtin_inff(); const float* lp = lut + (dq + 128 - 63);
    float b0[16], b1[16];
#pragma unroll
    for (int r = 0; r < 16; ++r) { const int cc = (r & 3) + 8 * (r >> 2); b0[r] = lp[63 - cc]; b1[r] = lp[63 - cc - 32]; }
#pragma unroll
    for (int r = 0; r < 16; ++r) { const int cc = (r & 3) + 8 * (r >> 2); p0[r] = (dq - cc < 0) ? NEG : p0[r] + b0[r]; p1[r] = (dq - cc - 32 < 0) ? NEG : p1[r] + b1[r]; }
}
__device__ __forceinline__ void partialSM(f32x16& p0, f32x16& p1, float& m_reg, float& mn, float& alpha) {
    float pmax = p0[0];
#pragma unroll
    for (int r = 1; r < 16; ++r) pmax = fmaxf(pmax, p0[r]);
#pragma unroll
    for (int r = 0; r < 16; ++r) pmax = fmaxf(pmax, p1[r]);
    { auto rr = __builtin_amdgcn_permlane32_swap(__float_as_uint(pmax), __float_as_uint(pmax), false, false);
      pmax = fmaxf(__uint_as_float(rr[0]), __uint_as_float(rr[1])); }
    constexpr float C2 = 1.4426950408889634f * SCALE;
    if (__builtin_expect(__all((pmax - m_reg) * SCALE <= THR), 1)) { mn = m_reg; alpha = 1.f; }
    else { mn = fmaxf(m_reg, pmax); alpha = __builtin_amdgcn_exp2f((m_reg - mn) * C2); m_reg = mn; }
    const float mnL = -mn * C2;
#pragma unroll
    for (int r = 0; r < 16; ++r) p0[r] = fmaf(p0[r], C2, mnL);
#pragma unroll
    for (int r = 0; r < 16; ++r) p1[r] = fmaf(p1[r], C2, mnL);
#pragma unroll
    for (int r = 0; r < 16; ++r) p0[r] = __builtin_amdgcn_exp2f(p0[r]);
}
__device__ __forceinline__ void finishSM(f32x16& p0, f32x16& p1, float alpha, float& l_reg, f16x8& pa0, f16x8& pa1, f16x8& pa2, f16x8& pa3) {
#pragma unroll
    for (int r = 0; r < 16; ++r) p1[r] = __builtin_amdgcn_exp2f(p1[r]);
    float ps = 0;
#pragma unroll
    for (int r = 0; r < 16; ++r) ps += p0[r];
#pragma unroll
    for (int r = 0; r < 16; ++r) ps += p1[r];
    { auto rr = __builtin_amdgcn_permlane32_swap(__float_as_uint(ps), __float_as_uint(ps), false, false);
      ps = __uint_as_float(rr[0]) + __uint_as_float(rr[1]); }
    l_reg = l_reg * alpha + ps;
#define PK4(P, B_, OUT) do { unsigned a0 = pk2(P[B_+0], P[B_+1]), a1 = pk2(P[B_+2], P[B_+3]);                          \
        unsigned b0 = pk2(P[B_+4], P[B_+5]), b1 = pk2(P[B_+6], P[B_+7]);                                             \
        auto r0 = __builtin_amdgcn_permlane32_swap(a0, b0, false, false); auto r1 = __builtin_amdgcn_permlane32_swap(a1, b1, false, false); \
        u32x4 w = {r0[0], r1[0], r0[1], r1[1]}; OUT = __builtin_bit_cast(f16x8, w); } while (0)
    PK4(p0, 0, pa0); PK4(p0, 8, pa1); PK4(p1, 0, pa2); PK4(p1, 8, pa3);
#undef PK4
}
template <int KB, int NCOMP>
__device__ __forceinline__ void qkt(f32x16& p0, f32x16& p1, const char* Kc_lds, int r32, int hi, const f16x8* qr) {
    const char* kb[4];
#pragma unroll
    for (int dd = 0; dd < 4; ++dd) kb[dd] = Kc_lds + KB * (NCOMP * SHM) + KSWZ(r32, (dd * 16 + hi * 8) * 2);
#pragma unroll
    for (int d0 = 0; d0 < 8; ++d0) { const char* a = kb[d0 & 3] + (d0 >> 2) * 128;
        const f16x8 b0 = *reinterpret_cast<const f16x8*>(a);
        const f16x8 b1 = *reinterpret_cast<const f16x8*>(a + 32 * 256);
        p0 = __builtin_amdgcn_mfma_f32_32x32x16_f16(b0, qr[d0], p0, 0, 0, 0);
        p1 = __builtin_amdgcn_mfma_f32_32x32x16_f16(b1, qr[d0], p1, 0, 0, 0); }
}
template <int VB>
__device__ __forceinline__ void pv_tile(f32x16* o, int vb0, f16x8 pa0, f16x8 pa1, f16x8 pa2, f16x8 pa3) {
#define TRRD(dst, off) asm volatile("ds_read_b64_tr_b16 %0, %1 offset:%2" : "=&v"(dst) : "v"(vb0), "i"(off) : "memory")
#define PKV(l, h) __builtin_bit_cast(f16x8, (short __attribute__((ext_vector_type(8)))){l[0], l[1], l[2], l[3], h[0], h[1], h[2], h[3]})
#define PV_D0(d0) do { s16x4 l0, l1, l2, l3, h0, h1, h2, h3; constexpr int b_ = L_V + VB * SHM + v_rd_off(d0, 0, 0); \
        TRRD(l0, b_); TRRD(h0, b_ + 2048); TRRD(l1, b_ + 4096); TRRD(h1, b_ + 6144); TRRD(l2, b_ + 8192); TRRD(h2, b_ + 10240); TRRD(l3, b_ + 12288); TRRD(h3, b_ + 14336); \
        asm volatile("s_waitcnt lgkmcnt(0)" ::: "memory"); SBAR();   \
        o[d0] = __builtin_amdgcn_mfma_f32_32x32x16_f16(pa0, PKV(l0, h0), o[d0], 0, 0, 0);   \
        o[d0] = __builtin_amdgcn_mfma_f32_32x32x16_f16(pa1, PKV(l1, h1), o[d0], 0, 0, 0);   \
        o[d0] = __builtin_amdgcn_mfma_f32_32x32x16_f16(pa2, PKV(l2, h2), o[d0], 0, 0, 0);   \
        o[d0] = __builtin_amdgcn_mfma_f32_32x32x16_f16(pa3, PKV(l3, h3), o[d0], 0, 0, 0); } while (0)
    PV_D0(0); PV_D0(1); PV_D0(2); PV_D0(3);
#undef PV_D0
#undef PKV
#undef TRRD
}

struct BlockRef { unsigned qoff, koff, voff; int P0; int b, h, half, x; };
template <int NCOMP> struct Seam { f16x8 qr[8]; f16x8 st[2 * NCOMP]; };
struct BlkCtx { unsigned selbits; int own; };
struct EpiArgs { const h16_t* Zb; h16_t* G; const float* subg; float lam_init; };

constexpr size_t HSTR = (size_t)S * HD;
#define ROW(p, k0, rr) ((p) + (size_t)((k0) + (rr)) * HD + sc)
#define VMW() asm volatile("s_waitcnt vmcnt(0)" ::: "memory")
#define VMWN(n) asm volatile("s_waitcnt vmcnt(%0)" :: "i"(n) : "memory")

__device__ __forceinline__ f16x8 ldg8(const void* ubase, unsigned off) { return *reinterpret_cast<const f16x8*>((const char*)ubase + off); }
template <int NCOMP>
__device__ __forceinline__ void sload_k(Seam<NCOMP>& S_, const h16_t* Kp, int k0, unsigned loff) {
    const char* kb_ = (const char*)Kp + (size_t)k0 * (HD * 2);
#pragma unroll
    for (int cc = 0; cc < NCOMP; ++cc) { S_.st[2 * cc] = ldg8(kb_ + cc * (HSTR * 2), loff); S_.st[2 * cc + 1] = ldg8(kb_ + cc * (HSTR * 2) + 32 * HD * 2, loff); }
}
template <int NCOMP>
__device__ __forceinline__ void sload_v(Seam<NCOMP>& S_, const h16_t* Vp, int k0, unsigned loff) {
    const char* vb_ = (const char*)Vp + (size_t)k0 * (HD * 2);
    S_.st[0] = ldg8(vb_, loff); S_.st[1] = ldg8(vb_ + 32 * HD * 2, loff);
}
template <int NCOMP>
__device__ __forceinline__ void swrite_k(const Seam<NCOMP>& S_, char* lds, int bf, int kws) {
#pragma unroll
    for (int cc = 0; cc < NCOMP; ++cc) { *(f16x8*)(lds + L_K + (bf * NCOMP + cc) * SHM + kws) = S_.st[2 * cc]; *(f16x8*)(lds + L_K + (bf * NCOMP + cc) * SHM + kws + 32 * 256) = S_.st[2 * cc + 1]; }
}
template <int NCOMP>
__device__ __forceinline__ void swrite_v(const Seam<NCOMP>& S_, char* lds, int bf, int vst0, int vst1) {
    *(f16x8*)(lds + L_V + bf * SHM + vst0) = S_.st[0]; *(f16x8*)(lds + L_V + bf * SHM + vst1) = S_.st[1];
}
template <int NCOMP>
__device__ __forceinline__ void att_prime(const BlockRef& cur, const h16_t* Qb, const h16_t* Kb, const h16_t* Vb, char* lds, Seam<NCOMP>& S_, int tid) {
    const int wid = __builtin_amdgcn_readfirstlane(tid >> 6), lane = tid & 63, r32 = lane & 31, hi = lane >> 5;
    const int comp = NCOMP == 2 ? (wid >> 2) : 0, wq = NCOMP == 2 ? (wid & 3) : wid;
    const int sr = tid >> 4, sc = (tid & 15) * 8, kws = KSWZ(sr, sc * 2); const unsigned loff = (unsigned)(sr * HD + sc) * 2u;
    { const char* qb_ = (const char*)(Qb + cur.qoff + comp * HSTR + (size_t)(wq * QBLK) * HD); const unsigned qo_ = (unsigned)(r32 * HD + hi * 8) * 2u;
#pragma unroll
      for (int d0 = 0; d0 < 8; ++d0) S_.qr[d0] = ldg8(qb_ + d0 * 32, qo_); }
    sload_k<NCOMP>(S_, Kb + cur.koff, 0, loff); VMW(); swrite_k<NCOMP>(S_, lds, 0, kws); SBAR(); sload_v<NCOMP>(S_, Vb + cur.voff, 0, loff);
    __syncthreads();
}

template <int MODE>
__device__ __forceinline__ void epilogue_part(const BlockRef& cur, char* lds, f32x16 (&o)[4], float l_reg, const EpiArgs& ea, int tid_in) {
    constexpr int NCOMP = MODE == 0 ? 2 : 1;
    typedef Lay<NCOMP> L;
    int tid = tid_in; asm volatile("" : "+v"(tid));
    const int wid = __builtin_amdgcn_readfirstlane(tid >> 6), lane = tid & 63, r32 = lane & 31, hi = lane >> 5;
    const int comp = NCOMP == 2 ? (wid >> 2) : 0, wq = NCOMP == 2 ? (wid & 3) : wid;
    float* ws = (float*)(lds + L::WS) + wid * 128; float* li_l = ws;
    if (hi == 0) li_l[r32] = l_reg; asm volatile("s_waitcnt lgkmcnt(0)" ::: "memory");
    float rli[16];
#pragma unroll
    for (int r = 0; r < 16; ++r) rli[r] = __builtin_amdgcn_rcpf(li_l[crow(r, hi)]);
    if (MODE != 0) {
        h16_t* stg = (h16_t*)(lds + L::OST) + wid * 4096;
#pragma unroll
        for (int r = 0; r < 16; ++r) { const int orow = crow(r, hi);
#pragma unroll
            for (int d0 = 0; d0 < 4; ++d0) stg[orow * 128 + d0 * 32 + r32] = f2h(o[d0][r] * rli[r]); }
        asm volatile("s_waitcnt lgkmcnt(0)" ::: "memory");
        const size_t gbase = ((size_t)(cur.b * S + cur.P0 + wq * QBLK) * E + cur.h * HD) * 2;
        const unsigned go_ = (unsigned)((lane >> 4) * E + (lane & 15) * 8) * 2u;
#pragma unroll
        for (int i = 0; i < 8; ++i) { const int row = i * 4 + (lane >> 4), ch = lane & 15;
            const u32x4 ov = *(const u32x4*)(stg + row * 128 + ch * 8);
            const u32x4 zv = *(const u32x4*)((const char*)ea.Zb + gbase + (size_t)i * (4 * E * 2) + go_); u32x4 w;
#pragma unroll
            for (int e = 0; e < 4; ++e) w[e] = pk2(lo16(ov[e]) * siluf(lo16(zv[e])), hi16(ov[e]) * siluf(hi16(zv[e])));
            *(u32x4*)((char*)ea.G + gbase + (size_t)i * (4 * E * 2) + go_) = w; SBAR(); }
    } else {
        unsigned* xch = (unsigned*)(lds + L::OST) + wq * 2048;
        if (comp == 1) { const float lam_ = ((const float*)(lds + L::MISC))[0];
#pragma unroll
            for (int d0 = 0; d0 < 4; ++d0)
#pragma unroll
                for (int r = 0; r < 16; r += 2) xch[(d0 * 8 + (r >> 1)) * 64 + lane] = pk2(o[d0][r] * rli[r] * lam_, o[d0][r + 1] * rli[r + 1] * lam_);
        }
        asm volatile("s_waitcnt lgkmcnt(0)" ::: "memory");
        __syncthreads();
        if (comp == 0) {
            float ssq[16];
#pragma unroll
            for (int r = 0; r < 16; ++r) ssq[r] = 0.f;
#pragma unroll
            for (int d0 = 0; d0 < 4; ++d0)
#pragma unroll
                for (int r = 0; r < 16; r += 2) { const unsigned w = xch[(d0 * 8 + (r >> 1)) * 64 + lane];
                    o[d0][r] = o[d0][r] * rli[r] - lo16(w); o[d0][r + 1] = o[d0][r + 1] * rli[r + 1] - hi16(w);
                    ssq[r] += o[d0][r] * o[d0][r]; ssq[r + 1] += o[d0][r + 1] * o[d0][r + 1]; }
#pragma unroll
            for (int off = 1; off < 32; off <<= 1)
#pragma unroll
                for (int r = 0; r < 16; ++r) ssq[r] += __shfl_xor(ssq[r], off);
            float* ssq_l = ws + 64;
            asm volatile("s_waitcnt lgkmcnt(0)" ::: "memory");
            h16_t* stg = (h16_t*)xch;
#pragma unroll
            for (int r = 0; r < 16; ++r) { const int orow = crow(r, hi);
#pragma unroll
                for (int d0 = 0; d0 < 4; ++d0) stg[orow * 128 + d0 * 32 + r32] = f2h(o[d0][r]); }
            const size_t gbase = ((size_t)(cur.b * S + cur.P0 + wq * QBLK) * E + cur.h * 256) * 2;
            const unsigned go_ = (unsigned)((lane >> 4) * E + (lane & 15) * 8) * 2u;
            if (cur.half == 0) {
                if (r32 == 0) {
#pragma unroll
                    for (int r = 0; r < 16; ++r) ssq_l[crow(r, hi)] = ssq[r]; }
                asm volatile("s_waitcnt lgkmcnt(0)" ::: "memory");
#pragma unroll
                for (int i = 0; i < 8; ++i) { const int row = i * 4 + (lane >> 4), ch = lane & 15;
                    *(u32x4*)((char*)ea.G + gbase + (size_t)i * (4 * E * 2) + go_) = *(const u32x4*)(stg + row * 128 + ch * 8); }
            } else {
                if (r32 == 0) {
#pragma unroll
                    for (int r = 0; r < 16; ++r) { const int orow = crow(r, hi); ssq_l[orow] = rsqrtf((ssq_l[orow] + ssq[r]) * (1.f / 256.f) + RMS_EPS) * (1.f - ea.lam_init); } }
                asm volatile("s_waitcnt vmcnt(0) lgkmcnt(0)" ::: "memory");
#pragma unroll
                for (int i = 0; i < 8; ++i) { const int row = i * 4 + (lane >> 4), ch = lane & 15; const float rs = ssq_l[row];
                    const size_t g0 = gbase + (size_t)i * (4 * E * 2), g1 = g0 + 256;
                    const u32x4 u1 = *(const u32x4*)(stg + row * 128 + ch * 8), u0 = *(const u32x4*)((const char*)ea.G + g0 + go_);
                    const u32x4 z0 = *(const u32x4*)((const char*)ea.Zb + g0 + go_), z1 = *(const u32x4*)((const char*)ea.Zb + g1 + go_);
                    const f32x4 ga = *(const f32x4*)(ea.subg + ch * 8), gb = *(const f32x4*)(ea.subg + ch * 8 + 4), gc = *(const f32x4*)(ea.subg + 128 + ch * 8), gd = *(const f32x4*)(ea.subg + 128 + ch * 8 + 4);
                    const float g0v[8] = {ga[0], ga[1], ga[2], ga[3], gb[0], gb[1], gb[2], gb[3]}, g1v[8] = {gc[0], gc[1], gc[2], gc[3], gd[0], gd[1], gd[2], gd[3]};
                    u32x4 w0, w1;
#pragma unroll
                    for (int e = 0; e < 4; ++e) {
                        w0[e] = pk2(lo16(u0[e]) * rs * g0v[2 * e] * siluf(lo16(z0[e])), hi16(u0[e]) * rs * g0v[2 * e + 1] * siluf(hi16(z0[e])));
                        w1[e] = pk2(lo16(u1[e]) * rs * g1v[2 * e] * siluf(lo16(z1[e])), hi16(u1[e]) * rs * g1v[2 * e + 1] * siluf(hi16(z1[e]))); }
                    *(u32x4*)((char*)ea.G + g0 + go_) = w0; *(u32x4*)((char*)ea.G + g1 + go_) = w1; SBAR(); }
            }
        }
    }
}

template <int MODE>
__device__ __forceinline__ void att_block(const BlockRef& cur, const BlockRef& nxt, const h16_t* Qb, const h16_t* Kb, const h16_t* Vb, char* lds, Seam<(MODE == 0 ? 2 : 1)>& S_, const BlkCtx& bc, const EpiArgs& ea, int tid_in) {
    constexpr int NCOMP = MODE == 0 ? 2 : 1, QROWS = 256 / NCOMP;
    typedef Lay<NCOMP> L;
    int tid = tid_in; asm volatile("" : "+v"(tid));
    const int wid = __builtin_amdgcn_readfirstlane(tid >> 6), lane = tid & 63, r32 = lane & 31, hi = lane >> 5;
    const int comp = NCOMP == 2 ? (wid >> 2) : 0, wq = NCOMP == 2 ? (wid & 3) : wid;
    const int NT = (cur.P0 + QROWS) / KVBLK;
    const int qlo = cur.P0 + wq * QBLK, qm = qlo + r32 - 4 * hi;
    const char* Kc_lds = lds + L_K + comp * SHM;
    float* ws = (float*)(lds + L::WS) + wid * 128; float* li_l = ws; float* al_l = ws + 32;
    const float* lut = (const float*)(lds + L::LUT) + comp * 352;
    const float* cumS = (const float*)(lds + L::BIG);
    float m_reg = -1e30f, l_reg = 0; f32x16 o[4] = {};
    const int sr = tid >> 4, sc = (tid & 15) * 8, vst0 = v_st(sr, sc), vst1 = v_st(32 + sr, sc), kws = KSWZ(sr, sc * 2);
    const int vb0 = (int)(uintptr_t)lds + v_rd_base(lane);
    const unsigned loff = (unsigned)(sr * HD + sc) * 2u;
    const h16_t* Kh = Kb + cur.koff; const h16_t* Vh = Vb + cur.voff;
#define RESC(a) do { if (__any((a) < 1.f)) { if (hi == 0) al_l[r32] = (a); asm volatile("s_waitcnt lgkmcnt(0)" ::: "memory");              \
                     _Pragma("unroll") for (int d_ = 0; d_ < 4; ++d_) _Pragma("unroll") for (int r = 0; r < 16; ++r) o[d_][r] *= al_l[crow(r, hi)]; } } while (0)
#define KBASE(t) ((t) * KVBLK)
#define T_ABOVE(t) (KBASE(t) > qlo + QBLK - 1)
#define T_NEAR(t) (KBASE(t) + KVBLK - 1 >= qlo - 112)
#define MKINIT(i0, i1, t) do { const int kb_ = KBASE(t);                                                                                  \
        if (MODE == 2) { const float* cp_ = cumS + kb_ + 4 * hi; const float cq_ = cumS[qlo + r32];                                                                \
            _Pragma("unroll") for (int g_ = 0; g_ < 4; ++g_) { const f32x4 c0_ = *(const f32x4*)(cp_ + 8 * g_), c1_ = *(const f32x4*)(cp_ + 32 + 8 * g_); \
                _Pragma("unroll") for (int e_ = 0; e_ < 4; ++e_) { i0[4 * g_ + e_] = cq_ - c0_[e_]; i1[4 * g_ + e_] = cq_ - c1_[e_]; } } }          \
        else { float v_ = T_NEAR(t) ? 0.f : lut[328];                                                                               \
            if (MODE == 1) { const int blk_ = kb_ >> 8; if (blk_ != bc.own && !((bc.selbits >> blk_) & 1u)) v_ = -__builtin_inff(); } \
            _Pragma("unroll") for (int r = 0; r < 16; ++r) { i0[r] = v_; i1[r] = v_; } } } while (0)
#define MASKT(P0_, P1_, t) do { const int kb_ = KBASE(t);                                                                         \
        if (T_ABOVE(t)) { const float NEG_ = -__builtin_inff(); _Pragma("unroll") for (int r = 0; r < 16; ++r) { P0_[r] = NEG_; P1_[r] = NEG_; } } \
        else if (MODE == 2) { if (kb_ + KVBLK - 1 > qlo) mask_tile(P0_, P1_, qm - kb_); }                                          \
        else if (T_NEAR(t)) bias_mask_tile(P0_, P1_, qm - kb_, lut); } while (0)
    constexpr int NQL = 8;
#define SEAM_K0() do { VMWN(NQL); swrite_k<NCOMP>(S_, lds, 0, kws); SBAR(); sload_v<NCOMP>(S_, Vb + nxt.voff, 0, loff); SBAR(); } while (0)
    f32x16 pA0, pA1, pB0, pB1; float mnA, mnB, alA, alB; f16x8 pa0, pa1, pa2, pa3;
    VMW(); swrite_v<NCOMP>(S_, lds, 0, vst0, vst1); SBAR();
    sload_k<NCOMP>(S_, Kh, KBASE(1), loff);
    MKINIT(pA0, pA1, 0);
    SBAR(); qkt<0, NCOMP>(pA0, pA1, Kc_lds, r32, hi, S_.qr);
    VMW(); swrite_k<NCOMP>(S_, lds, 1, kws); SBAR(); sload_v<NCOMP>(S_, Vh, KBASE(1), loff); SBAR();
    MASKT(pA0, pA1, 0); partialSM(pA0, pA1, m_reg, mnA, alA);
    VMW(); swrite_v<NCOMP>(S_, lds, 1, vst0, vst1); SBAR(); if (NT > 2) sload_k<NCOMP>(S_, Kh, KBASE(2), loff);
    __syncthreads();
#define HALF_STEP(PX0, PX1, mnX, alX, PY0, PY1, alY, t, KB, VB, SB) do {                                                      \
        MKINIT(PX0, PX1, t);                                                                                                  \
        SBAR(); qkt<KB, NCOMP>(PX0, PX1, Kc_lds, r32, hi, S_.qr);                                                             \
        finishSM(PY0, PY1, alY, l_reg, pa0, pa1, pa2, pa3); SBAR();                                                           \
        if ((t) + 1 < NT) { VMW(); swrite_k<NCOMP>(S_, lds, SB, kws); SBAR(); sload_v<NCOMP>(S_, Vh, KBASE((t) + 1), loff); SBAR(); } \
        pv_tile<VB>(o, vb0, pa0, pa1, pa2, pa3); MASKT(PX0, PX1, (t)); partialSM(PX0, PX1, m_reg, mnX, alX);                  \
        __syncthreads();                                                                                                      \
        if ((t) + 1 < NT) { VMW(); swrite_v<NCOMP>(S_, lds, SB, vst0, vst1); SBAR(); if ((t) + 2 < NT) sload_k<NCOMP>(S_, Kh, KBASE((t) + 2), loff); } \
        RESC(alX); __syncthreads(); } while (0)
    for (int t = 1; t + 1 < NT; t += 2) {
        HALF_STEP(pB0, pB1, mnB, alB, pA0, pA1, alA, t, 1, 0, 0);
        HALF_STEP(pA0, pA1, mnA, alA, pB0, pB1, alB, t + 1, 0, 1, 1);
    }
    MKINIT(pB0, pB1, NT - 1);
    SBAR(); qkt<1, NCOMP>(pB0, pB1, Kc_lds, r32, hi, S_.qr); SBAR();
    sload_k<NCOMP>(S_, Kb + nxt.koff, 0, loff); SBAR();
    { const char* qb_ = (const char*)(Qb + nxt.qoff + comp * HSTR + (size_t)(wq * QBLK) * HD); const unsigned qo_ = (unsigned)(r32 * HD + hi * 8) * 2u;
#pragma unroll
        for (int d0 = 0; d0 < 8; ++d0) S_.qr[d0] = ldg8(qb_ + d0 * 32, qo_); }
    SBAR();
    finishSM(pA0, pA1, alA, l_reg, pa0, pa1, pa2, pa3); SBAR();
    pv_tile<0>(o, vb0, pa0, pa1, pa2, pa3);
    MASKT(pB0, pB1, NT - 1); partialSM(pB0, pB1, m_reg, mnB, alB); __syncthreads(); RESC(alB);
    finishSM(pB0, pB1, alB, l_reg, pa0, pa1, pa2, pa3); SBAR(); pv_tile<1>(o, vb0, pa0, pa1, pa2, pa3);
    SBAR(); SEAM_K0();
    epilogue_part<MODE>(cur, lds, o, l_reg, ea, tid_in);
    __syncthreads();
#undef RESC
#undef KBASE
#undef T_ABOVE
#undef T_NEAR
#undef MKINIT
#undef MASKT
#undef SEAM_K0
#undef HALF_STEP
}

template <int MODE>
__device__ __forceinline__ BlockRef att_ref(int item, int j) {
    BlockRef r;
    if (MODE == 0) { const int bh = item >> 3, y = item & 7, x = (j < 2) ? y : 15 - y; r.b = bh >> 3; r.h = bh & 7; r.half = j & 1; r.x = x; r.P0 = x * 128;
        const unsigned hb = (unsigned)(r.b * NH + 2 * r.h) * (unsigned)HSTR; r.qoff = hb + (unsigned)r.P0 * HD; r.koff = hb; r.voff = hb + r.half * (unsigned)HSTR; }
    else { const int bh = item >> 2, y = item & 3, x = (j == 0) ? y : 7 - y; r.b = bh >> 4; r.h = bh & 15; r.half = 0; r.x = x; r.P0 = x * 256;
        const unsigned hb = (unsigned)(r.b * NH + r.h) * (unsigned)HSTR; r.qoff = hb + (unsigned)r.P0 * HD; r.koff = hb; r.voff = hb; }
    return r;
}
template <int MODE>
__device__ __forceinline__ void attn_phase(const Ctx& c, const AttnArgs& A) {
    constexpr int NCOMP = MODE == 0 ? 2 : 1, NBLK = MODE == 0 ? 4 : 2, NITEMS = 256;
    typedef Lay<NCOMP> L;
    char* lds = (char*)c.lds;
    const int tid = c.tid, wid = c.wave, lane = c.lane, r32 = lane & 31, hi = lane >> 5;
    const int comp = NCOMP == 2 ? (wid >> 2) : 0, wq = NCOMP == 2 ? (wid & 3) : wid;
    const int vcu = (c.G % 8 == 0) ? (c.bid % 8) * (c.G / 8) + c.bid / 8 : c.bid;
    float* misc = (float*)(lds + L::MISC); float* lutw = (float*)(lds + L::LUT); float* big = (float*)(lds + L::BIG);
    EpiArgs ea{A.Zb, A.G, A.subg, A.lam_init};
    if (MODE == 0) {
        if (tid < 64) { float a = A.lq1[tid] * A.lk1[tid] + A.lq1[tid + 64] * A.lk1[tid + 64], cc = A.lq2[tid] * A.lk2[tid] + A.lq2[tid + 64] * A.lk2[tid + 64];
            a = wave_sum(a); cc = wave_sum(cc); if (tid == 0) misc[0] = __expf(a) - __expf(cc) + A.lam_init; }
        __syncthreads();
    }
    Seam<NCOMP> S_;
    int item = vcu; if (item >= NITEMS) return;
    int j = 0; BlockRef cur = att_ref<MODE>(item, 0);
    att_prime<NCOMP>(cur, A.Qb, A.Kb, A.Vb, lds, S_, tid);
    bool new_item = true;
    for (;;) {
        if (new_item) {
            int tid = c.tid; asm volatile("" : "+v"(tid)); const int lane = tid & 63;
            if (MODE != 2) { for (int i = tid; i < NCOMP * 352; i += NTHREADS) { const int cc = i / 352, ii = i % 352, dist = ii - 128; const int hq = MODE == 0 ? 2 * cur.h + cc : cur.h;
                    lutw[i] = A.rel[t5_bucket(dist > 0 ? dist : 0) * 16 + hq] * (1.f / SCALE); } }
            if (MODE == 1) { for (int i = tid; i < 8 * 128; i += NTHREADS) { const float* k0 = A.kpart + (size_t)(cur.b * NH + cur.h) * 8 * HD + i; big[i] = (k0[0] + k0[(size_t)NB * NH * 8 * HD]) * (1.f / 256.f); } }
            if (MODE == 2) {
                float v[4];
#pragma unroll
                for (int e = 0; e < 4; ++e) v[e] = A.logf[(size_t)(cur.b * S + 4 * tid + e) * NH + cur.h];
                v[1] += v[0]; v[2] += v[1]; v[3] += v[2];
                float incl = v[3];
#pragma unroll
                for (int o = 1; o < 64; o <<= 1) { const float t = __shfl_up(incl, o); if (lane >= o) incl += t; }
                if (lane == 63) misc[8 + wid] = incl;
                __syncthreads();
                float off = incl - v[3];
                for (int w = 0; w < wid; ++w) off += misc[8 + w];
                const f32x4 o4 = {(v[0] + off) * (1.f / SCALE), (v[1] + off) * (1.f / SCALE), (v[2] + off) * (1.f / SCALE), (v[3] + off) * (1.f / SCALE)};
                *(f32x4*)(big + 4 * tid) = o4;
            }
            __syncthreads();
            new_item = false;
        }
        BlkCtx bc; bc.selbits = 0u; bc.own = cur.x;
        if (MODE == 1) {
            float gate[8];
#pragma unroll
            for (int n = 0; n < 8; ++n) { float gs = 0.f;
                if (n < cur.x) {
#pragma unroll
                    for (int d0 = 0; d0 < 8; ++d0) { const float* kp = big + n * 128 + d0 * 16 + hi * 8; const f32x4 k0 = *(const f32x4*)kp, k1 = *(const f32x4*)(kp + 4); const f16x8 q = S_.qr[d0];
                        gs += (float)q[0] * k0[0] + (float)q[1] * k0[1] + (float)q[2] * k0[2] + (float)q[3] * k0[3] + (float)q[4] * k1[0] + (float)q[5] * k1[1] + (float)q[6] * k1[2] + (float)q[7] * k1[3]; }
                    gs += __shfl_xor(gs, 32); }
                gate[n] = n < cur.x ? gs : NEGF; SBAR(); }
            unsigned sb = 0u;
#pragma unroll
            for (int k = 0; k < 3; ++k) { int best = -1; float bv = 0.f;
#pragma unroll
                for (int n = 0; n < 8; ++n) if (!((sb >> n) & 1u) && (best < 0 || gate[n] > bv)) { best = n; bv = gate[n]; }
                sb |= 1u << best; }
            bc.selbits = sb & ((1u << cur.x) - 1u);
        }
        int itemn = item, jn = j + 1; bool last = false;
        if (jn == NBLK) { jn = 0; itemn = item + c.G; if (itemn >= NITEMS) { last = true; itemn = item; jn = j; } }
        const BlockRef nxt = att_ref<MODE>(itemn, jn);
        att_block<MODE>(cur, nxt, A.Qb, A.Kb, A.Vb, lds, S_, bc, ea, tid);
        if (last) break;
        new_item = itemn != item; cur = nxt; item = itemn; j = jn;
    }
    VMW();
}
#undef ROW
#undef VMW
#undef VMWN
#undef KSWZ
#undef SBAR
}

struct Args { const float* in[29]; float* out; unsigned char* ws; int ph_lo, ph_hi; };
static_assert(sizeof(Args) == 31 * 8 + 8, "Args has no padding");

__global__ void __launch_bounds__(NTHREADS, 2) mega_fwd(Args args) {
    extern __shared__ __attribute__((aligned(16))) unsigned char lds[];
    cg::grid_group grid = cg::this_grid();
    unsigned char* ws = args.ws;
    const float* x = args.in[0]; const float* rel = args.in[1];
    h16_t* HB = (h16_t*)(ws + WS_HB); h16_t* Qb = (h16_t*)(ws + WS_Q); h16_t* Kb = (h16_t*)(ws + WS_K); h16_t* Vb = (h16_t*)(ws + WS_V);
    h16_t* Zb = (h16_t*)(ws + WS_Z); h16_t* Gb = (h16_t*)(ws + WS_G); float* stats = (float*)(ws + WS_STATS); float* kpart = (float*)(ws + WS_KPART);
    float* logf = (float*)(ws + WS_LOGF); float* cum = (float*)(ws + WS_CUM); h16_t* WfT = (h16_t*)(ws + WS_WF); float* T = args.out;
#define PHASE_BEGIN { Ctx c; c.tid = threadIdx.x; asm volatile("" : "+v"(c.tid)); c.lane = c.tid & 63; c.wave = __builtin_amdgcn_readfirstlane(c.tid >> 6); c.G = gridDim.x; c.bid = blockIdx.x; c.lds = lds;
#define PHASE_END(dosync_) if (dosync_) grid.sync(); }

    PHASE_BEGIN
    {
        const int i_win[4] = {2, 11, 15, 20}, i_wout[4] = {8, 12, 17, 26};
#pragma unroll
        for (int l = 0; l < 4; ++l) {
            transpose_phase(c, args.in[i_win[l]], (l == 2) ? NPROJ + 16 : NPROJ, 0, NPROJ, (h16_t*)(ws + WS_WIN + (size_t)l * 32 * MiB));
            transpose_phase(c, args.in[i_wout[l]], D, 0, D, (h16_t*)(ws + WS_WOUT + (size_t)l * 8 * MiB));
        }
        transpose_phase(c, args.in[15], NPROJ + 16, NPROJ, 16, WfT);
        cvt_phase(c, x, HB, (size_t)M * D);
    }
    PHASE_END(true)

#pragma unroll 1
    for (int l = 0; l < 4; ++l) {
        const int i_g[4] = {9, 13, 18, 27}, i_b[4] = {10, 14, 19, 28};
        const h16_t* WinT = (const h16_t*)(ws + WS_WIN + (size_t)l * 32 * MiB); const h16_t* WoutT = (const h16_t*)(ws + WS_WOUT + (size_t)l * 8 * MiB);
        PHASE_BEGIN
        {
            if (l == 2) logf_phase(c, HB, WfT, args.in[16], logf);
            pg8::Gemm g{HB, WinT, M, NPROJ, D}; pg8::StaticOrder So; So.init(M, NPROJ, c.G, c.bid);
            EpiQKVZ Ep{Qb, Kb, Vb, Zb, l == 1 ? kpart : nullptr};
            pg8::gemm_phase<EpiQKVZ, pg8::StaticOrder, true, true>((LAS unsigned char*)lds, g, So, Ep, c.tid);
        }
        PHASE_END(true)
        if (!FAST2) {
        PHASE_BEGIN
        if (l == 2) cum_phase(c, logf, cum);
        PHASE_END(l == 2)
        }
        PHASE_BEGIN
        {
            AttnArgs A{Qb, Kb, Vb, Zb, Gb, rel, kpart, cum, logf, nullptr, nullptr, nullptr, nullptr, nullptr, 0.f};
            if (l == 0 || l == 3) { const int base = (l == 0) ? 3 : 21; A.lq1 = args.in[base]; A.lk1 = args.in[base + 1]; A.lq2 = args.in[base + 2]; A.lk2 = args.in[base + 3]; A.subg = args.in[base + 4];
                A.lam_init = (l == 0) ? 0.2f : (0.8f - 0.6f * 0.40656965974059917f);
                if (FAST0) att::attn_phase<0>(c, A); else attn_naive_phase<0>(c, A); }
            else if (l == 1) { if (FAST1) att::attn_phase<1>(c, A); else attn_naive_phase<1>(c, A); }
            else { if (FAST2) att::attn_phase<2>(c, A); else attn_naive_phase<2>(c, A); }
        }
        PHASE_END(true)
        PHASE_BEGIN
        {
            pg8::Gemm g{Gb, WoutT, M, D, E}; pg8::StaticOrder So; So.init(M, D, c.G, c.bid);
            EpiResid Ep{T, x, stats, l ? args.in[i_g[l - 1]] : nullptr, l ? args.in[i_b[l - 1]] : nullptr, l};
            pg8::gemm_phase<EpiResid, pg8::StaticOrder, false, true>((LAS unsigned char*)lds, g, So, Ep, c.tid);
        }
        PHASE_END(true)
        PHASE_BEGIN
        ln_phase(c, T, args.in[i_g[l]], args.in[i_b[l]], stats, HB, l == 3);
        PHASE_END(true)
    }
}

extern "C" void kernel_launch(void* const* d_in, const int* in_sizes, int n_in, void* d_out, int out_size, void* d_ws, size_t ws_size, hipStream_t stream) {
    static int grid = 0;
    if (grid == 0) {
        if (n_in != 29 || ws_size < WS_END || out_size != M * D) { fprintf(stderr, "kernel_launch: unexpected shapes n_in=%d ws=%zu out=%d\n", n_in, ws_size, out_size); grid = -1; return; }
        int dev = 0, cus = 0, per_cu = 0;
        (void)hipGetDevice(&dev); (void)hipDeviceGetAttribute(&cus, hipDeviceAttributeMultiprocessorCount, dev);
        if (hipFuncSetAttribute((const void*)mega_fwd, hipFuncAttributeMaxDynamicSharedMemorySize, LDS_BYTES) != hipSuccess) { fprintf(stderr, "kernel_launch: hipFuncSetAttribute failed\n"); grid = -1; return; }
        if (hipOccupancyMaxActiveBlocksPerMultiprocessor(&per_cu, (const void*)mega_fwd, NTHREADS, LDS_BYTES) != hipSuccess || per_cu < 1) { fprintf(stderr, "kernel_launch: occupancy query says %d\n", per_cu); per_cu = 1; }
        (void)hipGetLastError();
        grid = cus > 0 ? cus : 256;
    }
    if (grid < 0) return;
    Args a{};
    for (int i = 0; i < 29; ++i) a.in[i] = (const float*)d_in[i];
    a.out = (float*)d_out; a.ws = (unsigned char*)d_ws; a.ph_lo = 0; a.ph_hi = 1000;
    void* kargs[] = {&a};
    hipError_t e = hipLaunchCooperativeKernel((const void*)mega_fwd, dim3(grid), dim3(NTHREADS), kargs, LDS_BYTES, stream);
    if (e != hipSuccess) fprintf(stderr, "kernel_launch: cooperative launch failed: %s (grid %d)\n", hipGetErrorString(e), grid);
}
```

```cpp
#include <hip/hip_runtime.h>
#include <hip/hip_cooperative_groups.h>
#include <cstdint>
#include <cstdio>
namespace cg = cooperative_groups;

typedef unsigned short h16_t;
typedef float f32x4 __attribute__((ext_vector_type(4)));
typedef float f32x2 __attribute__((ext_vector_type(2)));
typedef unsigned u32x4 __attribute__((ext_vector_type(4)));
typedef _Float16 f16x8 __attribute__((ext_vector_type(8)));
typedef _Float16 f16x2 __attribute__((ext_vector_type(2)));
#define LAS __attribute__((address_space(3)))

constexpr int NB = 4, S = 2048, D = 2048, M = NB * S, E = 2048, NH = 16, HD = 128;
constexpr int NPROJ = 4 * E;
constexpr float SCALE = 0.08838834764831845f;
constexpr float LN_EPS = 1e-5f, RMS_EPS = 1e-5f;
constexpr float DN_ALPHA = 1.681792830507429f;
constexpr float NEGF = -1e30f;
constexpr int NTHREADS = 512, NWAVES = 8;
constexpr int LDS_BYTES = 147456;
constexpr int XB_LDS_OFF = LDS_BYTES - 64;
#ifndef USE_CG_SYNC
#define USE_CG_SYNC 0
#endif

constexpr size_t MiB = 1u << 20;
constexpr size_t WS_CTL = 0;
constexpr size_t WS_WIN = 1 * MiB;
constexpr size_t WS_WOUT = WS_WIN + 128 * MiB;
constexpr size_t WS_HB = WS_WOUT + 32 * MiB;
constexpr size_t WS_Q = WS_HB + 32 * MiB;
constexpr size_t WS_K = WS_Q + 32 * MiB;
constexpr size_t WS_V = WS_K + 32 * MiB;
constexpr size_t WS_Z = WS_V + 32 * MiB;
constexpr size_t WS_G = WS_Z + 32 * MiB;
constexpr size_t WS_SMALL = WS_G + 32 * MiB;
constexpr size_t WS_STATS = WS_SMALL;
constexpr size_t WS_KPART = WS_STATS + 64 * 1024;
constexpr size_t WS_LOGF = WS_KPART + 512 * 1024;
constexpr size_t WS_CUM = WS_LOGF + 512 * 1024;
constexpr size_t WS_WF = WS_CUM + 512 * 1024;
constexpr size_t WS_END = WS_WF + 64 * 1024;

__device__ __forceinline__ float h2f(h16_t v) { return (float)__builtin_bit_cast(_Float16, v); }
__device__ __forceinline__ h16_t f2h(float f) { return __builtin_bit_cast(h16_t, (_Float16)f); }
__device__ __forceinline__ float lo16(unsigned u) { return h2f((h16_t)(u & 0xffffu)); }
__device__ __forceinline__ float hi16(unsigned u) { return h2f((h16_t)(u >> 16)); }
__device__ __forceinline__ unsigned pk2(float lo, float hi) { f32x2 v = {lo, hi}; return __builtin_bit_cast(unsigned, __builtin_convertvector(v, f16x2)); }
template <int MASK> __device__ __forceinline__ float xsw(float v) { return __int_as_float(__builtin_amdgcn_ds_swizzle(__float_as_int(v), (MASK << 10) | 0x1F)); }
__device__ __forceinline__ float xadd32(float v) { auto rr = __builtin_amdgcn_permlane32_swap(__float_as_uint(v), __float_as_uint(v), false, false); return __uint_as_float(rr[0]) + __uint_as_float(rr[1]); }
__device__ __forceinline__ float hsum32(float v) { v += xsw<1>(v); v += xsw<2>(v); v += xsw<4>(v); v += xsw<8>(v); v += xsw<16>(v); return v; }
__device__ __forceinline__ float siluf(float z) { return z / (1.f + __expf(-z)); }

__device__ __forceinline__ int t5_bucket(int d) {
    if (d < 16) return d;
    if (d >= 113) return 31;
    int b = 16;
    b += (d >= 19); b += (d >= 21); b += (d >= 24); b += (d >= 27); b += (d >= 31); b += (d >= 35); b += (d >= 40); b += (d >= 46);
    b += (d >= 52); b += (d >= 59); b += (d >= 67); b += (d >= 77); b += (d >= 87); b += (d >= 99);
    return b;
}

namespace pg8 {
constexpr int BM = 256, BK = 64, HALF = 128, HTB = HALF * BK * 2, STAGE_BYTES = 8 * HTB, NXCD = 8, WGM = 8;
__host__ __device__ __forceinline__ int lds_byte(int r, int c) { const int st = (r >> 4) * 2 + (c >> 5), rr = r & 15, cc = c & 31, ob = rr * 64 + cc * 2; return st * 1024 + (ob ^ (((ob >> 9) & 1) << 5)); }
__host__ __device__ __forceinline__ void stage_rc(int b, int& R, int& C) { const int st = b / 1024, sb = b % 1024, swz = sb ^ (((sb >> 9) & 1) << 5); R = (st >> 1) * 16 + swz / 64; C = (st & 1) * 32 + (swz % 64) / 2; }
__host__ __device__ __forceinline__ int perm32(int rho) { const int n = rho >> 4, i = rho & 15; return 8 * (i >> 2) + 4 * n + (i & 3); }
struct Unit { int pm, pn; };
struct Gemm { const h16_t* A; const h16_t* Bt; int M, N, K; };
struct StaticOrder {
    int nM, nN, nwg, G, c;
    __host__ __device__ void init(int M_, int N_, int G_, int c_) { nM = M_ / BM; nN = N_ / BM; nwg = nM * nN; G = G_; c = c_; }
    __host__ __device__ bool next(int i, Unit& u) const {
        const long L = (long)i * G + c; if (L >= nwg) return false;
        int wgid = (int)L; { const int q = nwg / NXCD, r = nwg % NXCD, xcd = wgid % NXCD, off = wgid / NXCD; wgid = (xcd < r ? xcd * (q + 1) : r * (q + 1) + (xcd - r) * q) + off; }
        const int nig = WGM * nN, gid = wgid / nig, fm = gid * WGM, gsz = (nM - fm) < WGM ? (nM - fm) : WGM;
        u.pm = fm + ((wgid % nig) % gsz); u.pn = (wgid % nig) / gsz; return true;
    }
    __device__ __forceinline__ void a_ready(const Unit&) const {}
    __device__ __forceinline__ void done(const Unit&) const {}
};

template <class Epi, class Sched, bool ALIGN_EPI = false, bool SP2 = false>
__device__ __forceinline__ void gemm_phase(LAS unsigned char* lds, const Gemm g, const Sched& S, const Epi& E, const int tid) {
    const int wid = __builtin_amdgcn_readfirstlane(tid >> 6), lane = tid & 63, wr = wid >> 2, wc = wid & 3, fr = lane & 15, fq = lane >> 4;
    const int K = g.K, nt = K / BK;
    unsigned voffA[2], voffB[2];
#pragma unroll
    for (int i = 0; i < 2; ++i) { int R, C; stage_rc(tid * 16 + i * 8192, R, C); const int Rb = Epi::PERM ? ((R & ~31) + perm32(R & 31)) : R;
        voffA[i] = (unsigned)(R * K + C) * 2u; voffB[i] = (unsigned)(Rb * K + C) * 2u; }
    const size_t kstep = (size_t)(BK * 2);
    const size_t hstep = (size_t)HALF * K * 2;
    const size_t tstep = 2 * hstep;
    const unsigned ldsw = (unsigned)wid * 1024u;
    const int aoff = lds_byte(wr * 64 + fr, fq * 8), boff = lds_byte(wc * 32 + fr, fq * 8);
#define PG8_SA(b, h) (((b) * 2 + (h)) * HTB)
#define PG8_SB(b, h) ((4 + (b) * 2 + (h)) * HTB)
#define PG8_STAGE(bufoff, gbase, voff) do { _Pragma("unroll") for (int _i = 0; _i < 2; ++_i) \
        __builtin_amdgcn_global_load_lds((const unsigned*)((const char*)(gbase) + (voff)[_i]), (LAS unsigned*)(lds + (bufoff) + ldsw + _i * 8192), 16, 0, 0); } while (0)
#define PG8_LDA(dst, b, h) do { _Pragma("unroll") for (int m = 0; m < 4; ++m) _Pragma("unroll") for (int k = 0; k < 2; ++k) dst[m][k] = *(const LAS f16x8*)(lds + PG8_SA(b, h) + aoff + m * 2048 + k * 1024); } while (0)
#define PG8_LDB(dst, b, h) do { _Pragma("unroll") for (int n = 0; n < 2; ++n) _Pragma("unroll") for (int k = 0; k < 2; ++k) dst[n][k] = *(const LAS f16x8*)(lds + PG8_SB(b, h) + boff + n * 2048 + k * 1024); } while (0)
#define PG8_MMA(ai, bj, At, Bt) do { __builtin_amdgcn_s_setprio(1); _Pragma("unroll") for (int m = 0; m < 4; ++m) _Pragma("unroll") for (int n = 0; n < 2; ++n) _Pragma("unroll") for (int k = 0; k < 2; ++k) \
        acc[ai][bj][m][n] = __builtin_amdgcn_mfma_f32_16x16x32_f16(Bt[n][k], At[m][k], acc[ai][bj][m][n], 0, 0, 0); __builtin_amdgcn_s_setprio(0); } while (0)
#define PG8_WAIT_V(n) asm volatile("s_waitcnt vmcnt(" #n ")" ::: "memory")
#define PG8_WAIT_L(n) asm volatile("s_waitcnt lgkmcnt(" #n ")" ::: "memory")
#define PG8_BAR __builtin_amdgcn_s_barrier()
#define PG8_SCHED __builtin_amdgcn_sched_barrier(0)
    Unit cur, nxt; int ui = 0;
    if (!S.next(0, cur)) return;
    f32x4 acc[2][2][4][2];
#pragma unroll
    for (int a = 0; a < 2; ++a)
#pragma unroll
        for (int b = 0; b < 2; ++b)
#pragma unroll
            for (int m = 0; m < 4; ++m)
#pragma unroll
                for (int n = 0; n < 2; ++n) acc[a][b][m][n] = (f32x4){0.f, 0.f, 0.f, 0.f};
    f16x8 At[4][2], B0[2][2], B1[2][2];
    const char* cA = (const char*)g.A + (size_t)cur.pm * tstep; const char* cB = (const char*)g.Bt + (size_t)cur.pn * tstep;
    S.a_ready(cur);
    if constexpr (SP2) {
        PG8_STAGE(PG8_SB(0, 0), cB, voffB); PG8_STAGE(PG8_SB(0, 1), cB + hstep, voffB); PG8_STAGE(PG8_SA(0, 0), cA, voffA); PG8_STAGE(PG8_SA(0, 1), cA + hstep, voffA);
        if (wr == 1) PG8_BAR;
        PG8_WAIT_V(2); PG8_BAR;
        PG8_STAGE(PG8_SB(1, 0), cB + kstep, voffB); PG8_STAGE(PG8_SA(1, 0), cA + kstep, voffA); PG8_STAGE(PG8_SB(1, 1), cB + hstep + kstep, voffB);
        PG8_WAIT_V(6); PG8_BAR;
    } else {
        PG8_STAGE(PG8_SB(0, 0), cB, voffB); PG8_STAGE(PG8_SA(0, 0), cA, voffA); PG8_STAGE(PG8_SB(0, 1), cB + hstep, voffB); PG8_STAGE(PG8_SA(0, 1), cA + hstep, voffA);
        if (wr == 1) PG8_BAR;
        PG8_WAIT_V(4); PG8_BAR;
        PG8_STAGE(PG8_SB(1, 0), cB + kstep, voffB); PG8_STAGE(PG8_SA(1, 0), cA + kstep, voffA); PG8_STAGE(PG8_SB(1, 1), cB + hstep + kstep, voffB);
        PG8_WAIT_V(6); PG8_BAR;
    }
    for (;;) {
        const bool has_next = S.next(ui + 1, nxt);
        const char* nA = has_next ? (const char*)g.A + (size_t)nxt.pm * tstep : cA; const char* nB = has_next ? (const char*)g.Bt + (size_t)nxt.pn * tstep : cB;
        for (int t = 0; t < nt; t += 2) {
            const bool last = (t == nt - 2);
            const char* a1 = cA + (size_t)(t + 1) * kstep;
            const char* a2 = last ? nA : cA + (size_t)(t + 2) * kstep; const char* b2 = last ? nB : cB + (size_t)(t + 2) * kstep;
            const char* a3 = a2 + kstep; const char* b3 = b2 + kstep;
            if (last && has_next) S.a_ready(nxt);
            if constexpr (SP2) {
            PG8_LDB(B0, 0, 0); PG8_LDB(B1, 0, 1); PG8_SCHED; PG8_LDA(At, 0, 0); PG8_STAGE(PG8_SA(1, 1), a1 + hstep, voffA);
            PG8_WAIT_V(8); PG8_WAIT_L(0); PG8_BAR; PG8_MMA(0, 0, At, B0); PG8_MMA(0, 1, At, B1); PG8_BAR; PG8_SCHED;
            PG8_LDA(At, 0, 1); PG8_STAGE(PG8_SB(0, 0), b2, voffB); PG8_STAGE(PG8_SB(0, 1), b2 + hstep, voffB); PG8_STAGE(PG8_SA(0, 0), a2, voffA);
            PG8_WAIT_V(8); PG8_WAIT_L(0); PG8_BAR; PG8_MMA(1, 0, At, B0); PG8_MMA(1, 1, At, B1); PG8_BAR; PG8_SCHED;
            PG8_LDB(B0, 1, 0); PG8_LDB(B1, 1, 1); PG8_SCHED; PG8_LDA(At, 1, 0); PG8_STAGE(PG8_SA(0, 1), a2 + hstep, voffA);
            PG8_WAIT_V(8); PG8_WAIT_L(0); PG8_BAR; PG8_MMA(0, 0, At, B0); PG8_MMA(0, 1, At, B1); PG8_BAR; PG8_SCHED;
            PG8_LDA(At, 1, 1); PG8_STAGE(PG8_SB(1, 0), b3, voffB); PG8_STAGE(PG8_SB(1, 1), b3 + hstep, voffB); PG8_STAGE(PG8_SA(1, 0), a3, voffA);
            PG8_WAIT_V(8); PG8_WAIT_L(0); PG8_BAR; PG8_MMA(1, 0, At, B0); PG8_MMA(1, 1, At, B1); PG8_BAR; PG8_SCHED;
            } else {
            PG8_LDB(B0, 0, 0); PG8_SCHED; PG8_LDA(At, 0, 0); PG8_STAGE(PG8_SA(1, 1), a1 + hstep, voffA);
            PG8_WAIT_L(8); PG8_BAR; PG8_WAIT_L(0); PG8_MMA(0, 0, At, B0); PG8_BAR; PG8_SCHED;
            PG8_LDB(B1, 0, 1); PG8_STAGE(PG8_SB(0, 0), b2, voffB);
            PG8_BAR; PG8_WAIT_L(0); PG8_MMA(0, 1, At, B1); PG8_BAR;
            PG8_LDA(At, 0, 1); PG8_STAGE(PG8_SA(0, 0), a2, voffA);
            PG8_BAR; PG8_WAIT_L(0); PG8_MMA(1, 0, At, B0); PG8_BAR; PG8_SCHED;
            PG8_STAGE(PG8_SB(0, 1), b2 + hstep, voffB);
            PG8_WAIT_V(6); PG8_BAR; PG8_MMA(1, 1, At, B1); PG8_BAR;
            PG8_LDB(B0, 1, 0); PG8_SCHED; PG8_LDA(At, 1, 0); PG8_STAGE(PG8_SA(0, 1), a2 + hstep, voffA);
            PG8_WAIT_L(8); PG8_BAR; PG8_WAIT_L(0); PG8_MMA(0, 0, At, B0); PG8_BAR; PG8_SCHED;
            PG8_LDB(B1, 1, 1); PG8_STAGE(PG8_SB(1, 0), b3, voffB);
            PG8_BAR; PG8_WAIT_L(0); PG8_MMA(0, 1, At, B1); PG8_BAR;
            PG8_LDA(At, 1, 1); PG8_STAGE(PG8_SA(1, 0), a3, voffA);
            PG8_BAR; PG8_WAIT_L(0); PG8_MMA(1, 0, At, B0); PG8_BAR; PG8_SCHED;
            PG8_STAGE(PG8_SB(1, 1), b3 + hstep, voffB);
            PG8_WAIT_V(6); PG8_BAR; PG8_MMA(1, 1, At, B1); PG8_BAR;
            }
        }
        if constexpr (ALIGN_EPI) { if (wr == 0) PG8_BAR; }
        E(acc, cur, wr, wc, fr, fq); S.done(cur);
        if (!has_next) break;
#pragma unroll
        for (int a = 0; a < 2; ++a)
#pragma unroll
            for (int b = 0; b < 2; ++b)
#pragma unroll
                for (int m = 0; m < 4; ++m)
#pragma unroll
                    for (int n = 0; n < 2; ++n) acc[a][b][m][n] = (f32x4){0.f, 0.f, 0.f, 0.f};
        cur = nxt; cA = nA; cB = nB; ++ui;
        if constexpr (ALIGN_EPI) { if (wr == 1) PG8_BAR; }
    }
    PG8_WAIT_V(0);
    if constexpr (!ALIGN_EPI) { if (wr == 0) PG8_BAR; }
    PG8_BAR;
#undef PG8_SA
#undef PG8_SB
#undef PG8_STAGE
#undef PG8_LDA
#undef PG8_LDB
#undef PG8_MMA
#undef PG8_WAIT_V
#undef PG8_WAIT_L
#undef PG8_BAR
#undef PG8_SCHED
}
}

struct EpiQKVZ {
    static constexpr bool PERM = true;
    h16_t *Q, *K, *V, *Z; float* kpart;
    __device__ __forceinline__ void operator()(const f32x4 (&acc)[2][2][4][2], const pg8::Unit& u, int wr, int wc, int fr, int fq) const {
        const int colt = u.pn * 256, sec = colt >> 11, cbase = colt & 2047;
        const int row0 = u.pm * 256 + wr * 64 + fr;
        h16_t* dst = sec == 0 ? Q : (sec == 1 ? K : (sec == 2 ? V : Z));
#pragma unroll
        for (int ai = 0; ai < 2; ++ai)
#pragma unroll
            for (int m = 0; m < 4; ++m) { const int r = row0 + ai * 128 + m * 16, b = r >> 11, s = r & 2047;
#pragma unroll
                for (int bj = 0; bj < 2; ++bj) { const f32x4 v0 = acc[ai][bj][m][0], v1 = acc[ai][bj][m][1];
                    u32x4 w; w.x = pk2(v0[0], v0[1]); w.y = pk2(v0[2], v0[3]); w.z = pk2(v1[0], v1[1]); w.w = pk2(v1[2], v1[3]);
                    const int c = cbase + bj * 128 + wc * 32 + 8 * fq;
                    h16_t* p = (sec == 3) ? dst + (size_t)r * E + c : dst + ((size_t)(b * NH + (c >> 7)) * S + s) * HD + (c & 127);
                    *(u32x4*)p = w; } }
        if (kpart != nullptr && sec == 1) {
            const int b = u.pm >> 3, nblk = u.pm & 7;
#pragma unroll
            for (int bj = 0; bj < 2; ++bj) { f32x4 s0 = {0.f, 0.f, 0.f, 0.f}, s1 = {0.f, 0.f, 0.f, 0.f};
#pragma unroll
                for (int ai = 0; ai < 2; ++ai)
#pragma unroll
                    for (int m = 0; m < 4; ++m) { s0 += acc[ai][bj][m][0]; s1 += acc[ai][bj][m][1]; }
#pragma unroll
                for (int e = 0; e < 4; ++e) { s0[e] += xsw<1>(s0[e]); s1[e] += xsw<1>(s1[e]); s0[e] += xsw<2>(s0[e]); s1[e] += xsw<2>(s1[e]);
                                              s0[e] += xsw<4>(s0[e]); s1[e] += xsw<4>(s1[e]); s0[e] += xsw<8>(s0[e]); s1[e] += xsw<8>(s1[e]); }
                if (fr == 0) { const int c = cbase + bj * 128 + wc * 32 + 8 * fq;
                    float* p = kpart + (size_t)wr * NB * NH * 8 * HD + ((size_t)(b * NH + (c >> 7)) * 8 + nblk) * HD + (c & 127);
                    *(f32x4*)p = s0; *(f32x4*)(p + 4) = s1; } }
        }
    }
};
struct EpiResid {
    static constexpr bool PERM = false;
    float* T; const float* x; const float* stats; const float* g; const float* bta; int layer;
    __device__ __forceinline__ void operator()(const f32x4 (&acc)[2][2][4][2], const pg8::Unit& u, int wr, int wc, int fr, int fq) const {
        const int col0 = u.pn * 256 + wc * 32 + 4 * fq, row0 = u.pm * 256 + wr * 64 + fr;
        f32x4 gv[2][2], bv[2][2];
        if (layer) {
#pragma unroll
            for (int bj = 0; bj < 2; ++bj)
#pragma unroll
                for (int n = 0; n < 2; ++n) { gv[bj][n] = *(const f32x4*)(g + col0 + bj * 128 + n * 16); bv[bj][n] = *(const f32x4*)(bta + col0 + bj * 128 + n * 16); } }
#pragma unroll
        for (int ai = 0; ai < 2; ++ai)
#pragma unroll
            for (int m = 0; m < 4; ++m) { const int r = row0 + ai * 128 + m * 16; float mean = 0.f, rstd = 1.f;
                if (layer) { const f32x2 st = *(const f32x2*)(stats + 2 * r); mean = st.x; rstd = st.y; }
#pragma unroll
                for (int bj = 0; bj < 2; ++bj)
#pragma unroll
                    for (int n = 0; n < 2; ++n) { const size_t idx = (size_t)r * D + col0 + bj * 128 + n * 16; f32x4 h;
                        if (layer) h = (*(const f32x4*)(T + idx) - mean) * rstd * gv[bj][n] + bv[bj][n]; else h = *(const f32x4*)(x + idx);
                        *(f32x4*)(T + idx) = DN_ALPHA * h + acc[ai][bj][m][n]; }
                asm volatile("" ::: "memory"); }
    }
};

struct Ctx { int tid, lane, wave, G, bid; unsigned char* lds; };

__device__ __forceinline__ void transpose_phase(const Ctx& c, const float* __restrict__ W, int ldw, int c0, int ncols, h16_t* __restrict__ WT) {
    float (*tile)[65] = (float (*)[65])(c.lds + (c.tid >> 8) * (64 * 65 * 4));
    const int nb = (ncols + 63) / 64, ntiles = (D / 64) * nb, t2 = c.tid & 255, tx = t2 & 63, ty = t2 >> 6;
    for (int it = c.bid * 2; it < ntiles; it += c.G * 2) {
        const int tl = it + (c.tid >> 8); const bool act = tl < ntiles;
        const int kb = tl / nb, cb = tl % nb, k0 = kb * 64, n0 = cb * 64;
        if (act) for (int i = ty; i < 64; i += 4) { const int n = n0 + tx; tile[i][tx] = (n < ncols) ? W[(size_t)(k0 + i) * ldw + c0 + n] : 0.f; }
        __syncthreads();
        if (act) for (int i = ty; i < 64; i += 4) { const int n = n0 + i; if (n < ncols) WT[(size_t)n * D + k0 + tx] = f2h(tile[tx][i]); }
        __syncthreads();
    }
}
__device__ __forceinline__ void cvt_phase(const Ctx& c, const float* __restrict__ x, h16_t* __restrict__ o, size_t n) {
    for (size_t i = ((size_t)c.bid * NTHREADS + c.tid) * 4; i < n; i += (size_t)c.G * NTHREADS * 4) { const f32x4 v = *(const f32x4*)(x + i); *(uint2*)(o + i) = make_uint2(pk2(v.x, v.y), pk2(v.z, v.w)); }
}
__device__ __forceinline__ float wave_sum(float v) { return xadd32(hsum32(v)); }
__device__ __forceinline__ void ln_phase(const Ctx& c, float* T, const float* __restrict__ g, const float* __restrict__ bta, float* stats, h16_t* HB, bool final_layer) {
    const int gw = c.bid * NWAVES + c.wave, NGW = c.G * NWAVES;
    for (int m = gw; m < M; m += NGW) {
        float* row = T + (size_t)m * D; f32x4 v[8]; float s = 0.f;
#pragma unroll
        for (int j = 0; j < 8; ++j) { v[j] = *(const f32x4*)(row + (64 * j + c.lane) * 4); s += (v[j].x + v[j].y) + (v[j].z + v[j].w); }
        const float mean = wave_sum(s) * (1.f / D); float q = 0.f;
#pragma unroll
        for (int j = 0; j < 8; ++j) { v[j] = v[j] - mean; q += (v[j].x * v[j].x + v[j].y * v[j].y) + (v[j].z * v[j].z + v[j].w * v[j].w); }
        const float rstd = rsqrtf(wave_sum(q) * (1.f / D) + LN_EPS);
        if (c.lane == 0) { stats[2 * m] = mean; stats[2 * m + 1] = rstd; }
#pragma unroll
        for (int j = 0; j < 8; ++j) { const int col = (64 * j + c.lane) * 4; const f32x4 o = v[j] * rstd * *(const f32x4*)(g + col) + *(const f32x4*)(bta + col);
            if (final_layer) *(f32x4*)(row + col) = o; else *(uint2*)(HB + (size_t)m * D + col) = make_uint2(pk2(o.x, o.y), pk2(o.z, o.w)); }
    }
}
__device__ __forceinline__ void logf_phase(const Ctx& c, const h16_t* __restrict__ HB, const h16_t* __restrict__ WfT, const float* __restrict__ bf, float* logf) {
    for (int rb = c.bid; rb < M / 32; rb += c.G) {
        const int m = rb * 32 + (c.tid >> 4), j = c.tid & 15;
        const h16_t* a = HB + (size_t)m * D; const h16_t* w = WfT + (size_t)j * D; float s = 0.f;
        for (int k = 0; k < D; k += 8) { const u32x4 av = *(const u32x4*)(a + k), wv = *(const u32x4*)(w + k);
#pragma unroll
            for (int e = 0; e < 4; ++e) { s = fmaf(lo16(av[e]), lo16(wv[e]), s); s = fmaf(hi16(av[e]), hi16(wv[e]), s); } }
        const float xx = s + bf[j];
        logf[(size_t)m * 16 + j] = fminf(xx, 0.f) - log1pf(__expf(-fabsf(xx)));
    }
}
__device__ __forceinline__ void cum_phase(const Ctx& c, const float* __restrict__ logf, float* cum) {
    float* wtot = (float*)c.lds;
    for (int bh = c.bid; bh < NB * NH; bh += c.G) {
        const int b = bh / NH, h = bh % NH; float v[4];
#pragma unroll
        for (int e = 0; e < 4; ++e) v[e] = logf[(size_t)(b * S + 4 * c.tid + e) * NH + h];
        v[1] += v[0]; v[2] += v[1]; v[3] += v[2];
        float incl = v[3];
#pragma unroll
        for (int o = 1; o < 64; o <<= 1) { const float t = __int_as_float(__builtin_amdgcn_ds_bpermute(((c.lane - o) & 63) << 2, __float_as_int(incl))); if (c.lane >= o) incl += t; }
        if (c.lane == 63) wtot[c.wave] = incl;
        __syncthreads();
        float off = incl - v[3];
        for (int w = 0; w < c.wave; ++w) off += wtot[w];
        f32x4 o4 = {v[0] + off, v[1] + off, v[2] + off, v[3] + off};
        *(f32x4*)(cum + (size_t)bh * S + 4 * c.tid) = o4;
        __syncthreads();
    }
}

#ifndef FAST0
#define FAST0 1
#endif
#ifndef FAST1
#define FAST1 1
#endif
#ifndef FAST2
#define FAST2 1
#endif
constexpr int SC_LD = 2064;
struct AttnArgs { const h16_t *Qb, *Kb, *Vb, *Zb; h16_t* G; const float *rel, *kpart, *cum, *logf, *lq1, *lk1, *lq2, *lk2, *subg; float lam_init; };
template <int MODE>
__device__ __forceinline__ void attn_naive_phase(const Ctx& c, const AttnArgs& A) {
    float* sc = (float*)c.lds; float* qs = sc + 16 * SC_LD; float* misc = qs + 16 * 128;
    const int tid = c.tid; const bool act = tid < 256; const int row = (tid >> 4) & 15, sub = tid & 15;
    constexpr int QPB = MODE == 0 ? 8 : 16, NHB = MODE == 0 ? 8 : 16;
    const int nqt = S / QPB, nvb = NB * NHB * nqt;
    for (int vb = c.bid; vb < nvb; vb += c.G) {
        const int qt = vb % nqt, hh = (vb / nqt) % NHB, b = vb / (nqt * NHB);
        const int t0 = qt * QPB, nkeys = t0 + QPB;
        const int qi = MODE == 0 ? (row & 7) : row, comp = MODE == 0 ? (row >> 3) : 0;
        const int hq = MODE == 0 ? 2 * hh + comp : hh;
        const int t = t0 + qi;
        if (act) for (int i = tid; i < 16 * 128; i += 256) { const int r = i >> 7, d = i & 127; const int rq = MODE == 0 ? (r & 7) : r, rh = MODE == 0 ? 2 * hh + (r >> 3) : hh;
            qs[i] = h2f(A.Qb[((size_t)(b * NH + rh) * S + t0 + rq) * HD + d]); }
        float lam = 0.f;
        if (MODE == 0) { if (tid < 64) { float a = A.lq1[tid] * A.lk1[tid] + A.lq1[tid + 64] * A.lk1[tid + 64], cc = A.lq2[tid] * A.lk2[tid] + A.lq2[tid + 64] * A.lk2[tid + 64];
                for (int o = 32; o; o >>= 1) { a += __shfl_xor(a, o); cc += __shfl_xor(cc, o); }
                if (tid == 0) misc[0] = __expf(a) - __expf(cc) + A.lam_init; } }
        __syncthreads();
        if (MODE == 0) lam = misc[0];
        unsigned selbits = 0u; const int own = t0 >> 8;
        if (MODE == 1) {
            if (tid < 16) { float gate[8]; unsigned sb = 0u;
#pragma unroll
                for (int n = 0; n < 8; ++n) { float gsum = 0.f;
                    if (n < own) { const float* k0 = A.kpart + (size_t)((b * NH + hh) * 8 + n) * HD; const float* k1 = k0 + (size_t)NB * NH * 8 * HD;
                        for (int d = 0; d < 128; ++d) gsum = fmaf(qs[tid * 128 + d], (k0[d] + k1[d]) * (1.f / 256.f), gsum); }
                    gate[n] = n < own ? gsum : NEGF; }
#pragma unroll
                for (int k = 0; k < 3; ++k) { int best = -1; float bv = 0.f;
#pragma unroll
                    for (int n = 0; n < 8; ++n) if (!((sb >> n) & 1u) && (best < 0 || gate[n] > bv)) { best = n; bv = gate[n]; }
                    sb |= 1u << best; }
                misc[16 + tid] = __uint_as_float(sb & ((1u << own) - 1u)); }
            __syncthreads();
            selbits = __float_as_uint(misc[16 + row]);
        }
        if (act) {
            const float cq = MODE == 2 ? A.cum[(size_t)(b * NH + hh) * S + t] : 0.f;
            for (int s = sub; s < nkeys; s += 16) {
                const h16_t* kr = A.Kb + ((size_t)(b * NH + hq) * S + s) * HD; float dot = 0.f;
                for (int d = 0; d < 128; d += 8) { const u32x4 kv = *(const u32x4*)(kr + d); const float* qq = qs + row * 128 + d;
#pragma unroll
                    for (int j = 0; j < 4; ++j) { dot = fmaf(qq[2 * j], lo16(kv[j]), dot); dot = fmaf(qq[2 * j + 1], hi16(kv[j]), dot); } }
                float lg = dot * SCALE; bool ok = s <= t;
                if (MODE == 0 || MODE == 1) lg += A.rel[t5_bucket(t - s > 0 ? t - s : 0) * 16 + hq];
                if (MODE == 1) { const int blk = s >> 8; if (blk != own) ok = (selbits >> blk) & 1u; }
                if (MODE == 2) lg += cq - A.cum[(size_t)(b * NH + hh) * S + s];
                sc[row * SC_LD + s] = ok ? lg : NEGF;
            }
        }
        __syncthreads();
        if (act) {
            float mx = NEGF;
            for (int s = sub; s < nkeys; s += 16) mx = fmaxf(mx, sc[row * SC_LD + s]);
            for (int o = 8; o; o >>= 1) mx = fmaxf(mx, __shfl_xor(mx, o));
            float sum = 0.f;
            for (int s = sub; s < nkeys; s += 16) { const float p = __expf(sc[row * SC_LD + s] - mx); sc[row * SC_LD + s] = p; sum += p; }
            for (int o = 8; o; o >>= 1) sum += __shfl_xor(sum, o);
            const float inv = 1.f / sum;
            for (int s = sub; s < nkeys; s += 16) sc[row * SC_LD + s] *= inv;
        }
        __syncthreads();
        if (act) {
            if (MODE == 0) {
                const int q2 = tid >> 5, dl = tid & 31, d0 = dl * 8;
                const int vh = 2 * hh + (d0 >> 7), dd = d0 & 127;
                float o[8];
#pragma unroll
                for (int j = 0; j < 8; ++j) o[j] = 0.f;
                for (int s = 0; s < nkeys; ++s) { const float a = sc[q2 * SC_LD + s] - lam * sc[(8 + q2) * SC_LD + s];
                    const u32x4 vv = *(const u32x4*)(A.Vb + ((size_t)(b * NH + vh) * S + s) * HD + dd);
#pragma unroll
                    for (int j = 0; j < 4; ++j) { o[2 * j] = fmaf(a, lo16(vv[j]), o[2 * j]); o[2 * j + 1] = fmaf(a, hi16(vv[j]), o[2 * j + 1]); } }
                float ss = 0.f;
#pragma unroll
                for (int j = 0; j < 8; ++j) ss += o[j] * o[j];
                for (int off = 16; off; off >>= 1) ss += __shfl_xor(ss, off);
                const float r = rsqrtf(ss * (1.f / 256.f) + RMS_EPS) * (1.f - A.lam_init);
                const size_t gi = (size_t)(b * S + t0 + q2) * E + hh * 256 + d0;
                const u32x4 zv = *(const u32x4*)(A.Zb + gi); u32x4 ov;
#pragma unroll
                for (int j = 0; j < 4; ++j) { const float a0 = o[2 * j] * r * A.subg[d0 + 2 * j] * siluf(lo16(zv[j])), a1 = o[2 * j + 1] * r * A.subg[d0 + 2 * j + 1] * siluf(hi16(zv[j]));
                    ov[j] = pk2(a0, a1); }
                *(u32x4*)(A.G + gi) = ov;
            } else {
                const int d0 = sub * 8; float o[8];
#pragma unroll
                for (int j = 0; j < 8; ++j) o[j] = 0.f;
                for (int s = 0; s < nkeys; ++s) { const float a = sc[row * SC_LD + s];
                    const u32x4 vv = *(const u32x4*)(A.Vb + ((size_t)(b * NH + hh) * S + s) * HD + d0);
#pragma unroll
                    for (int j = 0; j < 4; ++j) { o[2 * j] = fmaf(a, lo16(vv[j]), o[2 * j]); o[2 * j + 1] = fmaf(a, hi16(vv[j]), o[2 * j + 1]); } }
                const size_t gi = (size_t)(b * S + t) * E + hh * 128 + d0;
                const u32x4 zv = *(const u32x4*)(A.Zb + gi); u32x4 ov;
#pragma unroll
                for (int j = 0; j < 4; ++j) ov[j] = pk2(o[2 * j] * siluf(lo16(zv[j])), o[2 * j + 1] * siluf(hi16(zv[j])));
                *(u32x4*)(A.G + gi) = ov;
            }
        }
        __syncthreads();
    }
}

namespace att {
typedef short s16x4 __attribute__((ext_vector_type(4)));
typedef float f32x16 __attribute__((ext_vector_type(16)));
constexpr int QBLK = 32, KVBLK = 64, SHM = KVBLK * HD * 2;
constexpr float THR = 8.f;
constexpr int L_V = 0, L_K = 2 * SHM;
#define KSWZ(row, colB) ((row) * 256 + ((colB) ^ (((row) & 7) << 4)))
#define SBAR() __builtin_amdgcn_sched_barrier(0)
__device__ __forceinline__ int v_st(int k, int c) { const int kk = (k & ~0xC) | ((k & 4) << 1) | ((k & 8) >> 1); return ((kk >> 3) * 4 + (c >> 5)) * 512 + ((kk & 7) * 32 + (c & 31)) * 2; }
__device__ __forceinline__ int v_rd_base(int lane) { return ((lane & 3) << 3) | (((lane >> 2) & 3) << 6) | (((lane >> 4) & 1) << 5) | (((lane >> 5) & 1) << 8); }
constexpr int v_rd_off(int d0, int ks, int half) { return d0 * 512 + ks * 4096 + half * 2048; }
__device__ __forceinline__ int crow(int r, int hi) { return (r & 3) + 8 * (r >> 2) + 4 * hi; }
__device__ __forceinline__ f16x8 ld8(const h16_t* p) { return *reinterpret_cast<const f16x8*>(p); }

template <int NCOMP> struct Lay {
    static constexpr int WS = L_K + 2 * NCOMP * SHM;
    static constexpr int OST = WS + NWAVES * 512;
    static constexpr int TAB = OST + (NCOMP == 1 ? 8 : 4) * 8192;
    static constexpr int MISC = TAB, LUT = TAB + 256, BIG = LUT + 2 * 352 * 4, END = BIG + 8192;
};
static_assert(Lay<1>::END <= XB_LDS_OFF && Lay<2>::END <= XB_LDS_OFF, "attention LDS map");

__device__ __forceinline__ void mask_tile(f32x16& p0, f32x16& p1, int dq) {
    const float NEG = -__builtin_inff();
#pragma unroll
    for (int r = 0; r < 16; ++r) { const int cc = (r & 3) + 8 * (r >> 2); if (dq - cc < 0) p0[r] = NEG; if (dq - cc - 32 < 0) p1[r] = NEG; }
}
__device__ __forceinline__ void bias_mask_tile(f32x16& p0, f32x16& p1, int dq, const float* lut) {
    const float NEG = -__builtin_inff(); const float* lp = lut + (dq + 128 - 63);
    float b0[16], b1[16];
#pragma unroll
    for (int r = 0; r < 16; ++r) { const int cc = (r & 3) + 8 * (r >> 2); b0[r] = lp[63 - cc]; b1[r] = lp[63 - cc - 32]; }
#pragma unroll
    for (int r = 0; r < 16; ++r) { const int cc = (r & 3) + 8 * (r >> 2); p0[r] = (dq - cc < 0) ? NEG : p0[r] + b0[r]; p1[r] = (dq - cc - 32 < 0) ? NEG : p1[r] + b1[r]; }
}
#define PK4(P, B_, OUT) do { unsigned a0 = pk2(P[B_+0], P[B_+1]), a1 = pk2(P[B_+2], P[B_+3]);                          \
        unsigned b0 = pk2(P[B_+4], P[B_+5]), b1 = pk2(P[B_+6], P[B_+7]);                                             \
        auto r0 = __builtin_amdgcn_permlane32_swap(a0, b0, false, false); auto r1 = __builtin_amdgcn_permlane32_swap(a1, b1, false, false); \
        u32x4 w = {r0[0], r1[0], r0[1], r1[1]}; OUT = __builtin_bit_cast(f16x8, w); } while (0)
__device__ __forceinline__ void partialSM(f32x16& p0, f32x16& p1, float& m_reg, float& alpha, float& ps0, f16x8& pa0, f16x8& pa1) {
    float pmax = p0[0];
#pragma unroll
    for (int r = 1; r < 16; ++r) pmax = fmaxf(pmax, p0[r]);
#pragma unroll
    for (int r = 0; r < 16; ++r) pmax = fmaxf(pmax, p1[r]);
    { auto rr = __builtin_amdgcn_permlane32_swap(__float_as_uint(pmax), __float_as_uint(pmax), false, false);
      pmax = fmaxf(__uint_as_float(rr[0]), __uint_as_float(rr[1])); }
    constexpr float C2 = 1.4426950408889634f * SCALE;
    float mn;
    if (__builtin_expect(__all((pmax - m_reg) * SCALE <= THR), 1)) { mn = m_reg; alpha = 1.f; }
    else { mn = fmaxf(m_reg, pmax); alpha = __builtin_amdgcn_exp2f((m_reg - mn) * C2); m_reg = mn; }
    const float mnL = -mn * C2;
#pragma unroll
    for (int r = 0; r < 16; ++r) p0[r] = fmaf(p0[r], C2, mnL);
#pragma unroll
    for (int r = 0; r < 16; ++r) p1[r] = fmaf(p1[r], C2, mnL);
#pragma unroll
    for (int r = 0; r < 16; ++r) p0[r] = __builtin_amdgcn_exp2f(p0[r]);
    float ps = 0;
#pragma unroll
    for (int r = 0; r < 16; ++r) ps += p0[r];
    ps0 = ps;
    PK4(p0, 0, pa0); PK4(p0, 8, pa1);
}
__device__ __forceinline__ void finishSM(f32x16& p1, float alpha, float ps0, float& l_reg, f16x8& pa2, f16x8& pa3) {
#pragma unroll
    for (int r = 0; r < 16; ++r) p1[r] = __builtin_amdgcn_exp2f(p1[r]);
    float ps = ps0;
#pragma unroll
    for (int r = 0; r < 16; ++r) ps += p1[r];
    { auto rr = __builtin_amdgcn_permlane32_swap(__float_as_uint(ps), __float_as_uint(ps), false, false);
      ps = __uint_as_float(rr[0]) + __uint_as_float(rr[1]); }
    l_reg = l_reg * alpha + ps;
    PK4(p1, 0, pa2); PK4(p1, 8, pa3);
}
#undef PK4
template <int KB, int NCOMP>
__device__ __forceinline__ void qkt(f32x16& p0, f32x16& p1, const char* Kc_lds, int kswz0, const f16x8* qr) {
    int kb_ = kswz0; asm volatile("" : "+v"(kb_));
#pragma unroll
    for (int d0 = 0; d0 < 8; ++d0) { const char* a = Kc_lds + KB * (NCOMP * SHM) + (kb_ ^ ((d0 & 3) << 5)) + (d0 >> 2) * 128;
        const f16x8 b0 = *reinterpret_cast<const f16x8*>(a);
        const f16x8 b1 = *reinterpret_cast<const f16x8*>(a + 32 * 256);
        p0 = __builtin_amdgcn_mfma_f32_32x32x16_f16(b0, qr[d0], p0, 0, 0, 0);
        p1 = __builtin_amdgcn_mfma_f32_32x32x16_f16(b1, qr[d0], p1, 0, 0, 0); }
}
template <int VB>
__device__ __forceinline__ void pv_tile(f32x16* o, int vb0, f16x8 pa0, f16x8 pa1, f16x8 pa2, f16x8 pa3) {
#define TRRD(dst, off) asm volatile("ds_read_b64_tr_b16 %0, %1 offset:%2" : "=&v"(dst) : "v"(vb0), "i"(off) : "memory")
#define PKV(l, h) __builtin_bit_cast(f16x8, (short __attribute__((ext_vector_type(8)))){l[0], l[1], l[2], l[3], h[0], h[1], h[2], h[3]})
#define PV_D0(d0) do { s16x4 l0, l1, l2, l3, h0, h1, h2, h3; constexpr int b_ = L_V + VB * SHM + v_rd_off(d0, 0, 0); \
        TRRD(l0, b_); TRRD(h0, b_ + 2048); TRRD(l1, b_ + 4096); TRRD(h1, b_ + 6144); TRRD(l2, b_ + 8192); TRRD(h2, b_ + 10240); TRRD(l3, b_ + 12288); TRRD(h3, b_ + 14336); \
        asm volatile("s_waitcnt lgkmcnt(0)" ::: "memory"); SBAR();   \
        o[d0] = __builtin_amdgcn_mfma_f32_32x32x16_f16(pa0, PKV(l0, h0), o[d0], 0, 0, 0);   \
        o[d0] = __builtin_amdgcn_mfma_f32_32x32x16_f16(pa1, PKV(l1, h1), o[d0], 0, 0, 0);   \
        o[d0] = __builtin_amdgcn_mfma_f32_32x32x16_f16(pa2, PKV(l2, h2), o[d0], 0, 0, 0);   \
        o[d0] = __builtin_amdgcn_mfma_f32_32x32x16_f16(pa3, PKV(l3, h3), o[d0], 0, 0, 0); } while (0)
    PV_D0(0); PV_D0(1); PV_D0(2); PV_D0(3);
#undef PV_D0
#undef PKV
#undef TRRD
}

struct BlockRef { unsigned qoff, koff, voff; int P0; int b, h, half, x; };
template <int NCOMP> struct Seam { f16x8 qr[8]; f16x8 st[2 * NCOMP]; };
struct BlkCtx { unsigned selbits; int own; };
struct EpiArgs { const h16_t* Zb; h16_t* G; const float* subg; float lam_init; };

constexpr size_t HSTR = (size_t)S * HD;
#define ROW(p, k0, rr) ((p) + (size_t)((k0) + (rr)) * HD + sc)
#define VMW() asm volatile("s_waitcnt vmcnt(0)" ::: "memory")
#define VMWN(n) asm volatile("s_waitcnt vmcnt(%0)" :: "i"(n) : "memory")

__device__ __forceinline__ f16x8 ldg8(const void* ubase, unsigned off) { return *reinterpret_cast<const f16x8*>((const char*)ubase + off); }
template <int NCOMP>
__device__ __forceinline__ void sload_k(Seam<NCOMP>& S_, const h16_t* Kp, int k0, unsigned loff) {
    const char* kb_ = (const char*)Kp + (size_t)k0 * (HD * 2);
#pragma unroll
    for (int cc = 0; cc < NCOMP; ++cc) { S_.st[2 * cc] = ldg8(kb_ + cc * (HSTR * 2), loff); S_.st[2 * cc + 1] = ldg8(kb_ + cc * (HSTR * 2) + 32 * HD * 2, loff); }
}
template <int NCOMP>
__device__ __forceinline__ void sload_v(Seam<NCOMP>& S_, const h16_t* Vp, int k0, unsigned loff) {
    const char* vb_ = (const char*)Vp + (size_t)k0 * (HD * 2);
    S_.st[0] = ldg8(vb_, loff); S_.st[1] = ldg8(vb_ + 32 * HD * 2, loff);
}
template <int NCOMP>
__device__ __forceinline__ void swrite_k(const Seam<NCOMP>& S_, char* lds, int bf, unsigned loff_in) {
    unsigned lo_ = loff_in; asm volatile("" : "+v"(lo_)); const int kws = (int)(lo_ ^ (((lo_ >> 8) & 7u) << 4));
#pragma unroll
    for (int cc = 0; cc < NCOMP; ++cc) { *(f16x8*)(lds + L_K + (bf * NCOMP + cc) * SHM + kws) = S_.st[2 * cc]; *(f16x8*)(lds + L_K + (bf * NCOMP + cc) * SHM + kws + 32 * 256) = S_.st[2 * cc + 1]; }
}
template <int NCOMP>
__device__ __forceinline__ void swrite_v(const Seam<NCOMP>& S_, char* lds, int bf, unsigned loff_in) {
    unsigned lo_ = loff_in; asm volatile("" : "+v"(lo_)); const int vst0 = v_st((int)(lo_ >> 8), (int)((lo_ & 255u) >> 1));
    *(f16x8*)(lds + L_V + bf * SHM + vst0) = S_.st[0]; *(f16x8*)(lds + L_V + bf * SHM + vst0 + 8192) = S_.st[1];
}
template <int NCOMP>
__device__ __forceinline__ void att_prime(const BlockRef& cur, const h16_t* Qb, const h16_t* Kb, const h16_t* Vb, char* lds, Seam<NCOMP>& S_, int tid) {
    const int wid = __builtin_amdgcn_readfirstlane(tid >> 6), lane = tid & 63, r32 = lane & 31, hi = lane >> 5;
    const int comp = NCOMP == 2 ? (wid >> 2) : 0, wq = NCOMP == 2 ? (wid & 3) : wid;
    const int sr = tid >> 4, sc = (tid & 15) * 8; const unsigned loff = (unsigned)(sr * HD + sc) * 2u;
    { const char* qb_ = (const char*)(Qb + cur.qoff + comp * HSTR + (size_t)(wq * QBLK) * HD); const unsigned qo_ = (unsigned)(r32 * HD + hi * 8) * 2u;
#pragma unroll
      for (int d0 = 0; d0 < 8; ++d0) S_.qr[d0] = ldg8(qb_ + d0 * 32, qo_); }
    sload_k<NCOMP>(S_, Kb + cur.koff, 0, loff); VMW(); swrite_k<NCOMP>(S_, lds, 0, loff); SBAR(); sload_v<NCOMP>(S_, Vb + cur.voff, 0, loff);
    __syncthreads();
}

template <int MODE>
__device__ __forceinline__ void epilogue_part(const BlockRef& cur, char* lds, f32x16 (&o)[4], float l_reg, const EpiArgs& ea, int tid_in) {
    constexpr int NCOMP = MODE == 0 ? 2 : 1;
    typedef Lay<NCOMP> L;
    int tid = tid_in; asm volatile("" : "+v"(tid));
    const int wid = __builtin_amdgcn_readfirstlane(tid >> 6), lane = tid & 63, r32 = lane & 31, hi = lane >> 5;
    const int comp = NCOMP == 2 ? (wid >> 2) : 0, wq = NCOMP == 2 ? (wid & 3) : wid;
    float* ws = (float*)(lds + L::WS) + wid * 128; float* li_l = ws;
    if (hi == 0) li_l[r32] = l_reg; asm volatile("s_waitcnt lgkmcnt(0)" ::: "memory");
    float rli[16];
#pragma unroll
    for (int r = 0; r < 16; ++r) rli[r] = __builtin_amdgcn_rcpf(li_l[crow(r, hi)]);
    if (MODE != 0) {
        h16_t* stg = (h16_t*)(lds + L::OST) + wid * 4096;
#pragma unroll
        for (int r = 0; r < 16; ++r) { const int orow = crow(r, hi);
#pragma unroll
            for (int d0 = 0; d0 < 4; ++d0) stg[orow * 128 + d0 * 32 + r32] = f2h(o[d0][r] * rli[r]); }
        asm volatile("s_waitcnt lgkmcnt(0)" ::: "memory");
        const size_t gbase = ((size_t)(cur.b * S + cur.P0 + wq * QBLK) * E + cur.h * HD) * 2;
        const unsigned go_ = (unsigned)((lane >> 4) * E + (lane & 15) * 8) * 2u;
#pragma unroll
        for (int i = 0; i < 8; ++i) { const int row = i * 4 + (lane >> 4), ch = lane & 15;
            const u32x4 ov = *(const u32x4*)(stg + row * 128 + ch * 8);
            const u32x4 zv = *(const u32x4*)((const char*)ea.Zb + gbase + (size_t)i * (4 * E * 2) + go_); u32x4 w;
#pragma unroll
            for (int e = 0; e < 4; ++e) w[e] = pk2(lo16(ov[e]) * siluf(lo16(zv[e])), hi16(ov[e]) * siluf(hi16(zv[e])));
            *(u32x4*)((char*)ea.G + gbase + (size_t)i * (4 * E * 2) + go_) = w; SBAR(); }
    } else {
        unsigned* xch = (unsigned*)(lds + L::OST) + wq * 2048;
        if (comp == 1) { const float lam_ = ((const float*)(lds + L::MISC))[0];
#pragma unroll
            for (int d0 = 0; d0 < 4; ++d0)
#pragma unroll
                for (int r = 0; r < 16; r += 2) xch[(d0 * 8 + (r >> 1)) * 64 + lane] = pk2(o[d0][r] * rli[r] * lam_, o[d0][r + 1] * rli[r + 1] * lam_);
        }
        asm volatile("s_waitcnt lgkmcnt(0)" ::: "memory");
        __syncthreads();
        if (comp == 0) {
            float ssq[16];
#pragma unroll
            for (int r = 0; r < 16; ++r) ssq[r] = 0.f;
#pragma unroll
            for (int d0 = 0; d0 < 4; ++d0)
#pragma unroll
                for (int r = 0; r < 16; r += 2) { const unsigned w = xch[(d0 * 8 + (r >> 1)) * 64 + lane];
                    o[d0][r] = o[d0][r] * rli[r] - lo16(w); o[d0][r + 1] = o[d0][r + 1] * rli[r + 1] - hi16(w);
                    ssq[r] += o[d0][r] * o[d0][r]; ssq[r + 1] += o[d0][r + 1] * o[d0][r + 1]; }
#pragma unroll
            for (int r = 0; r < 16; ++r) ssq[r] = hsum32(ssq[r]);
            float* ssq_l = ws + 64;
            asm volatile("s_waitcnt lgkmcnt(0)" ::: "memory");
            h16_t* stg = (h16_t*)xch;
#pragma unroll
            for (int r = 0; r < 16; ++r) { const int orow = crow(r, hi);
#pragma unroll
                for (int d0 = 0; d0 < 4; ++d0) stg[orow * 128 + d0 * 32 + r32] = f2h(o[d0][r]); }
            const size_t gbase = ((size_t)(cur.b * S + cur.P0 + wq * QBLK) * E + cur.h * 256) * 2;
            const unsigned go_ = (unsigned)((lane >> 4) * E + (lane & 15) * 8) * 2u;
            if (cur.half == 0) {
                if (r32 == 0) {
#pragma unroll
                    for (int r = 0; r < 16; ++r) ssq_l[crow(r, hi)] = ssq[r]; }
                asm volatile("s_waitcnt lgkmcnt(0)" ::: "memory");
#pragma unroll
                for (int i = 0; i < 8; ++i) { const int row = i * 4 + (lane >> 4), ch = lane & 15;
                    *(u32x4*)((char*)ea.G + gbase + (size_t)i * (4 * E * 2) + go_) = *(const u32x4*)(stg + row * 128 + ch * 8); }
            } else {
                if (r32 == 0) {
#pragma unroll
                    for (int r = 0; r < 16; ++r) { const int orow = crow(r, hi); ssq_l[orow] = rsqrtf((ssq_l[orow] + ssq[r]) * (1.f / 256.f) + RMS_EPS) * (1.f - ea.lam_init); } }
                asm volatile("s_waitcnt vmcnt(0) lgkmcnt(0)" ::: "memory");
#pragma unroll
                for (int i = 0; i < 8; ++i) { const int row = i * 4 + (lane >> 4), ch = lane & 15; const float rs = ssq_l[row];
                    const size_t g0 = gbase + (size_t)i * (4 * E * 2), g1 = g0 + 256;
                    const u32x4 u1 = *(const u32x4*)(stg + row * 128 + ch * 8), u0 = *(const u32x4*)((const char*)ea.G + g0 + go_);
                    const u32x4 z0 = *(const u32x4*)((const char*)ea.Zb + g0 + go_), z1 = *(const u32x4*)((const char*)ea.Zb + g1 + go_);
                    const f32x4 ga = *(const f32x4*)(ea.subg + ch * 8), gb = *(const f32x4*)(ea.subg + ch * 8 + 4), gc = *(const f32x4*)(ea.subg + 128 + ch * 8), gd = *(const f32x4*)(ea.subg + 128 + ch * 8 + 4);
                    const float g0v[8] = {ga[0], ga[1], ga[2], ga[3], gb[0], gb[1], gb[2], gb[3]}, g1v[8] = {gc[0], gc[1], gc[2], gc[3], gd[0], gd[1], gd[2], gd[3]};
                    u32x4 w0, w1;
#pragma unroll
                    for (int e = 0; e < 4; ++e) {
                        w0[e] = pk2(lo16(u0[e]) * rs * g0v[2 * e] * siluf(lo16(z0[e])), hi16(u0[e]) * rs * g0v[2 * e + 1] * siluf(hi16(z0[e])));
                        w1[e] = pk2(lo16(u1[e]) * rs * g1v[2 * e] * siluf(lo16(z1[e])), hi16(u1[e]) * rs * g1v[2 * e + 1] * siluf(hi16(z1[e]))); }
                    *(u32x4*)((char*)ea.G + g0 + go_) = w0; *(u32x4*)((char*)ea.G + g1 + go_) = w1; SBAR(); }
            }
        }
    }
}

template <int MODE>
__device__ __forceinline__ void att_block(const BlockRef& cur, const BlockRef& nxt, const h16_t* Qb, const h16_t* Kb, const h16_t* Vb, char* lds, Seam<(MODE == 0 ? 2 : 1)>& S_, const BlkCtx& bc, const EpiArgs& ea, int tid_in) {
    constexpr int NCOMP = MODE == 0 ? 2 : 1, QROWS = 256 / NCOMP;
    typedef Lay<NCOMP> L;
    int tid = tid_in; asm volatile("" : "+v"(tid));
    const int wid = __builtin_amdgcn_readfirstlane(tid >> 6), lane = tid & 63, r32 = lane & 31, hi = lane >> 5;
    const int comp = NCOMP == 2 ? (wid >> 2) : 0, wq = NCOMP == 2 ? (wid & 3) : wid;
    const int NT = (cur.P0 + QROWS) / KVBLK;
    const int qlo = cur.P0 + wq * QBLK, qm = qlo + r32 - 4 * hi;
    const char* Kc_lds = lds + L_K + comp * SHM;
    float* ws = (float*)(lds + L::WS) + wid * 128; float* li_l = ws; float* al_l = ws + 32;
    const float* lut = (const float*)(lds + L::LUT) + comp * 352;
    const float* cumS = (const float*)(lds + L::BIG);
    float m_reg = -1e30f, l_reg = 0; f32x16 o[4] = {};
    const int sr = tid >> 4, sc = (tid & 15) * 8; const int kswz0 = KSWZ(r32, hi * 16);
    const int vb0 = (int)(uintptr_t)lds + v_rd_base(lane);
    const unsigned loff = (unsigned)(sr * HD + sc) * 2u;
    const h16_t* Kh = Kb + cur.koff; const h16_t* Vh = Vb + cur.voff;
#define RESC(a) do { if (__any((a) < 1.f)) { if (hi == 0) al_l[r32] = (a); asm volatile("s_waitcnt lgkmcnt(0)" ::: "memory");              \
                     _Pragma("unroll") for (int d_ = 0; d_ < 4; ++d_) _Pragma("unroll") for (int r = 0; r < 16; ++r) o[d_][r] *= al_l[crow(r, hi)]; } } while (0)
#define KBASE(t) ((t) * KVBLK)
#define T_ABOVE(t) (KBASE(t) > qlo + QBLK - 1)
#define T_NEAR(t) (KBASE(t) + KVBLK - 1 >= qlo - 112)
#define MKINIT(i0, i1, t) do { const int kb_ = KBASE(t);                                                                                  \
        if (MODE == 2) { const float* cp_ = cumS + kb_ + 4 * hi; const float cq_ = cumS[qlo + r32];                                                                \
            _Pragma("unroll") for (int g_ = 0; g_ < 4; ++g_) { const f32x4 c0_ = *(const f32x4*)(cp_ + 8 * g_), c1_ = *(const f32x4*)(cp_ + 32 + 8 * g_); \
                _Pragma("unroll") for (int e_ = 0; e_ < 4; ++e_) { i0[4 * g_ + e_] = cq_ - c0_[e_]; i1[4 * g_ + e_] = cq_ - c1_[e_]; } } }          \
        else { float v_ = T_NEAR(t) ? 0.f : lut[328];                                                                               \
            if (MODE == 1) { const int blk_ = kb_ >> 8; if (blk_ != bc.own && !((bc.selbits >> blk_) & 1u)) v_ = -__builtin_inff(); } \
            _Pragma("unroll") for (int r = 0; r < 16; ++r) { i0[r] = v_; i1[r] = v_; } } } while (0)
#define MASKT(P0_, P1_, t) do { const int kb_ = KBASE(t);                                                                         \
        if (T_ABOVE(t)) { const float NEG_ = -__builtin_inff(); _Pragma("unroll") for (int r = 0; r < 16; ++r) { P0_[r] = NEG_; P1_[r] = NEG_; } } \
        else if (MODE == 2) { if (kb_ + KVBLK - 1 > qlo) mask_tile(P0_, P1_, qm - kb_); }                                          \
        else if (T_NEAR(t)) bias_mask_tile(P0_, P1_, qm - kb_, lut); } while (0)
    constexpr int NQL = 8;
#define SEAM_K0() do { VMWN(NQL); swrite_k<NCOMP>(S_, lds, 0, loff); SBAR(); sload_v<NCOMP>(S_, Vb + nxt.voff, 0, loff); SBAR(); } while (0)
    f32x16 pA0, pA1, pB0, pB1; float alA, alB, psA, psB; f16x8 pa0, pa1, pa2, pa3;
    VMW(); swrite_v<NCOMP>(S_, lds, 0, loff); SBAR();
    sload_k<NCOMP>(S_, Kh, KBASE(1), loff);
    MKINIT(pA0, pA1, 0);
    SBAR(); qkt<0, NCOMP>(pA0, pA1, Kc_lds, kswz0, S_.qr);
    VMW(); swrite_k<NCOMP>(S_, lds, 1, loff); SBAR(); sload_v<NCOMP>(S_, Vh, KBASE(1), loff); SBAR();
    MASKT(pA0, pA1, 0); partialSM(pA0, pA1, m_reg, alA, psA, pa0, pa1);
    VMW(); swrite_v<NCOMP>(S_, lds, 1, loff); SBAR(); if (NT > 2) sload_k<NCOMP>(S_, Kh, KBASE(2), loff);
    __syncthreads();
#define HALF_STEP(PX0, PX1, alX, psX, PY1, alY, psY, t, KB, VB, SB) do {                                                          \
        MKINIT(PX0, PX1, t);                                                                                                  \
        SBAR(); qkt<KB, NCOMP>(PX0, PX1, Kc_lds, kswz0, S_.qr);                                                             \
        finishSM(PY1, alY, psY, l_reg, pa2, pa3); SBAR();                                                                     \
        if ((t) + 1 < NT) { VMW(); swrite_k<NCOMP>(S_, lds, SB, loff); SBAR(); sload_v<NCOMP>(S_, Vh, KBASE((t) + 1), loff); SBAR(); } \
        pv_tile<VB>(o, vb0, pa0, pa1, pa2, pa3); MASKT(PX0, PX1, (t)); partialSM(PX0, PX1, m_reg, alX, psX, pa0, pa1);               \
        __syncthreads();                                                                                                      \
        if ((t) + 1 < NT) { VMW(); swrite_v<NCOMP>(S_, lds, SB, loff); SBAR(); if ((t) + 2 < NT) sload_k<NCOMP>(S_, Kh, KBASE((t) + 2), loff); } \
        RESC(alX); __syncthreads(); } while (0)
    for (int t = 1; t + 1 < NT; t += 2) {
        HALF_STEP(pB0, pB1, alB, psB, pA1, alA, psA, t, 1, 0, 0);
        HALF_STEP(pA0, pA1, alA, psA, pB1, alB, psB, t + 1, 0, 1, 1);
    }
    MKINIT(pB0, pB1, NT - 1);
    SBAR(); qkt<1, NCOMP>(pB0, pB1, Kc_lds, kswz0, S_.qr); SBAR();
    sload_k<NCOMP>(S_, Kb + nxt.koff, 0, loff); SBAR();
    { const char* qb_ = (const char*)(Qb + nxt.qoff + comp * HSTR + (size_t)(wq * QBLK) * HD); const unsigned qo_ = (unsigned)(r32 * HD + hi * 8) * 2u;
#pragma unroll
        for (int d0 = 0; d0 < 8; ++d0) S_.qr[d0] = ldg8(qb_ + d0 * 32, qo_); }
    SBAR();
    finishSM(pA1, alA, psA, l_reg, pa2, pa3); SBAR();
    pv_tile<0>(o, vb0, pa0, pa1, pa2, pa3);
    MASKT(pB0, pB1, NT - 1); partialSM(pB0, pB1, m_reg, alB, psB, pa0, pa1); __syncthreads(); RESC(alB);
    finishSM(pB1, alB, psB, l_reg, pa2, pa3); SBAR(); pv_tile<1>(o, vb0, pa0, pa1, pa2, pa3);
    SBAR(); SEAM_K0();
    epilogue_part<MODE>(cur, lds, o, l_reg, ea, tid_in);
    __syncthreads();
#undef RESC
#undef KBASE
#undef T_ABOVE
#undef T_NEAR
#undef MKINIT
#undef MASKT
#undef SEAM_K0
#undef HALF_STEP
}

template <int MODE>
__device__ __forceinline__ BlockRef att_ref(int item, int j) {
    BlockRef r;
    if (MODE == 0) { const int bh = item >> 3, y = item & 7, x = (j < 2) ? y : 15 - y; r.b = bh >> 3; r.h = bh & 7; r.half = j & 1; r.x = x; r.P0 = x * 128;
        const unsigned hb = (unsigned)(r.b * NH + 2 * r.h) * (unsigned)HSTR; r.qoff = hb + (unsigned)r.P0 * HD; r.koff = hb; r.voff = hb + r.half * (unsigned)HSTR; }
    else { const int bh = item >> 2, y = item & 3, x = (j == 0) ? y : 7 - y; r.b = bh >> 4; r.h = bh & 15; r.half = 0; r.x = x; r.P0 = x * 256;
        const unsigned hb = (unsigned)(r.b * NH + r.h) * (unsigned)HSTR; r.qoff = hb + (unsigned)r.P0 * HD; r.koff = hb; r.voff = hb; }
    return r;
}
template <int MODE>
__device__ __forceinline__ void attn_phase(const Ctx& c, const AttnArgs& A) {
    constexpr int NCOMP = MODE == 0 ? 2 : 1, NBLK = MODE == 0 ? 4 : 2, NITEMS = 256;
    typedef Lay<NCOMP> L;
    char* lds = (char*)c.lds;
    const int tid = c.tid, wid = c.wave, lane = c.lane, r32 = lane & 31, hi = lane >> 5;
    const int comp = NCOMP == 2 ? (wid >> 2) : 0, wq = NCOMP == 2 ? (wid & 3) : wid;
    const int vcu = (c.G % 8 == 0) ? (c.bid % 8) * (c.G / 8) + c.bid / 8 : c.bid;
    float* misc = (float*)(lds + L::MISC); float* lutw = (float*)(lds + L::LUT); float* big = (float*)(lds + L::BIG);
    EpiArgs ea{A.Zb, A.G, A.subg, A.lam_init};
    if (MODE == 0) {
        if (tid < 64) { float a = A.lq1[tid] * A.lk1[tid] + A.lq1[tid + 64] * A.lk1[tid + 64], cc = A.lq2[tid] * A.lk2[tid] + A.lq2[tid + 64] * A.lk2[tid + 64];
            a = wave_sum(a); cc = wave_sum(cc); if (tid == 0) misc[0] = __expf(a) - __expf(cc) + A.lam_init; }
        __syncthreads();
    }
    Seam<NCOMP> S_;
    int item = vcu; if (item >= NITEMS) return;
    int j = 0; BlockRef cur = att_ref<MODE>(item, 0);
    att_prime<NCOMP>(cur, A.Qb, A.Kb, A.Vb, lds, S_, tid);
    bool new_item = true;
    for (;;) {
        if (new_item) {
            int tid = c.tid; asm volatile("" : "+v"(tid)); const int lane = tid & 63;
            if (MODE != 2) { for (int i = tid; i < NCOMP * 352; i += NTHREADS) { const int cc = i / 352, ii = i % 352, dist = ii - 128; const int hq = MODE == 0 ? 2 * cur.h + cc : cur.h;
                    lutw[i] = A.rel[t5_bucket(dist > 0 ? dist : 0) * 16 + hq] * (1.f / SCALE); } }
            if (MODE == 1) { for (int i = tid; i < 8 * 128; i += NTHREADS) { const float* k0 = A.kpart + (size_t)(cur.b * NH + cur.h) * 8 * HD + i; big[i] = (k0[0] + k0[(size_t)NB * NH * 8 * HD]) * (1.f / 256.f); } }
            if (MODE == 2) {
                float v[4];
#pragma unroll
                for (int e = 0; e < 4; ++e) v[e] = A.logf[(size_t)(cur.b * S + 4 * tid + e) * NH + cur.h];
                v[1] += v[0]; v[2] += v[1]; v[3] += v[2];
                float incl = v[3];
#pragma unroll
                for (int o = 1; o < 64; o <<= 1) { const float t = __int_as_float(__builtin_amdgcn_ds_bpermute(((lane - o) & 63) << 2, __float_as_int(incl))); if (lane >= o) incl += t; }
                if (lane == 63) misc[8 + wid] = incl;
                __syncthreads();
                float off = incl - v[3];
                for (int w = 0; w < wid; ++w) off += misc[8 + w];
                const f32x4 o4 = {(v[0] + off) * (1.f / SCALE), (v[1] + off) * (1.f / SCALE), (v[2] + off) * (1.f / SCALE), (v[3] + off) * (1.f / SCALE)};
                *(f32x4*)(big + 4 * tid) = o4;
            }
            __syncthreads();
            new_item = false;
        }
        BlkCtx bc; bc.selbits = 0u; bc.own = cur.x;
        if (MODE == 1) {
            float gate[8];
#pragma unroll
            for (int n = 0; n < 8; ++n) { float gs = 0.f;
                if (n < cur.x) {
#pragma unroll
                    for (int d0 = 0; d0 < 8; ++d0) { const float* kp = big + n * 128 + d0 * 16 + hi * 8; const f32x4 k0 = *(const f32x4*)kp, k1 = *(const f32x4*)(kp + 4); const f16x8 q = S_.qr[d0];
                        gs += (float)q[0] * k0[0] + (float)q[1] * k0[1] + (float)q[2] * k0[2] + (float)q[3] * k0[3] + (float)q[4] * k1[0] + (float)q[5] * k1[1] + (float)q[6] * k1[2] + (float)q[7] * k1[3]; }
                    gs = xadd32(gs); }
                gate[n] = n < cur.x ? gs : NEGF; SBAR(); }
            unsigned sb = 0u;
#pragma unroll
            for (int k = 0; k < 3; ++k) { int best = -1; float bv = 0.f;
#pragma unroll
                for (int n = 0; n < 8; ++n) if (!((sb >> n) & 1u) && (best < 0 || gate[n] > bv)) { best = n; bv = gate[n]; }
                sb |= 1u << best; }
            bc.selbits = sb & ((1u << cur.x) - 1u);
        }
        int itemn = item, jn = j + 1; bool last = false;
        if (jn == NBLK) { jn = 0; itemn = item + c.G; if (itemn >= NITEMS) { last = true; itemn = item; jn = j; } }
        const BlockRef nxt = att_ref<MODE>(itemn, jn);
        att_block<MODE>(cur, nxt, A.Qb, A.Kb, A.Vb, lds, S_, bc, ea, tid);
        if (last) break;
        new_item = itemn != item; cur = nxt; item = itemn; j = jn;
    }
    VMW();
}
#undef ROW
#undef VMW
#undef VMWN
#undef KSWZ
#undef SBAR
}

#define XB_TMO      128
#define XB_XCNT(j)  (256  + 64 * (j))
#define XB_XSUB(j)  (1280 + 64 * (j))
#define XB_XGEN(j)  (2304 + 64 * (j))
#define XB_TOP      3328
#define XB_TOPGEN   3392
#define XCD_BAR_WORDS 3456
#define XB_SPIN_CAP (1u << 18)
__device__ __forceinline__ unsigned xb_ld(unsigned* p)              { return __hip_atomic_load(p, __ATOMIC_RELAXED, __HIP_MEMORY_SCOPE_AGENT); }
__device__ __forceinline__ unsigned xb_add(unsigned* p, unsigned v) { return __hip_atomic_fetch_add(p, v, __ATOMIC_RELAXED, __HIP_MEMORY_SCOPE_AGENT); }
__device__ __forceinline__ unsigned xb_xcc_id() { return (unsigned)__builtin_amdgcn_s_getreg((3 << 11) | 20) & 0xFu; }
#define XB_SPIN(cond, bar) do { unsigned _sp = 0; while (cond) { __builtin_amdgcn_s_sleep(1); \
    if ((++_sp & 255u) == 0u) { if (xb_ld(&(bar)[XB_TMO])) break; if (_sp > XB_SPIN_CAP) { atomicAdd(&(bar)[XB_TMO], 1u); break; } } } } while (0)
struct XcdBarrier { unsigned* bar; unsigned x; volatile LAS unsigned* st; };
__device__ __forceinline__ void xcd_barrier_complete(unsigned* bar, unsigned x, unsigned& nloc, unsigned& nx) {
    const unsigned G = gridDim.x * gridDim.y * gridDim.z;
    unsigned sum, cnt, mine, sp = 0u;
    for (;;) {
        sum = 0u; cnt = 0u; mine = 0u;
#pragma unroll
        for (unsigned j = 0; j < 16; ++j) { const unsigned c = xb_ld(&bar[XB_XCNT(j)]); sum += c; cnt += (c > 0u) ? 1u : 0u; mine = (j == x) ? c : mine; }
        if (sum == G) break;
        __builtin_amdgcn_s_sleep(1);
        if ((++sp & 255u) == 0u) { if (xb_ld(&bar[XB_TMO])) break; if (sp > XB_SPIN_CAP) { atomicAdd(&bar[XB_TMO], 1u); break; } }
    }
    nloc = mine > 0u ? mine : 1u; nx = cnt > 0u ? cnt : 1u;
}
__device__ __forceinline__ void xcd_barrier(const XcdBarrier& b, bool leader_thread) {
    asm volatile("s_waitcnt vmcnt(0)" ::: "memory");
    __syncthreads();
    if (leader_thread) {
        unsigned* bar = b.bar;
        __builtin_amdgcn_s_waitcnt(0);
        unsigned nloc = b.st[0], nx = b.st[1];
        if (nloc == 0u) { xcd_barrier_complete(bar, b.x, nloc, nx); b.st[0] = nloc; b.st[1] = nx; }
        const unsigned old = xb_add(&bar[XB_XSUB(b.x)], 1u);
        const unsigned gen = old / nloc;
        if (old + 1u == (gen + 1u) * nloc) {
            __builtin_amdgcn_fence(__ATOMIC_RELEASE, "agent");
            asm volatile("s_waitcnt vmcnt(0)" ::: "memory");
            const unsigned og = xb_add(&bar[XB_TOP], 1u);
            const unsigned tg = og / nx;
            if (og + 1u == (tg + 1u) * nx) xb_add(&bar[XB_TOPGEN], 1u);
            else XB_SPIN(xb_ld(&bar[XB_TOPGEN]) == tg, bar);
            __builtin_amdgcn_fence(__ATOMIC_ACQUIRE, "agent");
            xb_add(&bar[XB_XGEN(b.x)], 1u);
            asm volatile("s_waitcnt vmcnt(0)" ::: "memory");
        } else {
            XB_SPIN(xb_ld(&bar[XB_XGEN(b.x)]) == gen, bar);
            __builtin_amdgcn_fence(__ATOMIC_ACQUIRE, "agent");
            asm volatile("s_waitcnt vmcnt(0)" ::: "memory");
        }
    }
    __syncthreads();
}

struct Args { const float* in[29]; float* out; unsigned char* ws; int ph_lo, ph_hi; };
static_assert(sizeof(Args) == 31 * 8 + 8, "Args has no padding");

__global__ void __launch_bounds__(NTHREADS, 2) mega_fwd(Args args) {
    extern __shared__ __attribute__((aligned(16))) unsigned char lds[];
    cg::grid_group grid = cg::this_grid();
    const int wave_id = __builtin_amdgcn_readfirstlane(threadIdx.x >> 6);
    volatile LAS unsigned* xst = (volatile LAS unsigned*)((LAS unsigned char*)lds + XB_LDS_OFF);
    if (threadIdx.x < 4) xst[threadIdx.x] = 0u;
    __syncthreads();
    XcdBarrier xbar; xbar.bar = (unsigned*)(args.ws + WS_CTL) + 1024; xbar.x = xb_xcc_id(); xbar.st = xst;
    if (threadIdx.x == 0) (void)xb_add(&xbar.bar[XB_XCNT(xbar.x)], 1u);
#define W_X (args.in[0])
#define W_REL (args.in[1])
#define W_HB ((h16_t*)(ws + WS_HB))
#define W_Q ((h16_t*)(ws + WS_Q))
#define W_K ((h16_t*)(ws + WS_K))
#define W_V ((h16_t*)(ws + WS_V))
#define W_Z ((h16_t*)(ws + WS_Z))
#define W_G ((h16_t*)(ws + WS_G))
#define W_STATS ((float*)(ws + WS_STATS))
#define W_KPART ((float*)(ws + WS_KPART))
#define W_LOGF ((float*)(ws + WS_LOGF))
#define W_CUM ((float*)(ws + WS_CUM))
#define W_WF ((h16_t*)(ws + WS_WF))
#define W_T (args.out)
#define PHASE_BEGIN { Ctx c; c.lane = (int)__builtin_amdgcn_mbcnt_hi(~0u, __builtin_amdgcn_mbcnt_lo(~0u, 0u)); c.tid = wave_id * 64 + c.lane; asm volatile("" : "+v"(c.tid)); c.lane = c.tid & 63; c.wave = wave_id; c.G = gridDim.x; c.bid = blockIdx.x; c.lds = lds; unsigned char* ws = args.ws; asm volatile("" : "+s"(ws));
#define PHASE_END(dosync_) if (dosync_) { if (USE_CG_SYNC) grid.sync(); else xcd_barrier(xbar, c.tid == 0); } }

    PHASE_BEGIN
    {
        const int i_win[4] = {2, 11, 15, 20}, i_wout[4] = {8, 12, 17, 26};
#pragma unroll
        for (int l = 0; l < 4; ++l) {
            transpose_phase(c, args.in[i_win[l]], (l == 2) ? NPROJ + 16 : NPROJ, 0, NPROJ, (h16_t*)(ws + WS_WIN + (size_t)l * 32 * MiB));
            transpose_phase(c, args.in[i_wout[l]], D, 0, D, (h16_t*)(ws + WS_WOUT + (size_t)l * 8 * MiB));
        }
        transpose_phase(c, args.in[15], NPROJ + 16, NPROJ, 16, W_WF);
        cvt_phase(c, W_X, W_HB, (size_t)M * D);
    }
    grid.sync(); }

#ifdef DBG_ONLY
    for (int l = DBG_LAYER; l <= DBG_LAYER; ++l) {
#else
#pragma unroll 1
    for (int l = 0; l < 4; ++l) {
#endif
        const int i_g[4] = {9, 13, 18, 27}, i_b[4] = {10, 14, 19, 28};
#define W_WIN ((const h16_t*)(ws + WS_WIN + (size_t)l * 32 * MiB))
#define W_WOUT ((const h16_t*)(ws + WS_WOUT + (size_t)l * 8 * MiB))
        PHASE_BEGIN
        {
            if (l == 2) logf_phase(c, W_HB, W_WF, args.in[16], W_LOGF);
            pg8::Gemm g{W_HB, W_WIN, M, NPROJ, D}; pg8::StaticOrder So; So.init(M, NPROJ, c.G, c.bid);
            EpiQKVZ Ep{W_Q, W_K, W_V, W_Z, l == 1 ? W_KPART : nullptr};
            pg8::gemm_phase<EpiQKVZ, pg8::StaticOrder, true, true>((LAS unsigned char*)lds, g, So, Ep, c.tid);
        }
        PHASE_END(true)
#ifdef DBG_LAYER
        if (l == DBG_LAYER) {
            h16_t* G2 = (h16_t*)args.out; unsigned* ctl = (unsigned*)args.ws;
            PHASE_BEGIN if (l == 2) cum_phase(c, W_LOGF, W_CUM); PHASE_END(true)
            for (int pass = 0; pass < 2; ++pass) {
            PHASE_BEGIN
            {
                AttnArgs A{W_Q, W_K, W_V, W_Z, pass ? G2 : W_G, W_REL, W_KPART, W_CUM, W_LOGF, nullptr, nullptr, nullptr, nullptr, nullptr, 0.f};
                if (l == 0 || l == 3) { const int base = (l == 0) ? 3 : 21; A.lq1 = args.in[base]; A.lk1 = args.in[base + 1]; A.lq2 = args.in[base + 2]; A.lk2 = args.in[base + 3]; A.subg = args.in[base + 4];
                    A.lam_init = (l == 0) ? 0.2f : (0.8f - 0.6f * 0.40656965974059917f);
                    if (pass) att::attn_phase<0>(c, A); else attn_naive_phase<0>(c, A); }
                else if (l == 1) { if (pass) att::attn_phase<1>(c, A); else attn_naive_phase<1>(c, A); }
                else { if (pass) att::attn_phase<2>(c, A); else attn_naive_phase<2>(c, A); }
            }
            PHASE_END(true)
            }
            PHASE_BEGIN
            {
                float best = 0.f; unsigned nbad = 0u;
                for (int sl = c.bid * NWAVES + c.wave; sl < M * 16; sl += c.G * NWAVES) {
                    const size_t idx = (size_t)(sl >> 4) * E + (sl & 15) * 128 + c.lane * 2;
                    const unsigned a = *(const unsigned*)(W_G + idx), b = *(const unsigned*)(G2 + idx);
                    float md = fmaxf(fabsf(lo16(a) - lo16(b)), fabsf(hi16(a) - hi16(b))), ma = fmaxf(fabsf(lo16(a)), fabsf(hi16(a)));
                    for (int o = 1; o < 64; o <<= 1) { md = fmaxf(md, __shfl_xor(md, o)); ma = fmaxf(ma, __shfl_xor(ma, o)); }
                    const float r = (md == md) ? md / fmaxf(ma, 1e-20f) : 1e9f;
                    best = fmaxf(best, r); nbad += (r > 0.05f) ? 1u : 0u;
                }
                if (c.lane == 0) { atomicMax(ctl + 0, __float_as_uint(best)); atomicAdd(ctl + 1, nbad); }
            }
            PHASE_END(true)
            PHASE_BEGIN
            for (size_t i = ((size_t)c.bid * NTHREADS + c.tid) * 4; i < (size_t)M * D; i += (size_t)c.G * NTHREADS * 4) *(f32x4*)(args.out + i) = (f32x4){0.f, 0.f, 0.f, 0.f};
            PHASE_END(true)
            if (blockIdx.x == 0 && threadIdx.x == 0) {
#if DBG_WHAT == 0
                args.out[0] = 1e6f * __uint_as_float(__hip_atomic_load(ctl + 0, __ATOMIC_RELAXED, __HIP_MEMORY_SCOPE_AGENT));
#else
                args.out[0] = 1e3f * (float)__hip_atomic_load(ctl + 1, __ATOMIC_RELAXED, __HIP_MEMORY_SCOPE_AGENT);
#endif
            }
            return;
        }
#endif
        if (!FAST2) {
        PHASE_BEGIN
        if (l == 2) cum_phase(c, W_LOGF, W_CUM);
        PHASE_END(l == 2)
        }
        PHASE_BEGIN
        {
            AttnArgs A{W_Q, W_K, W_V, W_Z, W_G, W_REL, W_KPART, W_CUM, W_LOGF, nullptr, nullptr, nullptr, nullptr, nullptr, 0.f};
            if (l == 0 || l == 3) { const int base = (l == 0) ? 3 : 21; A.lq1 = args.in[base]; A.lk1 = args.in[base + 1]; A.lq2 = args.in[base + 2]; A.lk2 = args.in[base + 3]; A.subg = args.in[base + 4];
                A.lam_init = (l == 0) ? 0.2f : (0.8f - 0.6f * 0.40656965974059917f);
                if (FAST0) att::attn_phase<0>(c, A); else attn_naive_phase<0>(c, A); }
            else if (l == 1) { if (FAST1) att::attn_phase<1>(c, A); else attn_naive_phase<1>(c, A); }
            else { if (FAST2) att::attn_phase<2>(c, A); else attn_naive_phase<2>(c, A); }
        }
        PHASE_END(true)
        PHASE_BEGIN
        {
            pg8::Gemm g{W_G, W_WOUT, M, D, E}; pg8::StaticOrder So; So.init(M, D, c.G, c.bid);
            EpiResid Ep{W_T, W_X, W_STATS, l ? args.in[i_g[l - 1]] : nullptr, l ? args.in[i_b[l - 1]] : nullptr, l};
            pg8::gemm_phase<EpiResid, pg8::StaticOrder, false, true>((LAS unsigned char*)lds, g, So, Ep, c.tid);
        }
        PHASE_END(true)
        PHASE_BEGIN
        ln_phase(c, W_T, args.in[i_g[l]], args.in[i_b[l]], W_STATS, W_HB, l == 3);
        PHASE_END(true)
    }
}

extern "C" void kernel_launch(void* const* d_in, const int* in_sizes, int n_in, void* d_out, int out_size, void* d_ws, size_t ws_size, hipStream_t stream) {
    static int grid = 0;
    if (grid == 0) {
        if (n_in != 29 || ws_size < WS_END || out_size != M * D) { fprintf(stderr, "kernel_launch: unexpected shapes n_in=%d ws=%zu out=%d\n", n_in, ws_size, out_size); grid = -1; return; }
        int dev = 0, cus = 0, per_cu = 0;
        (void)hipGetDevice(&dev); (void)hipDeviceGetAttribute(&cus, hipDeviceAttributeMultiprocessorCount, dev);
        if (hipFuncSetAttribute((const void*)mega_fwd, hipFuncAttributeMaxDynamicSharedMemorySize, LDS_BYTES) != hipSuccess) { fprintf(stderr, "kernel_launch: hipFuncSetAttribute failed\n"); grid = -1; return; }
        if (hipOccupancyMaxActiveBlocksPerMultiprocessor(&per_cu, (const void*)mega_fwd, NTHREADS, LDS_BYTES) != hipSuccess || per_cu < 1) { fprintf(stderr, "kernel_launch: occupancy query says %d\n", per_cu); per_cu = 1; }
        (void)hipGetLastError();
        grid = cus > 0 ? cus : 256;
    }
    if (grid < 0) return;
    (void)hipMemsetAsync(d_ws, 0, 32768, stream);
    Args a{};
    for (int i = 0; i < 29; ++i) a.in[i] = (const float*)d_in[i];
    a.out = (float*)d_out; a.ws = (unsigned char*)d_ws; a.ph_lo = 0; a.ph_hi = 1000;
    void* kargs[] = {&a};
    hipError_t e = hipLaunchCooperativeKernel((const void*)mega_fwd, dim3(grid), dim3(NTHREADS), kargs, LDS_BYTES, stream);
    if (e != hipSuccess) fprintf(stderr, "kernel_launch: cooperative launch failed: %s (grid %d)\n", hipGetErrorString(e), grid);
}
```

```cpp
#include <hip/hip_runtime.h>
#include <hip/hip_cooperative_groups.h>
#include <cstdint>
#include <cstdio>
namespace cg = cooperative_groups;

typedef unsigned short h16_t;
typedef float f32x4 __attribute__((ext_vector_type(4)));
typedef float f32x2 __attribute__((ext_vector_type(2)));
typedef unsigned u32x4 __attribute__((ext_vector_type(4)));
typedef _Float16 f16x8 __attribute__((ext_vector_type(8)));
typedef _Float16 f16x2 __attribute__((ext_vector_type(2)));
#define LAS __attribute__((address_space(3)))

constexpr int NB = 4, S = 2048, D = 2048, M = NB * S, E = 2048, NH = 16, HD = 128;
constexpr int NPROJ = 4 * E;
constexpr float SCALE = 0.08838834764831845f;
constexpr float LN_EPS = 1e-5f, RMS_EPS = 1e-5f;
constexpr float DN_ALPHA = 1.681792830507429f;
constexpr float NEGF = -1e30f;
constexpr int NTHREADS = 512, NWAVES = 8;
constexpr int LDS_BYTES = 147456;
constexpr int XB_LDS_OFF = LDS_BYTES - 64;
#ifndef REP_P0
#define REP_P0 1
#endif
#ifndef REP_IN
#define REP_IN 1
#endif
#ifndef REP_ATT
#define REP_ATT 1
#endif
#ifndef REP_LN
#define REP_LN 1
#endif
#ifndef USE_CG_SYNC
#define USE_CG_SYNC 0
#endif

constexpr size_t MiB = 1u << 20;
constexpr size_t WS_CTL = 0;
constexpr size_t WS_WIN = 1 * MiB;
constexpr size_t WS_WOUT = WS_WIN + 128 * MiB;
constexpr size_t WS_HB = WS_WOUT + 32 * MiB;
constexpr size_t WS_Q = WS_HB + 32 * MiB;
constexpr size_t WS_K = WS_Q + 32 * MiB;
constexpr size_t WS_V = WS_K + 32 * MiB;
constexpr size_t WS_Z = WS_V + 32 * MiB;
constexpr size_t WS_G = WS_Z + 32 * MiB;
constexpr size_t WS_SMALL = WS_G + 32 * MiB;
constexpr size_t WS_STATS = WS_SMALL;
constexpr size_t WS_KPART = WS_STATS + 64 * 1024;
constexpr size_t WS_LOGF = WS_KPART + 512 * 1024;
constexpr size_t WS_CUM = WS_LOGF + 512 * 1024;
constexpr size_t WS_WF = WS_CUM + 512 * 1024;
constexpr size_t WS_END = WS_WF + 64 * 1024;

__device__ __forceinline__ float h2f(h16_t v) { return (float)__builtin_bit_cast(_Float16, v); }
__device__ __forceinline__ h16_t f2h(float f) { return __builtin_bit_cast(h16_t, (_Float16)f); }
__device__ __forceinline__ float lo16(unsigned u) { return h2f((h16_t)(u & 0xffffu)); }
__device__ __forceinline__ float hi16(unsigned u) { return h2f((h16_t)(u >> 16)); }
__device__ __forceinline__ unsigned pk2(float lo, float hi) { f32x2 v = {lo, hi}; return __builtin_bit_cast(unsigned, __builtin_convertvector(v, f16x2)); }
template <int MASK> __device__ __forceinline__ float xsw(float v) { return __int_as_float(__builtin_amdgcn_ds_swizzle(__float_as_int(v), (MASK << 10) | 0x1F)); }
__device__ __forceinline__ float xadd32(float v) { auto rr = __builtin_amdgcn_permlane32_swap(__float_as_uint(v), __float_as_uint(v), false, false); return __uint_as_float(rr[0]) + __uint_as_float(rr[1]); }
__device__ __forceinline__ float hsum32(float v) { v += xsw<1>(v); v += xsw<2>(v); v += xsw<4>(v); v += xsw<8>(v); v += xsw<16>(v); return v; }
__device__ __forceinline__ float siluf(float z) { return z / (1.f + __expf(-z)); }

__device__ __forceinline__ int t5_bucket(int d) {
    if (d < 16) return d;
    if (d >= 113) return 31;
    int b = 16;
    b += (d >= 19); b += (d >= 21); b += (d >= 24); b += (d >= 27); b += (d >= 31); b += (d >= 35); b += (d >= 40); b += (d >= 46);
    b += (d >= 52); b += (d >= 59); b += (d >= 67); b += (d >= 77); b += (d >= 87); b += (d >= 99);
    return b;
}

namespace pg8 {
constexpr int BM = 256, BK = 64, HALF = 128, HTB = HALF * BK * 2, STAGE_BYTES = 8 * HTB, NXCD = 8, WGM = 8;
__host__ __device__ __forceinline__ int lds_byte(int r, int c) { const int st = (r >> 4) * 2 + (c >> 5), rr = r & 15, cc = c & 31, ob = rr * 64 + cc * 2; return st * 1024 + (ob ^ (((ob >> 9) & 1) << 5)); }
__host__ __device__ __forceinline__ void stage_rc(int b, int& R, int& C) { const int st = b / 1024, sb = b % 1024, swz = sb ^ (((sb >> 9) & 1) << 5); R = (st >> 1) * 16 + swz / 64; C = (st & 1) * 32 + (swz % 64) / 2; }
__host__ __device__ __forceinline__ int perm32(int rho) { const int n = rho >> 4, i = rho & 15; return 8 * (i >> 2) + 4 * n + (i & 3); }
struct Unit { int pm, pn; };
struct Gemm { const h16_t* A; const h16_t* Bt; int M, N, K; };
struct StaticOrder {
    int nM, nN, nwg, G, c;
    __host__ __device__ void init(int M_, int N_, int G_, int c_) { nM = M_ / BM; nN = N_ / BM; nwg = nM * nN; G = G_; c = c_; }
    __host__ __device__ bool next(int i, Unit& u) const {
        const long L = (long)i * G + c; if (L >= nwg) return false;
        int wgid = (int)L; { const int q = nwg / NXCD, r = nwg % NXCD, xcd = wgid % NXCD, off = wgid / NXCD; wgid = (xcd < r ? xcd * (q + 1) : r * (q + 1) + (xcd - r) * q) + off; }
        const int nig = WGM * nN, gid = wgid / nig, fm = gid * WGM, gsz = (nM - fm) < WGM ? (nM - fm) : WGM;
        u.pm = fm + ((wgid % nig) % gsz); u.pn = (wgid % nig) / gsz; return true;
    }
    __device__ __forceinline__ void a_ready(const Unit&) const {}
    __device__ __forceinline__ void done(const Unit&) const {}
};

template <class Epi, class Sched, bool ALIGN_EPI = false, bool SP2 = false>
__device__ __forceinline__ void gemm_phase(LAS unsigned char* lds, const Gemm g, const Sched& S, const Epi& E, const int tid) {
    const int wid = __builtin_amdgcn_readfirstlane(tid >> 6), lane = tid & 63, wr = wid >> 2, wc = wid & 3, fr = lane & 15, fq = lane >> 4;
    const int K = g.K, nt = K / BK;
    unsigned voffA[2], voffB[2];
#pragma unroll
    for (int i = 0; i < 2; ++i) { int R, C; stage_rc(tid * 16 + i * 8192, R, C); const int Rb = Epi::PERM ? ((R & ~31) + perm32(R & 31)) : R;
        voffA[i] = (unsigned)(R * K + C) * 2u; voffB[i] = (unsigned)(Rb * K + C) * 2u; }
    const size_t kstep = (size_t)(BK * 2);
    const size_t hstep = (size_t)HALF * K * 2;
    const size_t tstep = 2 * hstep;
    const unsigned ldsw = (unsigned)wid * 1024u;
    const int aoff = lds_byte(wr * 64 + fr, fq * 8), boff = lds_byte(wc * 32 + fr, fq * 8);
#define PG8_SA(b, h) (((b) * 2 + (h)) * HTB)
#define PG8_SB(b, h) ((4 + (b) * 2 + (h)) * HTB)
#define PG8_STAGE(bufoff, gbase, voff) do { _Pragma("unroll") for (int _i = 0; _i < 2; ++_i) \
        __builtin_amdgcn_global_load_lds((const unsigned*)((const char*)(gbase) + (voff)[_i]), (LAS unsigned*)(lds + (bufoff) + ldsw + _i * 8192), 16, 0, 0); } while (0)
#define PG8_LDA(dst, b, h) do { _Pragma("unroll") for (int m = 0; m < 4; ++m) _Pragma("unroll") for (int k = 0; k < 2; ++k) dst[m][k] = *(const LAS f16x8*)(lds + PG8_SA(b, h) + aoff + m * 2048 + k * 1024); } while (0)
#define PG8_LDB(dst, b, h) do { _Pragma("unroll") for (int n = 0; n < 2; ++n) _Pragma("unroll") for (int k = 0; k < 2; ++k) dst[n][k] = *(const LAS f16x8*)(lds + PG8_SB(b, h) + boff + n * 2048 + k * 1024); } while (0)
#define PG8_MMA(ai, bj, At, Bt) do { __builtin_amdgcn_s_setprio(1); _Pragma("unroll") for (int m = 0; m < 4; ++m) _Pragma("unroll") for (int n = 0; n < 2; ++n) _Pragma("unroll") for (int k = 0; k < 2; ++k) \
        acc[ai][bj][m][n] = __builtin_amdgcn_mfma_f32_16x16x32_f16(Bt[n][k], At[m][k], acc[ai][bj][m][n], 0, 0, 0); __builtin_amdgcn_s_setprio(0); } while (0)
#define PG8_WAIT_V(n) asm volatile("s_waitcnt vmcnt(" #n ")" ::: "memory")
#define PG8_WAIT_L(n) asm volatile("s_waitcnt lgkmcnt(" #n ")" ::: "memory")
#define PG8_BAR __builtin_amdgcn_s_barrier()
#define PG8_SCHED __builtin_amdgcn_sched_barrier(0)
    Unit cur, nxt; int ui = 0;
    if (!S.next(0, cur)) return;
    f32x4 acc[2][2][4][2];
#pragma unroll
    for (int a = 0; a < 2; ++a)
#pragma unroll
        for (int b = 0; b < 2; ++b)
#pragma unroll
            for (int m = 0; m < 4; ++m)
#pragma unroll
                for (int n = 0; n < 2; ++n) acc[a][b][m][n] = (f32x4){0.f, 0.f, 0.f, 0.f};
    f16x8 At[4][2], B0[2][2], B1[2][2];
    const char* cA = (const char*)g.A + (size_t)cur.pm * tstep; const char* cB = (const char*)g.Bt + (size_t)cur.pn * tstep;
    S.a_ready(cur);
    if constexpr (SP2) {
        PG8_STAGE(PG8_SB(0, 0), cB, voffB); PG8_STAGE(PG8_SB(0, 1), cB + hstep, voffB); PG8_STAGE(PG8_SA(0, 0), cA, voffA); PG8_STAGE(PG8_SA(0, 1), cA + hstep, voffA);
        if (wr == 1) PG8_BAR;
        PG8_WAIT_V(2); PG8_BAR;
        PG8_STAGE(PG8_SB(1, 0), cB + kstep, voffB); PG8_STAGE(PG8_SA(1, 0), cA + kstep, voffA); PG8_STAGE(PG8_SB(1, 1), cB + hstep + kstep, voffB);
        PG8_WAIT_V(6); PG8_BAR;
    } else {
        PG8_STAGE(PG8_SB(0, 0), cB, voffB); PG8_STAGE(PG8_SA(0, 0), cA, voffA); PG8_STAGE(PG8_SB(0, 1), cB + hstep, voffB); PG8_STAGE(PG8_SA(0, 1), cA + hstep, voffA);
        if (wr == 1) PG8_BAR;
        PG8_WAIT_V(4); PG8_BAR;
        PG8_STAGE(PG8_SB(1, 0), cB + kstep, voffB); PG8_STAGE(PG8_SA(1, 0), cA + kstep, voffA); PG8_STAGE(PG8_SB(1, 1), cB + hstep + kstep, voffB);
        PG8_WAIT_V(6); PG8_BAR;
    }
    for (;;) {
        const bool has_next = S.next(ui + 1, nxt);
        const char* nA = has_next ? (const char*)g.A + (size_t)nxt.pm * tstep : cA; const char* nB = has_next ? (const char*)g.Bt + (size_t)nxt.pn * tstep : cB;
        for (int t = 0; t < nt; t += 2) {
            const bool last = (t == nt - 2);
            const char* a1 = cA + (size_t)(t + 1) * kstep;
            const char* a2 = last ? nA : cA + (size_t)(t + 2) * kstep; const char* b2 = last ? nB : cB + (size_t)(t + 2) * kstep;
            const char* a3 = a2 + kstep; const char* b3 = b2 + kstep;
            if (last && has_next) S.a_ready(nxt);
            if constexpr (SP2) {
            PG8_LDB(B0, 0, 0); PG8_LDB(B1, 0, 1); PG8_SCHED; PG8_LDA(At, 0, 0); PG8_STAGE(PG8_SA(1, 1), a1 + hstep, voffA);
            PG8_WAIT_V(8); PG8_WAIT_L(0); PG8_BAR; PG8_MMA(0, 0, At, B0); PG8_MMA(0, 1, At, B1); PG8_BAR; PG8_SCHED;
            PG8_LDA(At, 0, 1); PG8_STAGE(PG8_SB(0, 0), b2, voffB); PG8_STAGE(PG8_SB(0, 1), b2 + hstep, voffB); PG8_STAGE(PG8_SA(0, 0), a2, voffA);
            PG8_WAIT_V(8); PG8_WAIT_L(0); PG8_BAR; PG8_MMA(1, 0, At, B0); PG8_MMA(1, 1, At, B1); PG8_BAR; PG8_SCHED;
            PG8_LDB(B0, 1, 0); PG8_LDB(B1, 1, 1); PG8_SCHED; PG8_LDA(At, 1, 0); PG8_STAGE(PG8_SA(0, 1), a2 + hstep, voffA);
            PG8_WAIT_V(8); PG8_WAIT_L(0); PG8_BAR; PG8_MMA(0, 0, At, B0); PG8_MMA(0, 1, At, B1); PG8_BAR; PG8_SCHED;
            PG8_LDA(At, 1, 1); PG8_STAGE(PG8_SB(1, 0), b3, voffB); PG8_STAGE(PG8_SB(1, 1), b3 + hstep, voffB); PG8_STAGE(PG8_SA(1, 0), a3, voffA);
            PG8_WAIT_V(8); PG8_WAIT_L(0); PG8_BAR; PG8_MMA(1, 0, At, B0); PG8_MMA(1, 1, At, B1); PG8_BAR; PG8_SCHED;
            } else {
            PG8_LDB(B0, 0, 0); PG8_SCHED; PG8_LDA(At, 0, 0); PG8_STAGE(PG8_SA(1, 1), a1 + hstep, voffA);
            PG8_WAIT_L(8); PG8_BAR; PG8_WAIT_L(0); PG8_MMA(0, 0, At, B0); PG8_BAR; PG8_SCHED;
            PG8_LDB(B1, 0, 1); PG8_STAGE(PG8_SB(0, 0), b2, voffB);
            PG8_BAR; PG8_WAIT_L(0); PG8_MMA(0, 1, At, B1); PG8_BAR;
            PG8_LDA(At, 0, 1); PG8_STAGE(PG8_SA(0, 0), a2, voffA);
            PG8_BAR; PG8_WAIT_L(0); PG8_MMA(1, 0, At, B0); PG8_BAR; PG8_SCHED;
            PG8_STAGE(PG8_SB(0, 1), b2 + hstep, voffB);
            PG8_WAIT_V(6); PG8_BAR; PG8_MMA(1, 1, At, B1); PG8_BAR;
            PG8_LDB(B0, 1, 0); PG8_SCHED; PG8_LDA(At, 1, 0); PG8_STAGE(PG8_SA(0, 1), a2 + hstep, voffA);
            PG8_WAIT_L(8); PG8_BAR; PG8_WAIT_L(0); PG8_MMA(0, 0, At, B0); PG8_BAR; PG8_SCHED;
            PG8_LDB(B1, 1, 1); PG8_STAGE(PG8_SB(1, 0), b3, voffB);
            PG8_BAR; PG8_WAIT_L(0); PG8_MMA(0, 1, At, B1); PG8_BAR;
            PG8_LDA(At, 1, 1); PG8_STAGE(PG8_SA(1, 0), a3, voffA);
            PG8_BAR; PG8_WAIT_L(0); PG8_MMA(1, 0, At, B0); PG8_BAR; PG8_SCHED;
            PG8_STAGE(PG8_SB(1, 1), b3 + hstep, voffB);
            PG8_WAIT_V(6); PG8_BAR; PG8_MMA(1, 1, At, B1); PG8_BAR;
            }
        }
        if constexpr (ALIGN_EPI) { if (wr == 0) PG8_BAR; }
        E(acc, cur, wr, wc, fr, fq); S.done(cur);
        if (!has_next) break;
#pragma unroll
        for (int a = 0; a < 2; ++a)
#pragma unroll
            for (int b = 0; b < 2; ++b)
#pragma unroll
                for (int m = 0; m < 4; ++m)
#pragma unroll
                    for (int n = 0; n < 2; ++n) acc[a][b][m][n] = (f32x4){0.f, 0.f, 0.f, 0.f};
        cur = nxt; cA = nA; cB = nB; ++ui;
        if constexpr (ALIGN_EPI) { if (wr == 1) PG8_BAR; }
    }
    PG8_WAIT_V(0);
    if constexpr (!ALIGN_EPI) { if (wr == 0) PG8_BAR; }
    PG8_BAR;
#undef PG8_SA
#undef PG8_SB
#undef PG8_STAGE
#undef PG8_LDA
#undef PG8_LDB
#undef PG8_MMA
#undef PG8_WAIT_V
#undef PG8_WAIT_L
#undef PG8_BAR
#undef PG8_SCHED
}
}

struct EpiQKVZ {
    static constexpr bool PERM = true;
    h16_t *Q, *K, *V, *Z; float* kpart;
    __device__ __forceinline__ void operator()(const f32x4 (&acc)[2][2][4][2], const pg8::Unit& u, int wr, int wc, int fr, int fq) const {
        const int colt = u.pn * 256, sec = colt >> 11, cbase = colt & 2047;
        const int row0 = u.pm * 256 + wr * 64 + fr;
        h16_t* dst = sec == 0 ? Q : (sec == 1 ? K : (sec == 2 ? V : Z));
#pragma unroll
        for (int ai = 0; ai < 2; ++ai)
#pragma unroll
            for (int m = 0; m < 4; ++m) { const int r = row0 + ai * 128 + m * 16, b = r >> 11, s = r & 2047;
#pragma unroll
                for (int bj = 0; bj < 2; ++bj) { const f32x4 v0 = acc[ai][bj][m][0], v1 = acc[ai][bj][m][1];
                    u32x4 w; w.x = pk2(v0[0], v0[1]); w.y = pk2(v0[2], v0[3]); w.z = pk2(v1[0], v1[1]); w.w = pk2(v1[2], v1[3]);
                    const int c = cbase + bj * 128 + wc * 32 + 8 * fq;
                    h16_t* p = (sec == 3) ? dst + (size_t)r * E + c : dst + ((size_t)(b * NH + (c >> 7)) * S + s) * HD + (c & 127);
                    *(u32x4*)p = w; } }
        if (kpart != nullptr && sec == 1) {
            const int b = u.pm >> 3, nblk = u.pm & 7;
#pragma unroll
            for (int bj = 0; bj < 2; ++bj) { f32x4 s0 = {0.f, 0.f, 0.f, 0.f}, s1 = {0.f, 0.f, 0.f, 0.f};
#pragma unroll
                for (int ai = 0; ai < 2; ++ai)
#pragma unroll
                    for (int m = 0; m < 4; ++m) { s0 += acc[ai][bj][m][0]; s1 += acc[ai][bj][m][1]; }
#pragma unroll
                for (int e = 0; e < 4; ++e) { s0[e] += xsw<1>(s0[e]); s1[e] += xsw<1>(s1[e]); s0[e] += xsw<2>(s0[e]); s1[e] += xsw<2>(s1[e]);
                                              s0[e] += xsw<4>(s0[e]); s1[e] += xsw<4>(s1[e]); s0[e] += xsw<8>(s0[e]); s1[e] += xsw<8>(s1[e]); }
                if (fr == 0) { const int c = cbase + bj * 128 + wc * 32 + 8 * fq;
                    float* p = kpart + (size_t)wr * NB * NH * 8 * HD + ((size_t)(b * NH + (c >> 7)) * 8 + nblk) * HD + (c & 127);
                    *(f32x4*)p = s0; *(f32x4*)(p + 4) = s1; } }
        }
    }
};
struct EpiResid {
    static constexpr bool PERM = false;
    float* T; const float* x; const float* stats; const float* g; const float* bta; int layer;
    __device__ __forceinline__ void operator()(const f32x4 (&acc)[2][2][4][2], const pg8::Unit& u, int wr, int wc, int fr, int fq) const {
        const int col0 = u.pn * 256 + wc * 32 + 4 * fq, row0 = u.pm * 256 + wr * 64 + fr;
        f32x4 gv[2][2], bv[2][2];
        if (layer) {
#pragma unroll
            for (int bj = 0; bj < 2; ++bj)
#pragma unroll
                for (int n = 0; n < 2; ++n) { gv[bj][n] = *(const f32x4*)(g + col0 + bj * 128 + n * 16); bv[bj][n] = *(const f32x4*)(bta + col0 + bj * 128 + n * 16); } }
#pragma unroll
        for (int ai = 0; ai < 2; ++ai)
#pragma unroll
            for (int m = 0; m < 4; ++m) { const int r = row0 + ai * 128 + m * 16; float mean = 0.f, rstd = 1.f;
                if (layer) { const f32x2 st = *(const f32x2*)(stats + 2 * r); mean = st.x; rstd = st.y; }
#pragma unroll
                for (int bj = 0; bj < 2; ++bj)
#pragma unroll
                    for (int n = 0; n < 2; ++n) { const size_t idx = (size_t)r * D + col0 + bj * 128 + n * 16; f32x4 h;
                        if (layer) h = (*(const f32x4*)(T + idx) - mean) * rstd * gv[bj][n] + bv[bj][n]; else h = *(const f32x4*)(x + idx);
                        *(f32x4*)(T + idx) = DN_ALPHA * h + acc[ai][bj][m][n]; }
                asm volatile("" ::: "memory"); }
    }
};

struct Ctx { int tid, lane, wave, G, bid; unsigned char* lds; };

__device__ __forceinline__ void p0_transpose_item(const float* __restrict__ W, int ldw, int c0, int ncols, h16_t* __restrict__ WT, LAS float* scr, int item, int lane) {
    const int nblk = (ncols + 63) / 64, kb = item / nblk, nb = item % nblk, k0 = 64 * kb, n0 = 64 * nb;
    const int r = lane >> 4, cq = (lane & 15) * 4; const bool nok = n0 + cq < ncols;
    const float* src = W + (size_t)(k0 + r) * ldw + c0 + n0 + cq;
    f32x4 v[16];
#pragma unroll
    for (int i = 0; i < 16; ++i) v[i] = nok ? *(const f32x4*)(src + (size_t)(4 * i) * ldw) : (f32x4){0.f, 0.f, 0.f, 0.f};
#pragma unroll
    for (int i = 0; i < 16; ++i) { LAS float* d = scr + (4 * i + r) * 65 + cq; d[0] = v[i][0]; d[1] = v[i][1]; d[2] = v[i][2]; d[3] = v[i][3]; }
    asm volatile("s_waitcnt lgkmcnt(0)" ::: "memory");
    const int cc = lane & 7;
#pragma unroll
    for (int j = 0; j < 8; ++j) { const int n = (lane >> 3) + 8 * j; const LAS float* s = scr + (8 * cc) * 65 + n;
        u32x4 o; o.x = pk2(s[0 * 65], s[1 * 65]); o.y = pk2(s[2 * 65], s[3 * 65]); o.z = pk2(s[4 * 65], s[5 * 65]); o.w = pk2(s[6 * 65], s[7 * 65]);
        if (n0 + n < ncols) *(u32x4*)(WT + (size_t)(n0 + n) * D + k0 + 8 * cc) = o; }
    asm volatile("s_waitcnt lgkmcnt(0)" ::: "memory");
}
__device__ __forceinline__ void transpose_phase(const Ctx& c, const float* __restrict__ W, int ldw, int c0, int ncols, h16_t* __restrict__ WT) {
    float (*tile)[65] = (float (*)[65])(c.lds + (c.tid >> 8) * (64 * 65 * 4));
    const int nb = (ncols + 63) / 64, ntiles = (D / 64) * nb, t2 = c.tid & 255, tx = t2 & 63, ty = t2 >> 6;
    for (int it = c.bid * 2; it < ntiles; it += c.G * 2) {
        const int tl = it + (c.tid >> 8); const bool act = tl < ntiles;
        const int kb = tl / nb, cb = tl % nb, k0 = kb * 64, n0 = cb * 64;
        if (act) for (int i = ty; i < 64; i += 4) { const int n = n0 + tx; tile[i][tx] = (n < ncols) ? W[(size_t)(k0 + i) * ldw + c0 + n] : 0.f; }
        __syncthreads();
        if (act) for (int i = ty; i < 64; i += 4) { const int n = n0 + i; if (n < ncols) WT[(size_t)n * D + k0 + tx] = f2h(tile[tx][i]); }
        __syncthreads();
    }
}
__device__ __forceinline__ void cvt_phase(const Ctx& c, const float* __restrict__ x, h16_t* __restrict__ o, size_t n) {
    const size_t stride = (size_t)c.G * NTHREADS * 4;
    for (size_t i = ((size_t)c.bid * NTHREADS + c.tid) * 4; i < n; i += 8 * stride) { f32x4 v[8];
#pragma unroll
        for (int j = 0; j < 8; ++j) v[j] = *(const f32x4*)(x + i + j * stride);
#pragma unroll
        for (int j = 0; j < 8; ++j) *(uint2*)(o + i + j * stride) = make_uint2(pk2(v[j].x, v[j].y), pk2(v[j].z, v[j].w)); }
}
__device__ __forceinline__ float wave_sum(float v) { return xadd32(hsum32(v)); }
__device__ __forceinline__ void ln_phase(const Ctx& c, float* T, const float* __restrict__ g, const float* __restrict__ bta, float* stats, h16_t* HB, bool final_layer) {
    const int gw = c.bid * NWAVES + c.wave, NGW = c.G * NWAVES;
    for (int m = gw; m < M; m += NGW) {
        float* row = T + (size_t)m * D; f32x4 v[8]; float s = 0.f;
#pragma unroll
        for (int j = 0; j < 8; ++j) { v[j] = *(const f32x4*)(row + (64 * j + c.lane) * 4); s += (v[j].x + v[j].y) + (v[j].z + v[j].w); }
        const float mean = wave_sum(s) * (1.f / D); float q = 0.f;
#pragma unroll
        for (int j = 0; j < 8; ++j) { v[j] = v[j] - mean; q += (v[j].x * v[j].x + v[j].y * v[j].y) + (v[j].z * v[j].z + v[j].w * v[j].w); }
        const float rstd = rsqrtf(wave_sum(q) * (1.f / D) + LN_EPS);
        if (c.lane == 0) { stats[2 * m] = mean; stats[2 * m + 1] = rstd; }
#pragma unroll
        for (int j = 0; j < 8; ++j) { const int col = (64 * j + c.lane) * 4; const f32x4 o = v[j] * rstd * *(const f32x4*)(g + col) + *(const f32x4*)(bta + col);
            if (final_layer) *(f32x4*)(row + col) = o; else *(uint2*)(HB + (size_t)m * D + col) = make_uint2(pk2(o.x, o.y), pk2(o.z, o.w)); }
    }
}
__device__ __forceinline__ void logf_phase(const Ctx& c, const h16_t* __restrict__ HB, const h16_t* __restrict__ WfT, const float* __restrict__ bf, float* logf) {
    for (int rb = c.bid; rb < M / 32; rb += c.G) {
        const int m = rb * 32 + (c.tid >> 4), j = c.tid & 15;
        const h16_t* a = HB + (size_t)m * D; const h16_t* w = WfT + (size_t)j * D; float s = 0.f;
        for (int k = 0; k < D; k += 8) { const u32x4 av = *(const u32x4*)(a + k), wv = *(const u32x4*)(w + k);
#pragma unroll
            for (int e = 0; e < 4; ++e) { s = fmaf(lo16(av[e]), lo16(wv[e]), s); s = fmaf(hi16(av[e]), hi16(wv[e]), s); } }
        const float xx = s + bf[j];
        logf[(size_t)m * 16 + j] = fminf(xx, 0.f) - log1pf(__expf(-fabsf(xx)));
    }
}
__device__ __forceinline__ void cum_phase(const Ctx& c, const float* __restrict__ logf, float* cum) {
    float* wtot = (float*)c.lds;
    for (int bh = c.bid; bh < NB * NH; bh += c.G) {
        const int b = bh / NH, h = bh % NH; float v[4];
#pragma unroll
        for (int e = 0; e < 4; ++e) v[e] = logf[(size_t)(b * S + 4 * c.tid + e) * NH + h];
        v[1] += v[0]; v[2] += v[1]; v[3] += v[2];
        float incl = v[3];
#pragma unroll
        for (int o = 1; o < 64; o <<= 1) { const float t = __int_as_float(__builtin_amdgcn_ds_bpermute(((c.lane - o) & 63) << 2, __float_as_int(incl))); if (c.lane >= o) incl += t; }
        if (c.lane == 63) wtot[c.wave] = incl;
        __syncthreads();
        float off = incl - v[3];
        for (int w = 0; w < c.wave; ++w) off += wtot[w];
        f32x4 o4 = {v[0] + off, v[1] + off, v[2] + off, v[3] + off};
        *(f32x4*)(cum + (size_t)bh * S + 4 * c.tid) = o4;
        __syncthreads();
    }
}

#ifndef FAST0
#define FAST0 1
#endif
#ifndef FAST1
#define FAST1 1
#endif
#ifndef FAST2
#define FAST2 1
#endif
constexpr int SC_LD = 2064;
struct AttnArgs { const h16_t *Qb, *Kb, *Vb, *Zb; h16_t* G; const float *rel, *kpart, *cum, *logf, *lq1, *lk1, *lq2, *lk2, *subg; float lam_init; };
template <int MODE>
__device__ __forceinline__ void attn_naive_phase(const Ctx& c, const AttnArgs& A) {
    float* sc = (float*)c.lds; float* qs = sc + 16 * SC_LD; float* misc = qs + 16 * 128;
    const int tid = c.tid; const bool act = tid < 256; const int row = (tid >> 4) & 15, sub = tid & 15;
    constexpr int QPB = MODE == 0 ? 8 : 16, NHB = MODE == 0 ? 8 : 16;
    const int nqt = S / QPB, nvb = NB * NHB * nqt;
    for (int vb = c.bid; vb < nvb; vb += c.G) {
        const int qt = vb % nqt, hh = (vb / nqt) % NHB, b = vb / (nqt * NHB);
        const int t0 = qt * QPB, nkeys = t0 + QPB;
        const int qi = MODE == 0 ? (row & 7) : row, comp = MODE == 0 ? (row >> 3) : 0;
        const int hq = MODE == 0 ? 2 * hh + comp : hh;
        const int t = t0 + qi;
        if (act) for (int i = tid; i < 16 * 128; i += 256) { const int r = i >> 7, d = i & 127; const int rq = MODE == 0 ? (r & 7) : r, rh = MODE == 0 ? 2 * hh + (r >> 3) : hh;
            qs[i] = h2f(A.Qb[((size_t)(b * NH + rh) * S + t0 + rq) * HD + d]); }
        float lam = 0.f;
        if (MODE == 0) { if (tid < 64) { float a = A.lq1[tid] * A.lk1[tid] + A.lq1[tid + 64] * A.lk1[tid + 64], cc = A.lq2[tid] * A.lk2[tid] + A.lq2[tid + 64] * A.lk2[tid + 64];
                for (int o = 32; o; o >>= 1) { a += __shfl_xor(a, o); cc += __shfl_xor(cc, o); }
                if (tid == 0) misc[0] = __expf(a) - __expf(cc) + A.lam_init; } }
        __syncthreads();
        if (MODE == 0) lam = misc[0];
        unsigned selbits = 0u; const int own = t0 >> 8;
        if (MODE == 1) {
            if (tid < 16) { float gate[8]; unsigned sb = 0u;
#pragma unroll
                for (int n = 0; n < 8; ++n) { float gsum = 0.f;
                    if (n < own) { const float* k0 = A.kpart + (size_t)((b * NH + hh) * 8 + n) * HD; const float* k1 = k0 + (size_t)NB * NH * 8 * HD;
                        for (int d = 0; d < 128; ++d) gsum = fmaf(qs[tid * 128 + d], (k0[d] + k1[d]) * (1.f / 256.f), gsum); }
                    gate[n] = n < own ? gsum : NEGF; }
#pragma unroll
                for (int k = 0; k < 3; ++k) { int best = -1; float bv = 0.f;
#pragma unroll
                    for (int n = 0; n < 8; ++n) if (!((sb >> n) & 1u) && (best < 0 || gate[n] > bv)) { best = n; bv = gate[n]; }
                    sb |= 1u << best; }
                misc[16 + tid] = __uint_as_float(sb & ((1u << own) - 1u)); }
            __syncthreads();
            selbits = __float_as_uint(misc[16 + row]);
        }
        if (act) {
            const float cq = MODE == 2 ? A.cum[(size_t)(b * NH + hh) * S + t] : 0.f;
            for (int s = sub; s < nkeys; s += 16) {
                const h16_t* kr = A.Kb + ((size_t)(b * NH + hq) * S + s) * HD; float dot = 0.f;
                for (int d = 0; d < 128; d += 8) { const u32x4 kv = *(const u32x4*)(kr + d); const float* qq = qs + row * 128 + d;
#pragma unroll
                    for (int j = 0; j < 4; ++j) { dot = fmaf(qq[2 * j], lo16(kv[j]), dot); dot = fmaf(qq[2 * j + 1], hi16(kv[j]), dot); } }
                float lg = dot * SCALE; bool ok = s <= t;
                if (MODE == 0 || MODE == 1) lg += A.rel[t5_bucket(t - s > 0 ? t - s : 0) * 16 + hq];
                if (MODE == 1) { const int blk = s >> 8; if (blk != own) ok = (selbits >> blk) & 1u; }
                if (MODE == 2) lg += cq - A.cum[(size_t)(b * NH + hh) * S + s];
                sc[row * SC_LD + s] = ok ? lg : NEGF;
            }
        }
        __syncthreads();
        if (act) {
            float mx = NEGF;
            for (int s = sub; s < nkeys; s += 16) mx = fmaxf(mx, sc[row * SC_LD + s]);
            for (int o = 8; o; o >>= 1) mx = fmaxf(mx, __shfl_xor(mx, o));
            float sum = 0.f;
            for (int s = sub; s < nkeys; s += 16) { const float p = __expf(sc[row * SC_LD + s] - mx); sc[row * SC_LD + s] = p; sum += p; }
            for (int o = 8; o; o >>= 1) sum += __shfl_xor(sum, o);
            const float inv = 1.f / sum;
            for (int s = sub; s < nkeys; s += 16) sc[row * SC_LD + s] *= inv;
        }
        __syncthreads();
        if (act) {
            if (MODE == 0) {
                const int q2 = tid >> 5, dl = tid & 31, d0 = dl * 8;
                const int vh = 2 * hh + (d0 >> 7), dd = d0 & 127;
                float o[8];
#pragma unroll
                for (int j = 0; j < 8; ++j) o[j] = 0.f;
                for (int s = 0; s < nkeys; ++s) { const float a = sc[q2 * SC_LD + s] - lam * sc[(8 + q2) * SC_LD + s];
                    const u32x4 vv = *(const u32x4*)(A.Vb + ((size_t)(b * NH + vh) * S + s) * HD + dd);
#pragma unroll
                    for (int j = 0; j < 4; ++j) { o[2 * j] = fmaf(a, lo16(vv[j]), o[2 * j]); o[2 * j + 1] = fmaf(a, hi16(vv[j]), o[2 * j + 1]); } }
                float ss = 0.f;
#pragma unroll
                for (int j = 0; j < 8; ++j) ss += o[j] * o[j];
                for (int off = 16; off; off >>= 1) ss += __shfl_xor(ss, off);
                const float r = rsqrtf(ss * (1.f / 256.f) + RMS_EPS) * (1.f - A.lam_init);
                const size_t gi = (size_t)(b * S + t0 + q2) * E + hh * 256 + d0;
                const u32x4 zv = *(const u32x4*)(A.Zb + gi); u32x4 ov;
#pragma unroll
                for (int j = 0; j < 4; ++j) { const float a0 = o[2 * j] * r * A.subg[d0 + 2 * j] * siluf(lo16(zv[j])), a1 = o[2 * j + 1] * r * A.subg[d0 + 2 * j + 1] * siluf(hi16(zv[j]));
                    ov[j] = pk2(a0, a1); }
                *(u32x4*)(A.G + gi) = ov;
            } else {
                const int d0 = sub * 8; float o[8];
#pragma unroll
                for (int j = 0; j < 8; ++j) o[j] = 0.f;
                for (int s = 0; s < nkeys; ++s) { const float a = sc[row * SC_LD + s];
                    const u32x4 vv = *(const u32x4*)(A.Vb + ((size_t)(b * NH + hh) * S + s) * HD + d0);
#pragma unroll
                    for (int j = 0; j < 4; ++j) { o[2 * j] = fmaf(a, lo16(vv[j]), o[2 * j]); o[2 * j + 1] = fmaf(a, hi16(vv[j]), o[2 * j + 1]); } }
                const size_t gi = (size_t)(b * S + t) * E + hh * 128 + d0;
                const u32x4 zv = *(const u32x4*)(A.Zb + gi); u32x4 ov;
#pragma unroll
                for (int j = 0; j < 4; ++j) ov[j] = pk2(o[2 * j] * siluf(lo16(zv[j])), o[2 * j + 1] * siluf(hi16(zv[j])));
                *(u32x4*)(A.G + gi) = ov;
            }
        }
        __syncthreads();
    }
}

namespace att {
typedef short s16x4 __attribute__((ext_vector_type(4)));
typedef float f32x16 __attribute__((ext_vector_type(16)));
constexpr int QBLK = 32, KVBLK = 64, SHM = KVBLK * HD * 2;
constexpr float THR = 8.f;
constexpr int L_V = 0, L_K = 2 * SHM;
#define KSWZ(row, colB) ((row) * 256 + ((colB) ^ (((row) & 7) << 4)))
#define SBAR() __builtin_amdgcn_sched_barrier(0)
__device__ __forceinline__ int v_st(int k, int c) { const int kk = (k & ~0xC) | ((k & 4) << 1) | ((k & 8) >> 1); return ((kk >> 3) * 4 + (c >> 5)) * 512 + ((kk & 7) * 32 + (c & 31)) * 2; }
__device__ __forceinline__ int v_rd_base(int lane) { return ((lane & 3) << 3) | (((lane >> 2) & 3) << 6) | (((lane >> 4) & 1) << 5) | (((lane >> 5) & 1) << 8); }
constexpr int v_rd_off(int d0, int ks, int half) { return d0 * 512 + ks * 4096 + half * 2048; }
__device__ __forceinline__ int crow(int r, int hi) { return (r & 3) + 8 * (r >> 2) + 4 * hi; }
__device__ __forceinline__ f16x8 ld8(const h16_t* p) { return *reinterpret_cast<const f16x8*>(p); }

template <int NCOMP> struct Lay {
    static constexpr int WS = L_K + 2 * NCOMP * SHM;
    static constexpr int OST = WS + NWAVES * 512;
    static constexpr int TAB = OST + (NCOMP == 1 ? 8 : 4) * 8192;
    static constexpr int MISC = TAB, LUT = TAB + 256, BIG = LUT + 2 * 352 * 4, END = BIG + 8192;
};
static_assert(Lay<1>::END <= XB_LDS_OFF && Lay<2>::END <= XB_LDS_OFF, "attention LDS map");

__device__ __forceinline__ void mask_tile(f32x16& p0, f32x16& p1, int dq) {
    const float NEG = -__builtin_inff();
#pragma unroll
    for (int r = 0; r < 16; ++r) { const int cc = (r & 3) + 8 * (r >> 2); if (dq - cc < 0) p0[r] = NEG; if (dq - cc - 32 < 0) p1[r] = NEG; }
}
__device__ __forceinline__ void bias_mask_tile(f32x16& p0, f32x16& p1, int dq, const float* lut) {
    const float NEG = -__builtin_inff(); const float* lp = lut + (dq + 128 - 63);
    float b0[16], b1[16];
#pragma unroll
    for (int r = 0; r < 16; ++r) { const int cc = (r & 3) + 8 * (r >> 2); b0[r] = lp[63 - cc]; b1[r] = lp[63 - cc - 32]; }
#pragma unroll
    for (int r = 0; r < 16; ++r) { const int cc = (r & 3) + 8 * (r >> 2); p0[r] = (dq - cc < 0) ? NEG : p0[r] + b0[r]; p1[r] = (dq - cc - 32 < 0) ? NEG : p1[r] + b1[r]; }
}
#define PK4(P, B_, OUT) do { unsigned a0 = pk2(P[B_+0], P[B_+1]), a1 = pk2(P[B_+2], P[B_+3]);                          \
        unsigned b0 = pk2(P[B_+4], P[B_+5]), b1 = pk2(P[B_+6], P[B_+7]);                                             \
        auto r0 = __builtin_amdgcn_permlane32_swap(a0, b0, false, false); auto r1 = __builtin_amdgcn_permlane32_swap(a1, b1, false, false); \
        u32x4 w = {r0[0], r1[0], r0[1], r1[1]}; OUT = __builtin_bit_cast(f16x8, w); } while (0)
__device__ __forceinline__ void partialSM(f32x16& p0, f32x16& p1, float& m_reg, float& alpha, float& ps0, f16x8& pa0, f16x8& pa1) {
    float pmax = p0[0];
#pragma unroll
    for (int r = 1; r < 16; ++r) pmax = fmaxf(pmax, p0[r]);
#pragma unroll
    for (int r = 0; r < 16; ++r) pmax = fmaxf(pmax, p1[r]);
    { auto rr = __builtin_amdgcn_permlane32_swap(__float_as_uint(pmax), __float_as_uint(pmax), false, false);
      pmax = fmaxf(__uint_as_float(rr[0]), __uint_as_float(rr[1])); }
    constexpr float C2 = 1.4426950408889634f * SCALE;
    float mn;
    if (__builtin_expect(__all((pmax - m_reg) * SCALE <= THR), 1)) { mn = m_reg; alpha = 1.f; }
    else { mn = fmaxf(m_reg, pmax); alpha = __builtin_amdgcn_exp2f((m_reg - mn) * C2); m_reg = mn; }
    const float mnL = -mn * C2;
#pragma unroll
    for (int r = 0; r < 16; ++r) p0[r] = fmaf(p0[r], C2, mnL);
#pragma unroll
    for (int r = 0; r < 16; ++r) p1[r] = fmaf(p1[r], C2, mnL);
#pragma unroll
    for (int r = 0; r < 16; ++r) p0[r] = __builtin_amdgcn_exp2f(p0[r]);
    float ps = 0;
#pragma unroll
    for (int r = 0; r < 16; ++r) ps += p0[r];
    ps0 = ps;
    PK4(p0, 0, pa0); PK4(p0, 8, pa1);
}
__device__ __forceinline__ void finishSM(f32x16& p1, float alpha, float ps0, float& l_reg, f16x8& pa2, f16x8& pa3) {
#pragma unroll
    for (int r = 0; r < 16; ++r) p1[r] = __builtin_amdgcn_exp2f(p1[r]);
    float ps = ps0;
#pragma unroll
    for (int r = 0; r < 16; ++r) ps += p1[r];
    { auto rr = __builtin_amdgcn_permlane32_swap(__float_as_uint(ps), __float_as_uint(ps), false, false);
      ps = __uint_as_float(rr[0]) + __uint_as_float(rr[1]); }
    l_reg = l_reg * alpha + ps;
    PK4(p1, 0, pa2); PK4(p1, 8, pa3);
}
#undef PK4
template <int KB, int NCOMP>
__device__ __forceinline__ void qkt(f32x16& p0, f32x16& p1, const char* Kc_lds, int kswz0, const f16x8* qr) {
    int kb_ = kswz0; asm volatile("" : "+v"(kb_));
#pragma unroll
    for (int d0 = 0; d0 < 8; ++d0) { const char* a = Kc_lds + KB * (NCOMP * SHM) + (kb_ ^ ((d0 & 3) << 5)) + (d0 >> 2) * 128;
        const f16x8 b0 = *reinterpret_cast<const f16x8*>(a);
        const f16x8 b1 = *reinterpret_cast<const f16x8*>(a + 32 * 256);
        p0 = __builtin_amdgcn_mfma_f32_32x32x16_f16(b0, qr[d0], p0, 0, 0, 0);
        p1 = __builtin_amdgcn_mfma_f32_32x32x16_f16(b1, qr[d0], p1, 0, 0, 0); }
}
template <int VB>
__device__ __forceinline__ void pv_tile(f32x16* o, int vb0, f16x8 pa0, f16x8 pa1, f16x8 pa2, f16x8 pa3) {
#define TRRD(dst, off) asm volatile("ds_read_b64_tr_b16 %0, %1 offset:%2" : "=&v"(dst) : "v"(vb0), "i"(off) : "memory")
#define PKV(l, h) __builtin_bit_cast(f16x8, (short __attribute__((ext_vector_type(8)))){l[0], l[1], l[2], l[3], h[0], h[1], h[2], h[3]})
#define PV_D0(d0) do { s16x4 l0, l1, l2, l3, h0, h1, h2, h3; constexpr int b_ = L_V + VB * SHM + v_rd_off(d0, 0, 0); \
        TRRD(l0, b_); TRRD(h0, b_ + 2048); TRRD(l1, b_ + 4096); TRRD(h1, b_ + 6144); TRRD(l2, b_ + 8192); TRRD(h2, b_ + 10240); TRRD(l3, b_ + 12288); TRRD(h3, b_ + 14336); \
        asm volatile("s_waitcnt lgkmcnt(0)" ::: "memory"); SBAR();   \
        o[d0] = __builtin_amdgcn_mfma_f32_32x32x16_f16(pa0, PKV(l0, h0), o[d0], 0, 0, 0);   \
        o[d0] = __builtin_amdgcn_mfma_f32_32x32x16_f16(pa1, PKV(l1, h1), o[d0], 0, 0, 0);   \
        o[d0] = __builtin_amdgcn_mfma_f32_32x32x16_f16(pa2, PKV(l2, h2), o[d0], 0, 0, 0);   \
        o[d0] = __builtin_amdgcn_mfma_f32_32x32x16_f16(pa3, PKV(l3, h3), o[d0], 0, 0, 0); } while (0)
    PV_D0(0); PV_D0(1); PV_D0(2); PV_D0(3);
#undef PV_D0
#undef PKV
#undef TRRD
}

struct BlockRef { unsigned qoff, koff, voff; int P0; int b, h, half, x; };
template <int NCOMP> struct Seam { f16x8 qr[8]; f16x8 st[2 * NCOMP]; };
struct BlkCtx { unsigned selbits; int own; };
struct EpiArgs { const h16_t* Zb; h16_t* G; const float* subg; float lam_init; };

constexpr size_t HSTR = (size_t)S * HD;
#define ROW(p, k0, rr) ((p) + (size_t)((k0) + (rr)) * HD + sc)
#define VMW() asm volatile("s_waitcnt vmcnt(0)" ::: "memory")
#define VMWN(n) asm volatile("s_waitcnt vmcnt(%0)" :: "i"(n) : "memory")

__device__ __forceinline__ f16x8 ldg8(const void* ubase, unsigned off) { return *reinterpret_cast<const f16x8*>((const char*)ubase + off); }
template <int NCOMP>
__device__ __forceinline__ void sload_k(Seam<NCOMP>& S_, const h16_t* Kp, int k0, unsigned loff) {
    const char* kb_ = (const char*)Kp + (size_t)k0 * (HD * 2);
#pragma unroll
    for (int cc = 0; cc < NCOMP; ++cc) { S_.st[2 * cc] = ldg8(kb_ + cc * (HSTR * 2), loff); S_.st[2 * cc + 1] = ldg8(kb_ + cc * (HSTR * 2) + 32 * HD * 2, loff); }
}
template <int NCOMP>
__device__ __forceinline__ void sload_v(Seam<NCOMP>& S_, const h16_t* Vp, int k0, unsigned loff) {
    const char* vb_ = (const char*)Vp + (size_t)k0 * (HD * 2);
    S_.st[0] = ldg8(vb_, loff); S_.st[1] = ldg8(vb_ + 32 * HD * 2, loff);
}
template <int NCOMP>
__device__ __forceinline__ void swrite_k(const Seam<NCOMP>& S_, char* lds, int bf, unsigned loff_in) {
    unsigned lo_ = loff_in; asm volatile("" : "+v"(lo_)); const int kws = (int)(lo_ ^ (((lo_ >> 8) & 7u) << 4));
#pragma unroll
    for (int cc = 0; cc < NCOMP; ++cc) { *(f16x8*)(lds + L_K + (bf * NCOMP + cc) * SHM + kws) = S_.st[2 * cc]; *(f16x8*)(lds + L_K + (bf * NCOMP + cc) * SHM + kws + 32 * 256) = S_.st[2 * cc + 1]; }
}
template <int NCOMP>
__device__ __forceinline__ void swrite_v(const Seam<NCOMP>& S_, char* lds, int bf, unsigned loff_in) {
    unsigned lo_ = loff_in; asm volatile("" : "+v"(lo_)); const int vst0 = v_st((int)(lo_ >> 8), (int)((lo_ & 255u) >> 1));
    *(f16x8*)(lds + L_V + bf * SHM + vst0) = S_.st[0]; *(f16x8*)(lds + L_V + bf * SHM + vst0 + 8192) = S_.st[1];
}
template <int NCOMP>
__device__ __forceinline__ void att_prime(const BlockRef& cur, const h16_t* Qb, const h16_t* Kb, const h16_t* Vb, char* lds, Seam<NCOMP>& S_, int tid) {
    const int wid = __builtin_amdgcn_readfirstlane(tid >> 6), lane = tid & 63, r32 = lane & 31, hi = lane >> 5;
    const int comp = NCOMP == 2 ? (wid >> 2) : 0, wq = NCOMP == 2 ? (wid & 3) : wid;
    const int sr = tid >> 4, sc = (tid & 15) * 8; const unsigned loff = (unsigned)(sr * HD + sc) * 2u;
    { const char* qb_ = (const char*)(Qb + cur.qoff + comp * HSTR + (size_t)(wq * QBLK) * HD); const unsigned qo_ = (unsigned)(r32 * HD + hi * 8) * 2u;
#pragma unroll
      for (int d0 = 0; d0 < 8; ++d0) S_.qr[d0] = ldg8(qb_ + d0 * 32, qo_); }
    sload_k<NCOMP>(S_, Kb + cur.koff, 0, loff); VMW(); swrite_k<NCOMP>(S_, lds, 0, loff); SBAR(); sload_v<NCOMP>(S_, Vb + cur.voff, 0, loff);
    __syncthreads();
}

template <int MODE>
__device__ __forceinline__ void epilogue_part(const BlockRef& cur, char* lds, f32x16 (&o)[4], float l_reg, const EpiArgs& ea, int tid_in) {
    constexpr int NCOMP = MODE == 0 ? 2 : 1;
    typedef Lay<NCOMP> L;
    int tid = tid_in; asm volatile("" : "+v"(tid));
    const int wid = __builtin_amdgcn_readfirstlane(tid >> 6), lane = tid & 63, r32 = lane & 31, hi = lane >> 5;
    const int comp = NCOMP == 2 ? (wid >> 2) : 0, wq = NCOMP == 2 ? (wid & 3) : wid;
    float* ws = (float*)(lds + L::WS) + wid * 128; float* li_l = ws;
    if (hi == 0) li_l[r32] = l_reg; asm volatile("s_waitcnt lgkmcnt(0)" ::: "memory");
    float rli[16];
#pragma unroll
    for (int r = 0; r < 16; ++r) rli[r] = __builtin_amdgcn_rcpf(li_l[crow(r, hi)]);
    if (MODE != 0) {
        h16_t* stg = (h16_t*)(lds + L::OST) + wid * 4096;
#pragma unroll
        for (int r = 0; r < 16; ++r) { const int orow = crow(r, hi);
#pragma unroll
            for (int d0 = 0; d0 < 4; ++d0) stg[orow * 128 + d0 * 32 + r32] = f2h(o[d0][r] * rli[r]); }
        asm volatile("s_waitcnt lgkmcnt(0)" ::: "memory");
        const size_t gbase = ((size_t)(cur.b * S + cur.P0 + wq * QBLK) * E + cur.h * HD) * 2;
        const unsigned go_ = (unsigned)((lane >> 4) * E + (lane & 15) * 8) * 2u;
#pragma unroll
        for (int i = 0; i < 8; ++i) { const int row = i * 4 + (lane >> 4), ch = lane & 15;
            const u32x4 ov = *(const u32x4*)(stg + row * 128 + ch * 8);
            const u32x4 zv = *(const u32x4*)((const char*)ea.Zb + gbase + (size_t)i * (4 * E * 2) + go_); u32x4 w;
#pragma unroll
            for (int e = 0; e < 4; ++e) w[e] = pk2(lo16(ov[e]) * siluf(lo16(zv[e])), hi16(ov[e]) * siluf(hi16(zv[e])));
            *(u32x4*)((char*)ea.G + gbase + (size_t)i * (4 * E * 2) + go_) = w; SBAR(); }
    } else {
        unsigned* xch = (unsigned*)(lds + L::OST) + wq * 2048;
        if (comp == 1) { const float lam_ = ((const float*)(lds + L::MISC))[0];
#pragma unroll
            for (int d0 = 0; d0 < 4; ++d0)
#pragma unroll
                for (int r = 0; r < 16; r += 2) xch[(d0 * 8 + (r >> 1)) * 64 + lane] = pk2(o[d0][r] * rli[r] * lam_, o[d0][r + 1] * rli[r + 1] * lam_);
        }
        asm volatile("s_waitcnt lgkmcnt(0)" ::: "memory");
        __syncthreads();
        if (comp == 0) {
            float ssq[16];
#pragma unroll
            for (int r = 0; r < 16; ++r) ssq[r] = 0.f;
#pragma unroll
            for (int d0 = 0; d0 < 4; ++d0)
#pragma unroll
                for (int r = 0; r < 16; r += 2) { const unsigned w = xch[(d0 * 8 + (r >> 1)) * 64 + lane];
                    o[d0][r] = o[d0][r] * rli[r] - lo16(w); o[d0][r + 1] = o[d0][r + 1] * rli[r + 1] - hi16(w);
                    ssq[r] += o[d0][r] * o[d0][r]; ssq[r + 1] += o[d0][r + 1] * o[d0][r + 1]; }
#pragma unroll
            for (int r = 0; r < 16; ++r) ssq[r] = hsum32(ssq[r]);
            float* ssq_l = ws + 64;
            asm volatile("s_waitcnt lgkmcnt(0)" ::: "memory");
            h16_t* stg = (h16_t*)xch;
#pragma unroll
            for (int r = 0; r < 16; ++r) { const int orow = crow(r, hi);
#pragma unroll
                for (int d0 = 0; d0 < 4; ++d0) stg[orow * 128 + d0 * 32 + r32] = f2h(o[d0][r]); }
            const size_t gbase = ((size_t)(cur.b * S + cur.P0 + wq * QBLK) * E + cur.h * 256) * 2;
            const unsigned go_ = (unsigned)((lane >> 4) * E + (lane & 15) * 8) * 2u;
            if (cur.half == 0) {
                if (r32 == 0) {
#pragma unroll
                    for (int r = 0; r < 16; ++r) ssq_l[crow(r, hi)] = ssq[r]; }
                asm volatile("s_waitcnt lgkmcnt(0)" ::: "memory");
#pragma unroll
                for (int i = 0; i < 8; ++i) { const int row = i * 4 + (lane >> 4), ch = lane & 15;
                    *(u32x4*)((char*)ea.G + gbase + (size_t)i * (4 * E * 2) + go_) = *(const u32x4*)(stg + row * 128 + ch * 8); }
            } else {
                if (r32 == 0) {
#pragma unroll
                    for (int r = 0; r < 16; ++r) { const int orow = crow(r, hi); ssq_l[orow] = rsqrtf((ssq_l[orow] + ssq[r]) * (1.f / 256.f) + RMS_EPS) * (1.f - ea.lam_init); } }
                asm volatile("s_waitcnt vmcnt(0) lgkmcnt(0)" ::: "memory");
#pragma unroll
                for (int i = 0; i < 8; ++i) { const int row = i * 4 + (lane >> 4), ch = lane & 15; const float rs = ssq_l[row];
                    const size_t g0 = gbase + (size_t)i * (4 * E * 2), g1 = g0 + 256;
                    const u32x4 u1 = *(const u32x4*)(stg + row * 128 + ch * 8), u0 = *(const u32x4*)((const char*)ea.G + g0 + go_);
                    const u32x4 z0 = *(const u32x4*)((const char*)ea.Zb + g0 + go_), z1 = *(const u32x4*)((const char*)ea.Zb + g1 + go_);
                    const f32x4 ga = *(const f32x4*)(ea.subg + ch * 8), gb = *(const f32x4*)(ea.subg + ch * 8 + 4), gc = *(const f32x4*)(ea.subg + 128 + ch * 8), gd = *(const f32x4*)(ea.subg + 128 + ch * 8 + 4);
                    const float g0v[8] = {ga[0], ga[1], ga[2], ga[3], gb[0], gb[1], gb[2], gb[3]}, g1v[8] = {gc[0], gc[1], gc[2], gc[3], gd[0], gd[1], gd[2], gd[3]};
                    u32x4 w0, w1;
#pragma unroll
                    for (int e = 0; e < 4; ++e) {
                        w0[e] = pk2(lo16(u0[e]) * rs * g0v[2 * e] * siluf(lo16(z0[e])), hi16(u0[e]) * rs * g0v[2 * e + 1] * siluf(hi16(z0[e])));
                        w1[e] = pk2(lo16(u1[e]) * rs * g1v[2 * e] * siluf(lo16(z1[e])), hi16(u1[e]) * rs * g1v[2 * e + 1] * siluf(hi16(z1[e]))); }
                    *(u32x4*)((char*)ea.G + g0 + go_) = w0; *(u32x4*)((char*)ea.G + g1 + go_) = w1; SBAR(); }
            }
        }
    }
}

template <int MODE>
__device__ __forceinline__ void att_block(const BlockRef& cur, const BlockRef& nxt, const h16_t* Qb, const h16_t* Kb, const h16_t* Vb, char* lds, Seam<(MODE == 0 ? 2 : 1)>& S_, const BlkCtx& bc, const EpiArgs& ea, int tid_in) {
    constexpr int NCOMP = MODE == 0 ? 2 : 1, QROWS = 256 / NCOMP;
    typedef Lay<NCOMP> L;
    int tid = tid_in; asm volatile("" : "+v"(tid));
    const int wid = __builtin_amdgcn_readfirstlane(tid >> 6), lane = tid & 63, r32 = lane & 31, hi = lane >> 5;
    const int comp = NCOMP == 2 ? (wid >> 2) : 0, wq = NCOMP == 2 ? (wid & 3) : wid;
    const int NT = (cur.P0 + QROWS) / KVBLK;
    const int qlo = cur.P0 + wq * QBLK, qm = qlo + r32 - 4 * hi;
    const char* Kc_lds = lds + L_K + comp * SHM;
    float* ws = (float*)(lds + L::WS) + wid * 128; float* li_l = ws; float* al_l = ws + 32;
    const float* lut = (const float*)(lds + L::LUT) + comp * 352;
    const float* cumS = (const float*)(lds + L::BIG);
    float m_reg = -1e30f, l_reg = 0; f32x16 o[4] = {};
    const int sr = tid >> 4, sc = (tid & 15) * 8; const int kswz0 = KSWZ(r32, hi * 16);
    const int vb0 = (int)(uintptr_t)lds + v_rd_base(lane);
    const unsigned loff = (unsigned)(sr * HD + sc) * 2u;
    const h16_t* Kh = Kb + cur.koff; const h16_t* Vh = Vb + cur.voff;
#define RESC(a) do { if (__any((a) < 1.f)) { if (hi == 0) al_l[r32] = (a); asm volatile("s_waitcnt lgkmcnt(0)" ::: "memory");              \
                     _Pragma("unroll") for (int d_ = 0; d_ < 4; ++d_) _Pragma("unroll") for (int r = 0; r < 16; ++r) o[d_][r] *= al_l[crow(r, hi)]; } } while (0)
#define KBASE(t) ((t) * KVBLK)
#define T_ABOVE(t) (KBASE(t) > qlo + QBLK - 1)
#define T_NEAR(t) (KBASE(t) + KVBLK - 1 >= qlo - 112)
#define MKINIT(i0, i1, t) do { const int kb_ = KBASE(t);                                                                                  \
        if (MODE == 2) { const float* cp_ = cumS + kb_ + 4 * hi; const float cq_ = cumS[qlo + r32];                                                                \
            _Pragma("unroll") for (int g_ = 0; g_ < 4; ++g_) { const f32x4 c0_ = *(const f32x4*)(cp_ + 8 * g_), c1_ = *(const f32x4*)(cp_ + 32 + 8 * g_); \
                _Pragma("unroll") for (int e_ = 0; e_ < 4; ++e_) { i0[4 * g_ + e_] = cq_ - c0_[e_]; i1[4 * g_ + e_] = cq_ - c1_[e_]; } } }          \
        else { float v_ = T_NEAR(t) ? 0.f : lut[328];                                                                               \
            if (MODE == 1) { const int blk_ = kb_ >> 8; if (blk_ != bc.own && !((bc.selbits >> blk_) & 1u)) v_ = -__builtin_inff(); } \
            _Pragma("unroll") for (int r = 0; r < 16; ++r) { i0[r] = v_; i1[r] = v_; } } } while (0)
#define MASKT(P0_, P1_, t) do { const int kb_ = KBASE(t);                                                                         \
        if (T_ABOVE(t)) { const float NEG_ = -__builtin_inff(); _Pragma("unroll") for (int r = 0; r < 16; ++r) { P0_[r] = NEG_; P1_[r] = NEG_; } } \
        else if (MODE == 2) { if (kb_ + KVBLK - 1 > qlo) mask_tile(P0_, P1_, qm - kb_); }                                          \
        else if (T_NEAR(t)) bias_mask_tile(P0_, P1_, qm - kb_, lut); } while (0)
    constexpr int NQL = 8;
#define SEAM_K0() do { VMWN(NQL); swrite_k<NCOMP>(S_, lds, 0, loff); SBAR(); sload_v<NCOMP>(S_, Vb + nxt.voff, 0, loff); SBAR(); } while (0)
    f32x16 pA0, pA1, pB0, pB1; float alA, alB, psA, psB; f16x8 pa0, pa1, pa2, pa3;
    VMW(); swrite_v<NCOMP>(S_, lds, 0, loff); SBAR();
    sload_k<NCOMP>(S_, Kh, KBASE(1), loff);
    MKINIT(pA0, pA1, 0);
    SBAR(); qkt<0, NCOMP>(pA0, pA1, Kc_lds, kswz0, S_.qr);
    VMW(); swrite_k<NCOMP>(S_, lds, 1, loff); SBAR(); sload_v<NCOMP>(S_, Vh, KBASE(1), loff); SBAR();
    MASKT(pA0, pA1, 0); partialSM(pA0, pA1, m_reg, alA, psA, pa0, pa1);
    VMW(); swrite_v<NCOMP>(S_, lds, 1, loff); SBAR(); if (NT > 2) sload_k<NCOMP>(S_, Kh, KBASE(2), loff);
    __syncthreads();
#define HALF_STEP(PX0, PX1, alX, psX, PY1, alY, psY, t, KB, VB, SB) do {                                                          \
        MKINIT(PX0, PX1, t);                                                                                                  \
        SBAR(); qkt<KB, NCOMP>(PX0, PX1, Kc_lds, kswz0, S_.qr);                                                             \
        finishSM(PY1, alY, psY, l_reg, pa2, pa3); SBAR();                                                                     \
        if ((t) + 1 < NT) { VMW(); swrite_k<NCOMP>(S_, lds, SB, loff); SBAR(); sload_v<NCOMP>(S_, Vh, KBASE((t) + 1), loff); SBAR(); } \
        pv_tile<VB>(o, vb0, pa0, pa1, pa2, pa3); MASKT(PX0, PX1, (t)); partialSM(PX0, PX1, m_reg, alX, psX, pa0, pa1);               \
        __syncthreads();                                                                                                      \
        if ((t) + 1 < NT) { VMW(); swrite_v<NCOMP>(S_, lds, SB, loff); SBAR(); if ((t) + 2 < NT) sload_k<NCOMP>(S_, Kh, KBASE((t) + 2), loff); } \
        RESC(alX); __syncthreads(); } while (0)
    for (int t = 1; t + 1 < NT; t += 2) {
        HALF_STEP(pB0, pB1, alB, psB, pA1, alA, psA, t, 1, 0, 0);
        HALF_STEP(pA0, pA1, alA, psA, pB1, alB, psB, t + 1, 0, 1, 1);
    }
    MKINIT(pB0, pB1, NT - 1);
    SBAR(); qkt<1, NCOMP>(pB0, pB1, Kc_lds, kswz0, S_.qr); SBAR();
    sload_k<NCOMP>(S_, Kb + nxt.koff, 0, loff); SBAR();
    { const char* qb_ = (const char*)(Qb + nxt.qoff + comp * HSTR + (size_t)(wq * QBLK) * HD); const unsigned qo_ = (unsigned)(r32 * HD + hi * 8) * 2u;
#pragma unroll
        for (int d0 = 0; d0 < 8; ++d0) S_.qr[d0] = ldg8(qb_ + d0 * 32, qo_); }
    SBAR();
    finishSM(pA1, alA, psA, l_reg, pa2, pa3); SBAR();
    pv_tile<0>(o, vb0, pa0, pa1, pa2, pa3);
    MASKT(pB0, pB1, NT - 1); partialSM(pB0, pB1, m_reg, alB, psB, pa0, pa1); __syncthreads(); RESC(alB);
    finishSM(pB1, alB, psB, l_reg, pa2, pa3); SBAR(); pv_tile<1>(o, vb0, pa0, pa1, pa2, pa3);
    SBAR(); SEAM_K0();
    epilogue_part<MODE>(cur, lds, o, l_reg, ea, tid_in);
    __syncthreads();
#undef RESC
#undef KBASE
#undef T_ABOVE
#undef T_NEAR
#undef MKINIT
#undef MASKT
#undef SEAM_K0
#undef HALF_STEP
}

template <int MODE>
__device__ __forceinline__ BlockRef att_ref(int item, int j) {
    BlockRef r;
    if (MODE == 0) { const int bh = item >> 3, y = item & 7, x = (j < 2) ? y : 15 - y; r.b = bh >> 3; r.h = bh & 7; r.half = j & 1; r.x = x; r.P0 = x * 128;
        const unsigned hb = (unsigned)(r.b * NH + 2 * r.h) * (unsigned)HSTR; r.qoff = hb + (unsigned)r.P0 * HD; r.koff = hb; r.voff = hb + r.half * (unsigned)HSTR; }
    else { const int bh = item >> 2, y = item & 3, x = (j == 0) ? y : 7 - y; r.b = bh >> 4; r.h = bh & 15; r.half = 0; r.x = x; r.P0 = x * 256;
        const unsigned hb = (unsigned)(r.b * NH + r.h) * (unsigned)HSTR; r.qoff = hb + (unsigned)r.P0 * HD; r.koff = hb; r.voff = hb; }
    return r;
}
template <int MODE>
__device__ __forceinline__ void attn_phase(const Ctx& c, const AttnArgs& A) {
    constexpr int NCOMP = MODE == 0 ? 2 : 1, NBLK = MODE == 0 ? 4 : 2, NITEMS = 256;
    typedef Lay<NCOMP> L;
    char* lds = (char*)c.lds;
    const int tid = c.tid, wid = c.wave, lane = c.lane, r32 = lane & 31, hi = lane >> 5;
    const int comp = NCOMP == 2 ? (wid >> 2) : 0, wq = NCOMP == 2 ? (wid & 3) : wid;
    const int vcu = (c.G % 8 == 0) ? (c.bid % 8) * (c.G / 8) + c.bid / 8 : c.bid;
    float* misc = (float*)(lds + L::MISC); float* lutw = (float*)(lds + L::LUT); float* big = (float*)(lds + L::BIG);
    EpiArgs ea{A.Zb, A.G, A.subg, A.lam_init};
    if (MODE == 0) {
        if (tid < 64) { float a = A.lq1[tid] * A.lk1[tid] + A.lq1[tid + 64] * A.lk1[tid + 64], cc = A.lq2[tid] * A.lk2[tid] + A.lq2[tid + 64] * A.lk2[tid + 64];
            a = wave_sum(a); cc = wave_sum(cc); if (tid == 0) misc[0] = __expf(a) - __expf(cc) + A.lam_init; }
        __syncthreads();
    }
    Seam<NCOMP> S_;
    int item = vcu; if (item >= NITEMS) return;
    int j = 0; BlockRef cur = att_ref<MODE>(item, 0);
    att_prime<NCOMP>(cur, A.Qb, A.Kb, A.Vb, lds, S_, tid);
    bool new_item = true;
    for (;;) {
        if (new_item) {
            int tid = c.tid; asm volatile("" : "+v"(tid)); const int lane = tid & 63;
            if (MODE != 2) { for (int i = tid; i < NCOMP * 352; i += NTHREADS) { const int cc = i / 352, ii = i % 352, dist = ii - 128; const int hq = MODE == 0 ? 2 * cur.h + cc : cur.h;
                    lutw[i] = A.rel[t5_bucket(dist > 0 ? dist : 0) * 16 + hq] * (1.f / SCALE); } }
            if (MODE == 1) { for (int i = tid; i < 8 * 128; i += NTHREADS) { const float* k0 = A.kpart + (size_t)(cur.b * NH + cur.h) * 8 * HD + i; big[i] = (k0[0] + k0[(size_t)NB * NH * 8 * HD]) * (1.f / 256.f); } }
            if (MODE == 2) {
                float v[4];
#pragma unroll
                for (int e = 0; e < 4; ++e) v[e] = A.logf[(size_t)(cur.b * S + 4 * tid + e) * NH + cur.h];
                v[1] += v[0]; v[2] += v[1]; v[3] += v[2];
                float incl = v[3];
#pragma unroll
                for (int o = 1; o < 64; o <<= 1) { const float t = __int_as_float(__builtin_amdgcn_ds_bpermute(((lane - o) & 63) << 2, __float_as_int(incl))); if (lane >= o) incl += t; }
                if (lane == 63) misc[8 + wid] = incl;
                __syncthreads();
                float off = incl - v[3];
                for (int w = 0; w < wid; ++w) off += misc[8 + w];
                const f32x4 o4 = {(v[0] + off) * (1.f / SCALE), (v[1] + off) * (1.f / SCALE), (v[2] + off) * (1.f / SCALE), (v[3] + off) * (1.f / SCALE)};
                *(f32x4*)(big + 4 * tid) = o4;
            }
            __syncthreads();
            new_item = false;
        }
        BlkCtx bc; bc.selbits = 0u; bc.own = cur.x;
        if (MODE == 1) {
            float gate[8];
#pragma unroll
            for (int n = 0; n < 8; ++n) { float gs = 0.f;
                if (n < cur.x) {
#pragma unroll
                    for (int d0 = 0; d0 < 8; ++d0) { const float* kp = big + n * 128 + d0 * 16 + hi * 8; const f32x4 k0 = *(const f32x4*)kp, k1 = *(const f32x4*)(kp + 4); const f16x8 q = S_.qr[d0];
                        gs += (float)q[0] * k0[0] + (float)q[1] * k0[1] + (float)q[2] * k0[2] + (float)q[3] * k0[3] + (float)q[4] * k1[0] + (float)q[5] * k1[1] + (float)q[6] * k1[2] + (float)q[7] * k1[3]; }
                    gs = xadd32(gs); }
                gate[n] = n < cur.x ? gs : NEGF; SBAR(); }
            unsigned sb = 0u;
#pragma unroll
            for (int k = 0; k < 3; ++k) { int best = -1; float bv = 0.f;
#pragma unroll
                for (int n = 0; n < 8; ++n) if (!((sb >> n) & 1u) && (best < 0 || gate[n] > bv)) { best = n; bv = gate[n]; }
                sb |= 1u << best; }
            bc.selbits = sb & ((1u << cur.x) - 1u);
        }
        int itemn = item, jn = j + 1; bool last = false;
        if (jn == NBLK) { jn = 0; itemn = item + c.G; if (itemn >= NITEMS) { last = true; itemn = item; jn = j; } }
        const BlockRef nxt = att_ref<MODE>(itemn, jn);
        att_block<MODE>(cur, nxt, A.Qb, A.Kb, A.Vb, lds, S_, bc, ea, tid);
        if (last) break;
        new_item = itemn != item; cur = nxt; item = itemn; j = jn;
    }
    VMW();
}
#undef ROW
#undef VMW
#undef VMWN
#undef KSWZ
#undef SBAR
}

#define XB_TMO      128
#define XB_XCNT(j)  (256  + 64 * (j))
#define XB_XSUB(j)  (1280 + 64 * (j))
#define XB_XGEN(j)  (2304 + 64 * (j))
#define XB_TOP      3328
#define XB_TOPGEN   3392
#define XCD_BAR_WORDS 3456
#define XB_SPIN_CAP (1u << 18)
__device__ __forceinline__ unsigned xb_ld(unsigned* p)              { return __hip_atomic_load(p, __ATOMIC_RELAXED, __HIP_MEMORY_SCOPE_AGENT); }
__device__ __forceinline__ unsigned xb_add(unsigned* p, unsigned v) { return __hip_atomic_fetch_add(p, v, __ATOMIC_RELAXED, __HIP_MEMORY_SCOPE_AGENT); }
__device__ __forceinline__ unsigned xb_xcc_id() { return (unsigned)__builtin_amdgcn_s_getreg((3 << 11) | 20) & 0xFu; }
#define XB_SPIN(cond, bar) do { unsigned _sp = 0; while (cond) { __builtin_amdgcn_s_sleep(1); \
    if ((++_sp & 255u) == 0u) { if (xb_ld(&(bar)[XB_TMO])) break; if (_sp > XB_SPIN_CAP) { atomicAdd(&(bar)[XB_TMO], 1u); break; } } } } while (0)
struct XcdBarrier { unsigned* bar; unsigned x; volatile LAS unsigned* st; };
__device__ __forceinline__ void xcd_barrier_complete(unsigned* bar, unsigned x, unsigned& nloc, unsigned& nx) {
    const unsigned G = gridDim.x * gridDim.y * gridDim.z;
    unsigned sum, cnt, mine, sp = 0u;
    for (;;) {
        sum = 0u; cnt = 0u; mine = 0u;
#pragma unroll
        for (unsigned j = 0; j < 16; ++j) { const unsigned c = xb_ld(&bar[XB_XCNT(j)]); sum += c; cnt += (c > 0u) ? 1u : 0u; mine = (j == x) ? c : mine; }
        if (sum == G) break;
        __builtin_amdgcn_s_sleep(1);
        if ((++sp & 255u) == 0u) { if (xb_ld(&bar[XB_TMO])) break; if (sp > XB_SPIN_CAP) { atomicAdd(&bar[XB_TMO], 1u); break; } }
    }
    nloc = mine > 0u ? mine : 1u; nx = cnt > 0u ? cnt : 1u;
}
__device__ __forceinline__ void xcd_barrier(const XcdBarrier& b, bool leader_thread) {
    asm volatile("s_waitcnt vmcnt(0)" ::: "memory");
    __syncthreads();
    if (leader_thread) {
        unsigned* bar = b.bar;
        __builtin_amdgcn_s_waitcnt(0);
        unsigned nloc = b.st[0], nx = b.st[1];
        if (nloc == 0u) { xcd_barrier_complete(bar, b.x, nloc, nx); b.st[0] = nloc; b.st[1] = nx; }
        const unsigned old = xb_add(&bar[XB_XSUB(b.x)], 1u);
        const unsigned gen = old / nloc;
        if (old + 1u == (gen + 1u) * nloc) {
            __builtin_amdgcn_fence(__ATOMIC_RELEASE, "agent");
            asm volatile("s_waitcnt vmcnt(0)" ::: "memory");
            const unsigned og = xb_add(&bar[XB_TOP], 1u);
            const unsigned tg = og / nx;
            if (og + 1u == (tg + 1u) * nx) xb_add(&bar[XB_TOPGEN], 1u);
            else XB_SPIN(xb_ld(&bar[XB_TOPGEN]) == tg, bar);
            __builtin_amdgcn_fence(__ATOMIC_ACQUIRE, "agent");
            xb_add(&bar[XB_XGEN(b.x)], 1u);
            asm volatile("s_waitcnt vmcnt(0)" ::: "memory");
        } else {
            XB_SPIN(xb_ld(&bar[XB_XGEN(b.x)]) == gen, bar);
            __builtin_amdgcn_fence(__ATOMIC_ACQUIRE, "agent");
            asm volatile("s_waitcnt vmcnt(0)" ::: "memory");
        }
    }
    __syncthreads();
}

struct Args { const float* in[29]; float* out; unsigned char* ws; int ph_lo, ph_hi; };
static_assert(sizeof(Args) == 31 * 8 + 8, "Args has no padding");

__global__ void __launch_bounds__(NTHREADS, 2) mega_fwd(Args args) {
    extern __shared__ __attribute__((aligned(16))) unsigned char lds[];
    cg::grid_group grid = cg::this_grid();
    const int wave_id = __builtin_amdgcn_readfirstlane(threadIdx.x >> 6);
    volatile LAS unsigned* xst = (volatile LAS unsigned*)((LAS unsigned char*)lds + XB_LDS_OFF);
    if (threadIdx.x < 4) xst[threadIdx.x] = 0u;
    __syncthreads();
    XcdBarrier xbar; xbar.bar = (unsigned*)(args.ws + WS_CTL) + 1024; xbar.x = xb_xcc_id(); xbar.st = xst;
    if (threadIdx.x == 0) (void)xb_add(&xbar.bar[XB_XCNT(xbar.x)], 1u);
#define W_X (args.in[0])
#define W_REL (args.in[1])
#define W_HB ((h16_t*)(ws + WS_HB))
#define W_Q ((h16_t*)(ws + WS_Q))
#define W_K ((h16_t*)(ws + WS_K))
#define W_V ((h16_t*)(ws + WS_V))
#define W_Z ((h16_t*)(ws + WS_Z))
#define W_G ((h16_t*)(ws + WS_G))
#define W_STATS ((float*)(ws + WS_STATS))
#define W_KPART ((float*)(ws + WS_KPART))
#define W_LOGF ((float*)(ws + WS_LOGF))
#define W_CUM ((float*)(ws + WS_CUM))
#define W_WF ((h16_t*)(ws + WS_WF))
#define W_T (args.out)
#define PHASE_BEGIN { Ctx c; c.lane = (int)__builtin_amdgcn_mbcnt_hi(~0u, __builtin_amdgcn_mbcnt_lo(~0u, 0u)); c.tid = wave_id * 64 + c.lane; asm volatile("" : "+v"(c.tid)); c.lane = c.tid & 63; c.wave = wave_id; c.G = gridDim.x; c.bid = blockIdx.x; c.lds = lds; unsigned char* ws = args.ws; asm volatile("" : "+s"(ws));
#define PHASE_END(dosync_) if (dosync_) { if (USE_CG_SYNC) grid.sync(); else xcd_barrier(xbar, c.tid == 0); } }

    for (int rep_ = 0; rep_ < REP_P0; ++rep_) {
    PHASE_BEGIN
    {
        LAS float* scr = (LAS float*)((LAS unsigned char*)lds + c.wave * 16640);
        const int gw = c.bid * NWAVES + c.wave, NGW = c.G * NWAVES;
        constexpr int I_IN = (D / 64) * (NPROJ / 64), I_OUT = (E / 64) * (D / 64), I_F = D / 64, NITEMS = 4 * (I_IN + I_OUT) + I_F;
        for (int it = gw; it < NITEMS; it += NGW) {
            int r = it;
            if (r < 4 * I_IN) { const int l = r / I_IN; r -= l * I_IN; const int wi = l == 0 ? 2 : (l == 1 ? 11 : (l == 2 ? 15 : 20));
                p0_transpose_item(args.in[wi], (l == 2) ? NPROJ + 16 : NPROJ, 0, NPROJ, (h16_t*)(ws + WS_WIN + (size_t)l * 32 * MiB), scr, r, c.lane); continue; }
            r -= 4 * I_IN;
            if (r < 4 * I_OUT) { const int l = r / I_OUT; r -= l * I_OUT; const int wi = l == 0 ? 8 : (l == 1 ? 12 : (l == 2 ? 17 : 26));
                p0_transpose_item(args.in[wi], D, 0, D, (h16_t*)(ws + WS_WOUT + (size_t)l * 8 * MiB), scr, r, c.lane); continue; }
            r -= 4 * I_OUT;
            p0_transpose_item(args.in[15], NPROJ + 16, NPROJ, 16, W_WF, scr, r, c.lane);
        }
        cvt_phase(c, W_X, W_HB, (size_t)M * D);
    }
    if (rep_ + 1 < REP_P0) { xcd_barrier(xbar, c.tid == 0); } else
    grid.sync(); } }

#ifdef DBG_ONLY
    for (int l = DBG_LAYER; l <= DBG_LAYER; ++l) {
#else
#pragma unroll 1
    for (int l = 0; l < 4; ++l) {
#endif
        const int i_g[4] = {9, 13, 18, 27}, i_b[4] = {10, 14, 19, 28};
#define W_WIN ((const h16_t*)(ws + WS_WIN + (size_t)l * 32 * MiB))
#define W_WOUT ((const h16_t*)(ws + WS_WOUT + (size_t)l * 8 * MiB))
        for (int rep_ = 0; rep_ < REP_IN; ++rep_) {
        PHASE_BEGIN
        {
            if (l == 2) logf_phase(c, W_HB, W_WF, args.in[16], W_LOGF);
            pg8::Gemm g{W_HB, W_WIN, M, NPROJ, D}; pg8::StaticOrder So; So.init(M, NPROJ, c.G, c.bid);
            EpiQKVZ Ep{W_Q, W_K, W_V, W_Z, l == 1 ? W_KPART : nullptr};
            pg8::gemm_phase<EpiQKVZ, pg8::StaticOrder, true, true>((LAS unsigned char*)lds, g, So, Ep, c.tid);
        }
        PHASE_END(true)
        }
#ifdef DBG_LAYER
        if (l == DBG_LAYER) {
            h16_t* G2 = (h16_t*)args.out; unsigned* ctl = (unsigned*)args.ws;
            PHASE_BEGIN if (l == 2) cum_phase(c, W_LOGF, W_CUM); PHASE_END(true)
            for (int pass = 0; pass < 2; ++pass) {
            PHASE_BEGIN
            {
                AttnArgs A{W_Q, W_K, W_V, W_Z, pass ? G2 : W_G, W_REL, W_KPART, W_CUM, W_LOGF, nullptr, nullptr, nullptr, nullptr, nullptr, 0.f};
                if (l == 0 || l == 3) { const int base = (l == 0) ? 3 : 21; A.lq1 = args.in[base]; A.lk1 = args.in[base + 1]; A.lq2 = args.in[base + 2]; A.lk2 = args.in[base + 3]; A.subg = args.in[base + 4];
                    A.lam_init = (l == 0) ? 0.2f : (0.8f - 0.6f * 0.40656965974059917f);
                    if (pass) att::attn_phase<0>(c, A); else attn_naive_phase<0>(c, A); }
                else if (l == 1) { if (pass) att::attn_phase<1>(c, A); else attn_naive_phase<1>(c, A); }
                else { if (pass) att::attn_phase<2>(c, A); else attn_naive_phase<2>(c, A); }
            }
            PHASE_END(true)
            }
            PHASE_BEGIN
            {
                float best = 0.f; unsigned nbad = 0u;
                for (int sl = c.bid * NWAVES + c.wave; sl < M * 16; sl += c.G * NWAVES) {
                    const size_t idx = (size_t)(sl >> 4) * E + (sl & 15) * 128 + c.lane * 2;
                    const unsigned a = *(const unsigned*)(W_G + idx), b = *(const unsigned*)(G2 + idx);
                    float md = fmaxf(fabsf(lo16(a) - lo16(b)), fabsf(hi16(a) - hi16(b))), ma = fmaxf(fabsf(lo16(a)), fabsf(hi16(a)));
                    for (int o = 1; o < 64; o <<= 1) { md = fmaxf(md, __shfl_xor(md, o)); ma = fmaxf(ma, __shfl_xor(ma, o)); }
                    const float r = (md == md) ? md / fmaxf(ma, 1e-20f) : 1e9f;
                    best = fmaxf(best, r); nbad += (r > 0.05f) ? 1u : 0u;
                }
                if (c.lane == 0) { atomicMax(ctl + 0, __float_as_uint(best)); atomicAdd(ctl + 1, nbad); }
            }
            PHASE_END(true)
            PHASE_BEGIN
            for (size_t i = ((size_t)c.bid * NTHREADS + c.tid) * 4; i < (size_t)M * D; i += (size_t)c.G * NTHREADS * 4) *(f32x4*)(args.out + i) = (f32x4){0.f, 0.f, 0.f, 0.f};
            PHASE_END(true)
            if (blockIdx.x == 0 && threadIdx.x == 0) {
#if DBG_WHAT == 0
                args.out[0] = 1e6f * __uint_as_float(__hip_atomic_load(ctl + 0, __ATOMIC_RELAXED, __HIP_MEMORY_SCOPE_AGENT));
#else
                args.out[0] = 1e3f * (float)__hip_atomic_load(ctl + 1, __ATOMIC_RELAXED, __HIP_MEMORY_SCOPE_AGENT);
#endif
            }
            return;
        }
#endif
        if (!FAST2) {
        PHASE_BEGIN
        if (l == 2) cum_phase(c, W_LOGF, W_CUM);
        PHASE_END(l == 2)
        }
        for (int rep_ = 0; rep_ < REP_ATT; ++rep_) {
        PHASE_BEGIN
        {
            AttnArgs A{W_Q, W_K, W_V, W_Z, W_G, W_REL, W_KPART, W_CUM, W_LOGF, nullptr, nullptr, nullptr, nullptr, nullptr, 0.f};
            if (l == 0 || l == 3) { const int base = (l == 0) ? 3 : 21; A.lq1 = args.in[base]; A.lk1 = args.in[base + 1]; A.lq2 = args.in[base + 2]; A.lk2 = args.in[base + 3]; A.subg = args.in[base + 4];
                A.lam_init = (l == 0) ? 0.2f : (0.8f - 0.6f * 0.40656965974059917f);
                if (FAST0) att::attn_phase<0>(c, A); else attn_naive_phase<0>(c, A); }
            else if (l == 1) { if (FAST1) att::attn_phase<1>(c, A); else attn_naive_phase<1>(c, A); }
            else { if (FAST2) att::attn_phase<2>(c, A); else attn_naive_phase<2>(c, A); }
        }
        PHASE_END(true)
        }
        PHASE_BEGIN
        {
            pg8::Gemm g{W_G, W_WOUT, M, D, E}; pg8::StaticOrder So; So.init(M, D, c.G, c.bid);
            EpiResid Ep{W_T, W_X, W_STATS, l ? args.in[i_g[l - 1]] : nullptr, l ? args.in[i_b[l - 1]] : nullptr, l};
            pg8::gemm_phase<EpiResid, pg8::StaticOrder, false, true>((LAS unsigned char*)lds, g, So, Ep, c.tid);
        }
        PHASE_END(true)
        for (int rep_ = 0; rep_ < (l == 3 ? 1 : REP_LN); ++rep_) {
        PHASE_BEGIN
        ln_phase(c, W_T, args.in[i_g[l]], args.in[i_b[l]], W_STATS, W_HB, l == 3);
        PHASE_END(true)
        }
    }
}

extern "C" void kernel_launch(void* const* d_in, const int* in_sizes, int n_in, void* d_out, int out_size, void* d_ws, size_t ws_size, hipStream_t stream) {
    static int grid = 0;
    if (grid == 0) {
        if (n_in != 29 || ws_size < WS_END || out_size != M * D) { fprintf(stderr, "kernel_launch: unexpected shapes n_in=%d ws=%zu out=%d\n", n_in, ws_size, out_size); grid = -1; return; }
        int dev = 0, cus = 0, per_cu = 0;
        (void)hipGetDevice(&dev); (void)hipDeviceGetAttribute(&cus, hipDeviceAttributeMultiprocessorCount, dev);
        if (hipFuncSetAttribute((const void*)mega_fwd, hipFuncAttributeMaxDynamicSharedMemorySize, LDS_BYTES) != hipSuccess) { fprintf(stderr, "kernel_launch: hipFuncSetAttribute failed\n"); grid = -1; return; }
        if (hipOccupancyMaxActiveBlocksPerMultiprocessor(&per_cu, (const void*)mega_fwd, NTHREADS, LDS_BYTES) != hipSuccess || per_cu < 1) { fprintf(stderr, "kernel_launch: occupancy query says %d\n", per_cu); per_cu = 1; }
        (void)hipGetLastError();
        grid = cus > 0 ? cus : 256;
    }
    if (grid < 0) return;
    (void)hipMemsetAsync(d_ws, 0, 32768, stream);
    Args a{};
    for (int i = 0; i < 29; ++i) a.in[i] = (const float*)d_in[i];
    a.out = (float*)d_out; a.ws = (unsigned char*)d_ws; a.ph_lo = 0; a.ph_hi = 1000;
    void* kargs[] = {&a};
    hipError_t e = hipLaunchCooperativeKernel((const void*)mega_fwd, dim3(grid), dim3(NTHREADS), kargs, LDS_BYTES, stream);
    if (e != hipSuccess) fprintf(stderr, "kernel_launch: cooperative launch failed: %s (grid %d)\n", hipGetErrorString(e), grid);
}
```

```cpp
#include <hip/hip_runtime.h>
#include <hip/hip_cooperative_groups.h>
#include <cstdint>
#include <cstdio>
namespace cg = cooperative_groups;

typedef unsigned short h16_t;
typedef float f32x4 __attribute__((ext_vector_type(4)));
typedef float f32x2 __attribute__((ext_vector_type(2)));
typedef unsigned u32x4 __attribute__((ext_vector_type(4)));
typedef _Float16 f16x8 __attribute__((ext_vector_type(8)));
typedef _Float16 f16x2 __attribute__((ext_vector_type(2)));
#define LAS __attribute__((address_space(3)))

constexpr int NB = 4, S = 2048, D = 2048, M = NB * S, E = 2048, NH = 16, HD = 128;
constexpr int NPROJ = 4 * E;
constexpr float SCALE = 0.08838834764831845f;
constexpr float LN_EPS = 1e-5f, RMS_EPS = 1e-5f;
constexpr float DN_ALPHA = 1.681792830507429f;
constexpr float NEGF = -1e30f;
constexpr int NTHREADS = 512, NWAVES = 8;
constexpr int LDS_BYTES = 147456;
constexpr int XB_LDS_OFF = LDS_BYTES - 64;
#ifndef REP_P0
#define REP_P0 1
#endif
#ifndef REP_IN
#define REP_IN 1
#endif
#ifndef REP_ATT
#define REP_ATT 1
#endif
#ifndef REP_ATT_L
#define REP_ATT_L -1
#endif
#ifndef REP_LN
#define REP_LN 1
#endif
#ifndef USE_CG_SYNC
#define USE_CG_SYNC 0
#endif

constexpr size_t MiB = 1u << 20;
constexpr size_t WS_CTL = 0;
constexpr size_t WS_WIN = 1 * MiB;
constexpr size_t WS_WOUT = WS_WIN + 128 * MiB;
constexpr size_t WS_HB = WS_WOUT + 32 * MiB;
constexpr size_t WS_Q = WS_HB + 32 * MiB;
constexpr size_t WS_K = WS_Q + 32 * MiB;
constexpr size_t WS_V = WS_K + 32 * MiB;
constexpr size_t WS_Z = WS_V + 32 * MiB;
constexpr size_t WS_G = WS_Z + 32 * MiB;
constexpr size_t WS_SMALL = WS_G + 32 * MiB;
constexpr size_t WS_STATS = WS_SMALL;
constexpr size_t WS_KPART = WS_STATS + 64 * 1024;
constexpr size_t WS_LOGF = WS_KPART + 512 * 1024;
constexpr size_t WS_CUM = WS_LOGF + 512 * 1024;
constexpr size_t WS_WF = WS_CUM + 512 * 1024;
constexpr size_t WS_END = WS_WF + 64 * 1024;

__device__ __forceinline__ float h2f(h16_t v) { return (float)__builtin_bit_cast(_Float16, v); }
__device__ __forceinline__ h16_t f2h(float f) { return __builtin_bit_cast(h16_t, (_Float16)f); }
__device__ __forceinline__ float lo16(unsigned u) { return h2f((h16_t)(u & 0xffffu)); }
__device__ __forceinline__ float hi16(unsigned u) { return h2f((h16_t)(u >> 16)); }
__device__ __forceinline__ unsigned pk2(float lo, float hi) { f32x2 v = {lo, hi}; return __builtin_bit_cast(unsigned, __builtin_convertvector(v, f16x2)); }
template <int MASK> __device__ __forceinline__ float xsw(float v) { return __int_as_float(__builtin_amdgcn_ds_swizzle(__float_as_int(v), (MASK << 10) | 0x1F)); }
__device__ __forceinline__ float xadd32(float v) { auto rr = __builtin_amdgcn_permlane32_swap(__float_as_uint(v), __float_as_uint(v), false, false); return __uint_as_float(rr[0]) + __uint_as_float(rr[1]); }
__device__ __forceinline__ float hsum32(float v) { v += xsw<1>(v); v += xsw<2>(v); v += xsw<4>(v); v += xsw<8>(v); v += xsw<16>(v); return v; }
__device__ __forceinline__ float siluf(float z) { return z / (1.f + __expf(-z)); }

__device__ __forceinline__ int t5_bucket(int d) {
    if (d < 16) return d;
    if (d >= 113) return 31;
    int b = 16;
    b += (d >= 19); b += (d >= 21); b += (d >= 24); b += (d >= 27); b += (d >= 31); b += (d >= 35); b += (d >= 40); b += (d >= 46);
    b += (d >= 52); b += (d >= 59); b += (d >= 67); b += (d >= 77); b += (d >= 87); b += (d >= 99);
    return b;
}

namespace pg8 {
constexpr int BM = 256, BK = 64, HALF = 128, HTB = HALF * BK * 2, STAGE_BYTES = 8 * HTB, NXCD = 8, WGM = 8;
__host__ __device__ __forceinline__ int lds_byte(int r, int c) { const int st = (r >> 4) * 2 + (c >> 5), rr = r & 15, cc = c & 31, ob = rr * 64 + cc * 2; return st * 1024 + (ob ^ (((ob >> 9) & 1) << 5)); }
__host__ __device__ __forceinline__ void stage_rc(int b, int& R, int& C) { const int st = b / 1024, sb = b % 1024, swz = sb ^ (((sb >> 9) & 1) << 5); R = (st >> 1) * 16 + swz / 64; C = (st & 1) * 32 + (swz % 64) / 2; }
__host__ __device__ __forceinline__ int perm32(int rho) { const int n = rho >> 4, i = rho & 15; return 8 * (i >> 2) + 4 * n + (i & 3); }
struct Unit { int pm, pn; };
struct Gemm { const h16_t* A; const h16_t* Bt; int M, N, K; };
struct StaticOrder {
    int nM, nN, nwg, G, c;
    __host__ __device__ void init(int M_, int N_, int G_, int c_) { nM = M_ / BM; nN = N_ / BM; nwg = nM * nN; G = G_; c = c_; }
    __host__ __device__ bool next(int i, Unit& u) const {
        const long L = (long)i * G + c; if (L >= nwg) return false;
        int wgid = (int)L; { const int q = nwg / NXCD, r = nwg % NXCD, xcd = wgid % NXCD, off = wgid / NXCD; wgid = (xcd < r ? xcd * (q + 1) : r * (q + 1) + (xcd - r) * q) + off; }
        const int nig = WGM * nN, gid = wgid / nig, fm = gid * WGM, gsz = (nM - fm) < WGM ? (nM - fm) : WGM;
        u.pm = fm + ((wgid % nig) % gsz); u.pn = (wgid % nig) / gsz; return true;
    }
    __device__ __forceinline__ void a_ready(const Unit&) const {}
    __device__ __forceinline__ void done(const Unit&) const {}
};

template <class Epi, class Sched, bool ALIGN_EPI = false, bool SP2 = false>
__device__ __forceinline__ void gemm_phase(LAS unsigned char* lds, const Gemm g, const Sched& S, const Epi& E, const int tid) {
    const int wid = __builtin_amdgcn_readfirstlane(tid >> 6), lane = tid & 63, wr = wid >> 2, wc = wid & 3, fr = lane & 15, fq = lane >> 4;
    const int K = g.K, nt = K / BK;
    unsigned voffA[2], voffB[2];
#pragma unroll
    for (int i = 0; i < 2; ++i) { int R, C; stage_rc(tid * 16 + i * 8192, R, C); const int Rb = Epi::PERM ? ((R & ~31) + perm32(R & 31)) : R;
        voffA[i] = (unsigned)(R * K + C) * 2u; voffB[i] = (unsigned)(Rb * K + C) * 2u; }
    const size_t kstep = (size_t)(BK * 2);
    const size_t hstep = (size_t)HALF * K * 2;
    const size_t tstep = 2 * hstep;
    const unsigned ldsw = (unsigned)wid * 1024u;
    const int aoff = lds_byte(wr * 64 + fr, fq * 8), boff = lds_byte(wc * 32 + fr, fq * 8);
#define PG8_SA(b, h) (((b) * 2 + (h)) * HTB)
#define PG8_SB(b, h) ((4 + (b) * 2 + (h)) * HTB)
#define PG8_STAGE(bufoff, gbase, voff) do { _Pragma("unroll") for (int _i = 0; _i < 2; ++_i) \
        __builtin_amdgcn_global_load_lds((const unsigned*)((const char*)(gbase) + (voff)[_i]), (LAS unsigned*)(lds + (bufoff) + ldsw + _i * 8192), 16, 0, 0); } while (0)
#define PG8_LDA(dst, b, h) do { _Pragma("unroll") for (int m = 0; m < 4; ++m) _Pragma("unroll") for (int k = 0; k < 2; ++k) dst[m][k] = *(const LAS f16x8*)(lds + PG8_SA(b, h) + aoff + m * 2048 + k * 1024); } while (0)
#define PG8_LDB(dst, b, h) do { _Pragma("unroll") for (int n = 0; n < 2; ++n) _Pragma("unroll") for (int k = 0; k < 2; ++k) dst[n][k] = *(const LAS f16x8*)(lds + PG8_SB(b, h) + boff + n * 2048 + k * 1024); } while (0)
#define PG8_MMA(ai, bj, At, Bt) do { __builtin_amdgcn_s_setprio(1); _Pragma("unroll") for (int m = 0; m < 4; ++m) _Pragma("unroll") for (int n = 0; n < 2; ++n) _Pragma("unroll") for (int k = 0; k < 2; ++k) \
        acc[ai][bj][m][n] = __builtin_amdgcn_mfma_f32_16x16x32_f16(Bt[n][k], At[m][k], acc[ai][bj][m][n], 0, 0, 0); __builtin_amdgcn_s_setprio(0); } while (0)
#define PG8_WAIT_V(n) asm volatile("s_waitcnt vmcnt(" #n ")" ::: "memory")
#define PG8_WAIT_L(n) asm volatile("s_waitcnt lgkmcnt(" #n ")" ::: "memory")
#define PG8_BAR __builtin_amdgcn_s_barrier()
#define PG8_SCHED __builtin_amdgcn_sched_barrier(0)
    Unit cur, nxt; int ui = 0;
    if (!S.next(0, cur)) return;
    f32x4 acc[2][2][4][2];
#pragma unroll
    for (int a = 0; a < 2; ++a)
#pragma unroll
        for (int b = 0; b < 2; ++b)
#pragma unroll
            for (int m = 0; m < 4; ++m)
#pragma unroll
                for (int n = 0; n < 2; ++n) acc[a][b][m][n] = (f32x4){0.f, 0.f, 0.f, 0.f};
    f16x8 At[4][2], B0[2][2], B1[2][2];
    const char* cA = (const char*)g.A + (size_t)cur.pm * tstep; const char* cB = (const char*)g.Bt + (size_t)cur.pn * tstep;
    S.a_ready(cur);
    if constexpr (SP2) {
        PG8_STAGE(PG8_SB(0, 0), cB, voffB); PG8_STAGE(PG8_SB(0, 1), cB + hstep, voffB); PG8_STAGE(PG8_SA(0, 0), cA, voffA); PG8_STAGE(PG8_SA(0, 1), cA + hstep, voffA);
        if (wr == 1) PG8_BAR;
        PG8_WAIT_V(2); PG8_BAR;
        PG8_STAGE(PG8_SB(1, 0), cB + kstep, voffB); PG8_STAGE(PG8_SA(1, 0), cA + kstep, voffA); PG8_STAGE(PG8_SB(1, 1), cB + hstep + kstep, voffB);
        PG8_WAIT_V(6); PG8_BAR;
    } else {
        PG8_STAGE(PG8_SB(0, 0), cB, voffB); PG8_STAGE(PG8_SA(0, 0), cA, voffA); PG8_STAGE(PG8_SB(0, 1), cB + hstep, voffB); PG8_STAGE(PG8_SA(0, 1), cA + hstep, voffA);
        if (wr == 1) PG8_BAR;
        PG8_WAIT_V(4); PG8_BAR;
        PG8_STAGE(PG8_SB(1, 0), cB + kstep, voffB); PG8_STAGE(PG8_SA(1, 0), cA + kstep, voffA); PG8_STAGE(PG8_SB(1, 1), cB + hstep + kstep, voffB);
        PG8_WAIT_V(6); PG8_BAR;
    }
    for (;;) {
        const bool has_next = S.next(ui + 1, nxt);
        const char* nA = has_next ? (const char*)g.A + (size_t)nxt.pm * tstep : cA; const char* nB = has_next ? (const char*)g.Bt + (size_t)nxt.pn * tstep : cB;
        for (int t = 0; t < nt; t += 2) {
            const bool last = (t == nt - 2);
            const char* a1 = cA + (size_t)(t + 1) * kstep;
            const char* a2 = last ? nA : cA + (size_t)(t + 2) * kstep; const char* b2 = last ? nB : cB + (size_t)(t + 2) * kstep;
            const char* a3 = a2 + kstep; const char* b3 = b2 + kstep;
            if (last && has_next) S.a_ready(nxt);
            if constexpr (SP2) {
            PG8_LDB(B0, 0, 0); PG8_LDB(B1, 0, 1); PG8_SCHED; PG8_LDA(At, 0, 0); PG8_STAGE(PG8_SA(1, 1), a1 + hstep, voffA);
            PG8_WAIT_V(8); PG8_WAIT_L(0); PG8_BAR; PG8_MMA(0, 0, At, B0); PG8_MMA(0, 1, At, B1); PG8_BAR; PG8_SCHED;
            PG8_LDA(At, 0, 1); PG8_STAGE(PG8_SB(0, 0), b2, voffB); PG8_STAGE(PG8_SB(0, 1), b2 + hstep, voffB); PG8_STAGE(PG8_SA(0, 0), a2, voffA);
            PG8_WAIT_V(8); PG8_WAIT_L(0); PG8_BAR; PG8_MMA(1, 0, At, B0); PG8_MMA(1, 1, At, B1); PG8_BAR; PG8_SCHED;
            PG8_LDB(B0, 1, 0); PG8_LDB(B1, 1, 1); PG8_SCHED; PG8_LDA(At, 1, 0); PG8_STAGE(PG8_SA(0, 1), a2 + hstep, voffA);
            PG8_WAIT_V(8); PG8_WAIT_L(0); PG8_BAR; PG8_MMA(0, 0, At, B0); PG8_MMA(0, 1, At, B1); PG8_BAR; PG8_SCHED;
            PG8_LDA(At, 1, 1); PG8_STAGE(PG8_SB(1, 0), b3, voffB); PG8_STAGE(PG8_SB(1, 1), b3 + hstep, voffB); PG8_STAGE(PG8_SA(1, 0), a3, voffA);
            PG8_WAIT_V(8); PG8_WAIT_L(0); PG8_BAR; PG8_MMA(1, 0, At, B0); PG8_MMA(1, 1, At, B1); PG8_BAR; PG8_SCHED;
            } else {
            PG8_LDB(B0, 0, 0); PG8_SCHED; PG8_LDA(At, 0, 0); PG8_STAGE(PG8_SA(1, 1), a1 + hstep, voffA);
            PG8_WAIT_L(8); PG8_BAR; PG8_WAIT_L(0); PG8_MMA(0, 0, At, B0); PG8_BAR; PG8_SCHED;
            PG8_LDB(B1, 0, 1); PG8_STAGE(PG8_SB(0, 0), b2, voffB);
            PG8_BAR; PG8_WAIT_L(0); PG8_MMA(0, 1, At, B1); PG8_BAR;
            PG8_LDA(At, 0, 1); PG8_STAGE(PG8_SA(0, 0), a2, voffA);
            PG8_BAR; PG8_WAIT_L(0); PG8_MMA(1, 0, At, B0); PG8_BAR; PG8_SCHED;
            PG8_STAGE(PG8_SB(0, 1), b2 + hstep, voffB);
            PG8_WAIT_V(6); PG8_BAR; PG8_MMA(1, 1, At, B1); PG8_BAR;
            PG8_LDB(B0, 1, 0); PG8_SCHED; PG8_LDA(At, 1, 0); PG8_STAGE(PG8_SA(0, 1), a2 + hstep, voffA);
            PG8_WAIT_L(8); PG8_BAR; PG8_WAIT_L(0); PG8_MMA(0, 0, At, B0); PG8_BAR; PG8_SCHED;
            PG8_LDB(B1, 1, 1); PG8_STAGE(PG8_SB(1, 0), b3, voffB);
            PG8_BAR; PG8_WAIT_L(0); PG8_MMA(0, 1, At, B1); PG8_BAR;
            PG8_LDA(At, 1, 1); PG8_STAGE(PG8_SA(1, 0), a3, voffA);
            PG8_BAR; PG8_WAIT_L(0); PG8_MMA(1, 0, At, B0); PG8_BAR; PG8_SCHED;
            PG8_STAGE(PG8_SB(1, 1), b3 + hstep, voffB);
            PG8_WAIT_V(6); PG8_BAR; PG8_MMA(1, 1, At, B1); PG8_BAR;
            }
        }
        if constexpr (ALIGN_EPI) { if (wr == 0) PG8_BAR; }
        E(acc, cur, wr, wc, fr, fq); S.done(cur);
        if (!has_next) break;
#pragma unroll
        for (int a = 0; a < 2; ++a)
#pragma unroll
            for (int b = 0; b < 2; ++b)
#pragma unroll
                for (int m = 0; m < 4; ++m)
#pragma unroll
                    for (int n = 0; n < 2; ++n) acc[a][b][m][n] = (f32x4){0.f, 0.f, 0.f, 0.f};
        cur = nxt; cA = nA; cB = nB; ++ui;
        if constexpr (ALIGN_EPI) { if (wr == 1) PG8_BAR; }
    }
    PG8_WAIT_V(0);
    if constexpr (!ALIGN_EPI) { if (wr == 0) PG8_BAR; }
    PG8_BAR;
#undef PG8_SA
#undef PG8_SB
#undef PG8_STAGE
#undef PG8_LDA
#undef PG8_LDB
#undef PG8_MMA
#undef PG8_WAIT_V
#undef PG8_WAIT_L
#undef PG8_BAR
#undef PG8_SCHED
}
}

struct EpiQKVZ {
    static constexpr bool PERM = true;
    h16_t *Q, *K, *V, *Z; float* kpart;
    __device__ __forceinline__ void operator()(const f32x4 (&acc)[2][2][4][2], const pg8::Unit& u, int wr, int wc, int fr, int fq) const {
        const int colt = u.pn * 256, sec = colt >> 11, cbase = colt & 2047;
        const int row0 = u.pm * 256 + wr * 64 + fr;
        h16_t* dst = sec == 0 ? Q : (sec == 1 ? K : (sec == 2 ? V : Z));
#pragma unroll
        for (int ai = 0; ai < 2; ++ai)
#pragma unroll
            for (int m = 0; m < 4; ++m) { const int r = row0 + ai * 128 + m * 16, b = r >> 11, s = r & 2047;
#pragma unroll
                for (int bj = 0; bj < 2; ++bj) { const f32x4 v0 = acc[ai][bj][m][0], v1 = acc[ai][bj][m][1];
                    u32x4 w; w.x = pk2(v0[0], v0[1]); w.y = pk2(v0[2], v0[3]); w.z = pk2(v1[0], v1[1]); w.w = pk2(v1[2], v1[3]);
                    const int c = cbase + bj * 128 + wc * 32 + 8 * fq;
                    h16_t* p = (sec == 3) ? dst + (size_t)r * E + c : dst + ((size_t)(b * NH + (c >> 7)) * S + s) * HD + (c & 127);
                    *(u32x4*)p = w; } }
        if (kpart != nullptr && sec == 1) {
            const int b = u.pm >> 3, nblk = u.pm & 7;
#pragma unroll
            for (int bj = 0; bj < 2; ++bj) { f32x4 s0 = {0.f, 0.f, 0.f, 0.f}, s1 = {0.f, 0.f, 0.f, 0.f};
#pragma unroll
                for (int ai = 0; ai < 2; ++ai)
#pragma unroll
                    for (int m = 0; m < 4; ++m) { s0 += acc[ai][bj][m][0]; s1 += acc[ai][bj][m][1]; }
#pragma unroll
                for (int e = 0; e < 4; ++e) { s0[e] += xsw<1>(s0[e]); s1[e] += xsw<1>(s1[e]); s0[e] += xsw<2>(s0[e]); s1[e] += xsw<2>(s1[e]);
                                              s0[e] += xsw<4>(s0[e]); s1[e] += xsw<4>(s1[e]); s0[e] += xsw<8>(s0[e]); s1[e] += xsw<8>(s1[e]); }
                if (fr == 0) { const int c = cbase + bj * 128 + wc * 32 + 8 * fq;
                    float* p = kpart + (size_t)wr * NB * NH * 8 * HD + ((size_t)(b * NH + (c >> 7)) * 8 + nblk) * HD + (c & 127);
                    *(f32x4*)p = s0; *(f32x4*)(p + 4) = s1; } }
        }
    }
};
struct EpiResid {
    static constexpr bool PERM = false;
    float* T; const float* x; const float* stats; const float* g; const float* bta; int layer;
    __device__ __forceinline__ void operator()(const f32x4 (&acc)[2][2][4][2], const pg8::Unit& u, int wr, int wc, int fr, int fq) const {
        const int col0 = u.pn * 256 + wc * 32 + 4 * fq, row0 = u.pm * 256 + wr * 64 + fr;
        f32x4 gv[2][2], bv[2][2];
        if (layer) {
#pragma unroll
            for (int bj = 0; bj < 2; ++bj)
#pragma unroll
                for (int n = 0; n < 2; ++n) { gv[bj][n] = *(const f32x4*)(g + col0 + bj * 128 + n * 16); bv[bj][n] = *(const f32x4*)(bta + col0 + bj * 128 + n * 16); } }
#pragma unroll
        for (int ai = 0; ai < 2; ++ai)
#pragma unroll
            for (int m = 0; m < 4; ++m) { const int r = row0 + ai * 128 + m * 16; float mean = 0.f, rstd = 1.f;
                if (layer) { const f32x2 st = *(const f32x2*)(stats + 2 * r); mean = st.x; rstd = st.y; }
#pragma unroll
                for (int bj = 0; bj < 2; ++bj)
#pragma unroll
                    for (int n = 0; n < 2; ++n) { const size_t idx = (size_t)r * D + col0 + bj * 128 + n * 16; f32x4 h;
                        if (layer) h = (*(const f32x4*)(T + idx) - mean) * rstd * gv[bj][n] + bv[bj][n]; else h = *(const f32x4*)(x + idx);
                        *(f32x4*)(T + idx) = DN_ALPHA * h + acc[ai][bj][m][n]; }
                asm volatile("" ::: "memory"); }
    }
};

struct Ctx { int tid, lane, wave, G, bid; unsigned char* lds; };

__device__ __forceinline__ void p0_transpose_item(const float* __restrict__ W, int ldw, int c0, int ncols, h16_t* __restrict__ WT, LAS float* scr, int item, int lane) {
    const int nblk = (ncols + 63) / 64, kb = item / nblk, nb = item % nblk, k0 = 64 * kb, n0 = 64 * nb;
    const int r = lane >> 4, cq = (lane & 15) * 4; const bool nok = n0 + cq < ncols;
    const float* src = W + (size_t)(k0 + r) * ldw + c0 + n0 + cq;
    f32x4 v[16];
#pragma unroll
    for (int i = 0; i < 16; ++i) v[i] = nok ? *(const f32x4*)(src + (size_t)(4 * i) * ldw) : (f32x4){0.f, 0.f, 0.f, 0.f};
#pragma unroll
    for (int i = 0; i < 16; ++i) { LAS float* d = scr + (4 * i + r) * 65 + cq; d[0] = v[i][0]; d[1] = v[i][1]; d[2] = v[i][2]; d[3] = v[i][3]; }
    asm volatile("s_waitcnt lgkmcnt(0)" ::: "memory");
    const int cc = lane & 7;
#pragma unroll
    for (int j = 0; j < 8; ++j) { const int n = (lane >> 3) + 8 * j; const LAS float* s = scr + (8 * cc) * 65 + n;
        u32x4 o; o.x = pk2(s[0 * 65], s[1 * 65]); o.y = pk2(s[2 * 65], s[3 * 65]); o.z = pk2(s[4 * 65], s[5 * 65]); o.w = pk2(s[6 * 65], s[7 * 65]);
        if (n0 + n < ncols) *(u32x4*)(WT + (size_t)(n0 + n) * D + k0 + 8 * cc) = o; }
    asm volatile("s_waitcnt lgkmcnt(0)" ::: "memory");
}
__device__ __forceinline__ void transpose_phase(const Ctx& c, const float* __restrict__ W, int ldw, int c0, int ncols, h16_t* __restrict__ WT) {
    float (*tile)[65] = (float (*)[65])(c.lds + (c.tid >> 8) * (64 * 65 * 4));
    const int nb = (ncols + 63) / 64, ntiles = (D / 64) * nb, t2 = c.tid & 255, tx = t2 & 63, ty = t2 >> 6;
    for (int it = c.bid * 2; it < ntiles; it += c.G * 2) {
        const int tl = it + (c.tid >> 8); const bool act = tl < ntiles;
        const int kb = tl / nb, cb = tl % nb, k0 = kb * 64, n0 = cb * 64;
        if (act) for (int i = ty; i < 64; i += 4) { const int n = n0 + tx; tile[i][tx] = (n < ncols) ? W[(size_t)(k0 + i) * ldw + c0 + n] : 0.f; }
        __syncthreads();
        if (act) for (int i = ty; i < 64; i += 4) { const int n = n0 + i; if (n < ncols) WT[(size_t)n * D + k0 + tx] = f2h(tile[tx][i]); }
        __syncthreads();
    }
}
__device__ __forceinline__ void cvt_phase(const Ctx& c, const float* __restrict__ x, h16_t* __restrict__ o, size_t n) {
    const size_t stride = (size_t)c.G * NTHREADS * 4;
    for (size_t i = ((size_t)c.bid * NTHREADS + c.tid) * 4; i < n; i += 8 * stride) { f32x4 v[8];
#pragma unroll
        for (int j = 0; j < 8; ++j) v[j] = *(const f32x4*)(x + i + j * stride);
#pragma unroll
        for (int j = 0; j < 8; ++j) *(uint2*)(o + i + j * stride) = make_uint2(pk2(v[j].x, v[j].y), pk2(v[j].z, v[j].w)); }
}
__device__ __forceinline__ float wave_sum(float v) { return xadd32(hsum32(v)); }
__device__ __forceinline__ void ln_phase(const Ctx& c, float* T, const float* __restrict__ g, const float* __restrict__ bta, float* stats, h16_t* HB, bool final_layer) {
    const int gw = c.bid * NWAVES + c.wave, NGW = c.G * NWAVES;
    for (int m = gw; m < M; m += NGW) {
        float* row = T + (size_t)m * D; f32x4 v[8]; float s = 0.f;
#pragma unroll
        for (int j = 0; j < 8; ++j) { v[j] = *(const f32x4*)(row + (64 * j + c.lane) * 4); s += (v[j].x + v[j].y) + (v[j].z + v[j].w); }
        const float mean = wave_sum(s) * (1.f / D); float q = 0.f;
#pragma unroll
        for (int j = 0; j < 8; ++j) { v[j] = v[j] - mean; q += (v[j].x * v[j].x + v[j].y * v[j].y) + (v[j].z * v[j].z + v[j].w * v[j].w); }
        const float rstd = rsqrtf(wave_sum(q) * (1.f / D) + LN_EPS);
        if (c.lane == 0) { stats[2 * m] = mean; stats[2 * m + 1] = rstd; }
#pragma unroll
        for (int j = 0; j < 8; ++j) { const int col = (64 * j + c.lane) * 4; const f32x4 o = v[j] * rstd * *(const f32x4*)(g + col) + *(const f32x4*)(bta + col);
            if (final_layer) *(f32x4*)(row + col) = o; else *(uint2*)(HB + (size_t)m * D + col) = make_uint2(pk2(o.x, o.y), pk2(o.z, o.w)); }
    }
}
__device__ __forceinline__ void logf_phase(const Ctx& c, const h16_t* __restrict__ HB, const h16_t* __restrict__ WfT, const float* __restrict__ bf, float* logf) {
    for (int rb = c.bid; rb < M / 32; rb += c.G) {
        const int m = rb * 32 + (c.tid >> 4), j = c.tid & 15;
        const h16_t* a = HB + (size_t)m * D; const h16_t* w = WfT + (size_t)j * D; float s = 0.f;
        for (int k = 0; k < D; k += 8) { const u32x4 av = *(const u32x4*)(a + k), wv = *(const u32x4*)(w + k);
#pragma unroll
            for (int e = 0; e < 4; ++e) { s = fmaf(lo16(av[e]), lo16(wv[e]), s); s = fmaf(hi16(av[e]), hi16(wv[e]), s); } }
        const float xx = s + bf[j];
        logf[(size_t)m * 16 + j] = fminf(xx, 0.f) - log1pf(__expf(-fabsf(xx)));
    }
}
__device__ __forceinline__ void cum_phase(const Ctx& c, const float* __restrict__ logf, float* cum) {
    float* wtot = (float*)c.lds;
    for (int bh = c.bid; bh < NB * NH; bh += c.G) {
        const int b = bh / NH, h = bh % NH; float v[4];
#pragma unroll
        for (int e = 0; e < 4; ++e) v[e] = logf[(size_t)(b * S + 4 * c.tid + e) * NH + h];
        v[1] += v[0]; v[2] += v[1]; v[3] += v[2];
        float incl = v[3];
#pragma unroll
        for (int o = 1; o < 64; o <<= 1) { const float t = __int_as_float(__builtin_amdgcn_ds_bpermute(((c.lane - o) & 63) << 2, __float_as_int(incl))); if (c.lane >= o) incl += t; }
        if (c.lane == 63) wtot[c.wave] = incl;
        __syncthreads();
        float off = incl - v[3];
        for (int w = 0; w < c.wave; ++w) off += wtot[w];
        f32x4 o4 = {v[0] + off, v[1] + off, v[2] + off, v[3] + off};
        *(f32x4*)(cum + (size_t)bh * S + 4 * c.tid) = o4;
        __syncthreads();
    }
}

#ifndef FAST0
#define FAST0 1
#endif
#ifndef FAST1
#define FAST1 1
#endif
#ifndef FAST2
#define FAST2 1
#endif
constexpr int SC_LD = 2064;
struct AttnArgs { const h16_t *Qb, *Kb, *Vb, *Zb; h16_t* G; const float *rel, *kpart, *cum, *logf, *lq1, *lk1, *lq2, *lk2, *subg; float lam_init; };
template <int MODE>
__device__ __forceinline__ void attn_naive_phase(const Ctx& c, const AttnArgs& A) {
    float* sc = (float*)c.lds; float* qs = sc + 16 * SC_LD; float* misc = qs + 16 * 128;
    const int tid = c.tid; const bool act = tid < 256; const int row = (tid >> 4) & 15, sub = tid & 15;
    constexpr int QPB = MODE == 0 ? 8 : 16, NHB = MODE == 0 ? 8 : 16;
    const int nqt = S / QPB, nvb = NB * NHB * nqt;
    for (int vb = c.bid; vb < nvb; vb += c.G) {
        const int qt = vb % nqt, hh = (vb / nqt) % NHB, b = vb / (nqt * NHB);
        const int t0 = qt * QPB, nkeys = t0 + QPB;
        const int qi = MODE == 0 ? (row & 7) : row, comp = MODE == 0 ? (row >> 3) : 0;
        const int hq = MODE == 0 ? 2 * hh + comp : hh;
        const int t = t0 + qi;
        if (act) for (int i = tid; i < 16 * 128; i += 256) { const int r = i >> 7, d = i & 127; const int rq = MODE == 0 ? (r & 7) : r, rh = MODE == 0 ? 2 * hh + (r >> 3) : hh;
            qs[i] = h2f(A.Qb[((size_t)(b * NH + rh) * S + t0 + rq) * HD + d]); }
        float lam = 0.f;
        if (MODE == 0) { if (tid < 64) { float a = A.lq1[tid] * A.lk1[tid] + A.lq1[tid + 64] * A.lk1[tid + 64], cc = A.lq2[tid] * A.lk2[tid] + A.lq2[tid + 64] * A.lk2[tid + 64];
                for (int o = 32; o; o >>= 1) { a += __shfl_xor(a, o); cc += __shfl_xor(cc, o); }
                if (tid == 0) misc[0] = __expf(a) - __expf(cc) + A.lam_init; } }
        __syncthreads();
        if (MODE == 0) lam = misc[0];
        unsigned selbits = 0u; const int own = t0 >> 8;
        if (MODE == 1) {
            if (tid < 16) { float gate[8]; unsigned sb = 0u;
#pragma unroll
                for (int n = 0; n < 8; ++n) { float gsum = 0.f;
                    if (n < own) { const float* k0 = A.kpart + (size_t)((b * NH + hh) * 8 + n) * HD; const float* k1 = k0 + (size_t)NB * NH * 8 * HD;
                        for (int d = 0; d < 128; ++d) gsum = fmaf(qs[tid * 128 + d], (k0[d] + k1[d]) * (1.f / 256.f), gsum); }
                    gate[n] = n < own ? gsum : NEGF; }
#pragma unroll
                for (int k = 0; k < 3; ++k) { int best = -1; float bv = 0.f;
#pragma unroll
                    for (int n = 0; n < 8; ++n) if (!((sb >> n) & 1u) && (best < 0 || gate[n] > bv)) { best = n; bv = gate[n]; }
                    sb |= 1u << best; }
                misc[16 + tid] = __uint_as_float(sb & ((1u << own) - 1u)); }
            __syncthreads();
            selbits = __float_as_uint(misc[16 + row]);
        }
        if (act) {
            const float cq = MODE == 2 ? A.cum[(size_t)(b * NH + hh) * S + t] : 0.f;
            for (int s = sub; s < nkeys; s += 16) {
                const h16_t* kr = A.Kb + ((size_t)(b * NH + hq) * S + s) * HD; float dot = 0.f;
                for (int d = 0; d < 128; d += 8) { const u32x4 kv = *(const u32x4*)(kr + d); const float* qq = qs + row * 128 + d;
#pragma unroll
                    for (int j = 0; j < 4; ++j) { dot = fmaf(qq[2 * j], lo16(kv[j]), dot); dot = fmaf(qq[2 * j + 1], hi16(kv[j]), dot); } }
                float lg = dot * SCALE; bool ok = s <= t;
                if (MODE == 0 || MODE == 1) lg += A.rel[t5_bucket(t - s > 0 ? t - s : 0) * 16 + hq];
                if (MODE == 1) { const int blk = s >> 8; if (blk != own) ok = (selbits >> blk) & 1u; }
                if (MODE == 2) lg += cq - A.cum[(size_t)(b * NH + hh) * S + s];
                sc[row * SC_LD + s] = ok ? lg : NEGF;
            }
        }
        __syncthreads();
        if (act) {
            float mx = NEGF;
            for (int s = sub; s < nkeys; s += 16) mx = fmaxf(mx, sc[row * SC_LD + s]);
            for (int o = 8; o; o >>= 1) mx = fmaxf(mx, __shfl_xor(mx, o));
            float sum = 0.f;
            for (int s = sub; s < nkeys; s += 16) { const float p = __expf(sc[row * SC_LD + s] - mx); sc[row * SC_LD + s] = p; sum += p; }
            for (int o = 8; o; o >>= 1) sum += __shfl_xor(sum, o);
            const float inv = 1.f / sum;
            for (int s = sub; s < nkeys; s += 16) sc[row * SC_LD + s] *= inv;
        }
        __syncthreads();
        if (act) {
            if (MODE == 0) {
                const int q2 = tid >> 5, dl = tid & 31, d0 = dl * 8;
                const int vh = 2 * hh + (d0 >> 7), dd = d0 & 127;
                float o[8];
#pragma unroll
                for (int j = 0; j < 8; ++j) o[j] = 0.f;
                for (int s = 0; s < nkeys; ++s) { const float a = sc[q2 * SC_LD + s] - lam * sc[(8 + q2) * SC_LD + s];
                    const u32x4 vv = *(const u32x4*)(A.Vb + ((size_t)(b * NH + vh) * S + s) * HD + dd);
#pragma unroll
                    for (int j = 0; j < 4; ++j) { o[2 * j] = fmaf(a, lo16(vv[j]), o[2 * j]); o[2 * j + 1] = fmaf(a, hi16(vv[j]), o[2 * j + 1]); } }
                float ss = 0.f;
#pragma unroll
                for (int j = 0; j < 8; ++j) ss += o[j] * o[j];
                for (int off = 16; off; off >>= 1) ss += __shfl_xor(ss, off);
                const float r = rsqrtf(ss * (1.f / 256.f) + RMS_EPS) * (1.f - A.lam_init);
                const size_t gi = (size_t)(b * S + t0 + q2) * E + hh * 256 + d0;
                const u32x4 zv = *(const u32x4*)(A.Zb + gi); u32x4 ov;
#pragma unroll
                for (int j = 0; j < 4; ++j) { const float a0 = o[2 * j] * r * A.subg[d0 + 2 * j] * siluf(lo16(zv[j])), a1 = o[2 * j + 1] * r * A.subg[d0 + 2 * j + 1] * siluf(hi16(zv[j]));
                    ov[j] = pk2(a0, a1); }
                *(u32x4*)(A.G + gi) = ov;
            } else {
                const int d0 = sub * 8; float o[8];
#pragma unroll
                for (int j = 0; j < 8; ++j) o[j] = 0.f;
                for (int s = 0; s < nkeys; ++s) { const float a = sc[row * SC_LD + s];
                    const u32x4 vv = *(const u32x4*)(A.Vb + ((size_t)(b * NH + hh) * S + s) * HD + d0);
#pragma unroll
                    for (int j = 0; j < 4; ++j) { o[2 * j] = fmaf(a, lo16(vv[j]), o[2 * j]); o[2 * j + 1] = fmaf(a, hi16(vv[j]), o[2 * j + 1]); } }
                const size_t gi = (size_t)(b * S + t) * E + hh * 128 + d0;
                const u32x4 zv = *(const u32x4*)(A.Zb + gi); u32x4 ov;
#pragma unroll
                for (int j = 0; j < 4; ++j) ov[j] = pk2(o[2 * j] * siluf(lo16(zv[j])), o[2 * j + 1] * siluf(hi16(zv[j])));
                *(u32x4*)(A.G + gi) = ov;
            }
        }
        __syncthreads();
    }
}

namespace att {
typedef short s16x4 __attribute__((ext_vector_type(4)));
typedef float f32x16 __attribute__((ext_vector_type(16)));
constexpr int QBLK = 32, KVBLK = 64, SHM = KVBLK * HD * 2;
constexpr float THR = 8.f;
constexpr int L_V = 0, L_K = 2 * SHM;
#define KSWZ(row, colB) ((row) * 256 + ((colB) ^ (((row) & 7) << 4)))
#define SBAR() __builtin_amdgcn_sched_barrier(0)
__device__ __forceinline__ int v_st(int k, int c) { const int kk = (k & ~0xC) | ((k & 4) << 1) | ((k & 8) >> 1); return ((kk >> 3) * 4 + (c >> 5)) * 512 + ((kk & 7) * 32 + (c & 31)) * 2; }
__device__ __forceinline__ int v_rd_base(int lane) { return ((lane & 3) << 3) | (((lane >> 2) & 3) << 6) | (((lane >> 4) & 1) << 5) | (((lane >> 5) & 1) << 8); }
constexpr int v_rd_off(int d0, int ks, int half) { return d0 * 512 + ks * 4096 + half * 2048; }
__device__ __forceinline__ int crow(int r, int hi) { return (r & 3) + 8 * (r >> 2) + 4 * hi; }
__device__ __forceinline__ f16x8 ld8(const h16_t* p) { return *reinterpret_cast<const f16x8*>(p); }

template <int NCOMP> struct Lay {
    static constexpr int WS = L_K + 2 * NCOMP * SHM;
    static constexpr int OST = WS + NWAVES * 512;
    static constexpr int TAB = OST + (NCOMP == 1 ? 8 : 4) * 8192;
    static constexpr int MISC = TAB, LUT = TAB + 256, BIG = LUT + 2 * 352 * 4, END = BIG + 8192;
};
static_assert(Lay<1>::END <= XB_LDS_OFF && Lay<2>::END <= XB_LDS_OFF, "attention LDS map");

__device__ __forceinline__ void mask_tile(f32x16& p0, f32x16& p1, int dq) {
    const float NEG = -__builtin_inff();
#pragma unroll
    for (int r = 0; r < 16; ++r) { const int cc = (r & 3) + 8 * (r >> 2); if (dq - cc < 0) p0[r] = NEG; if (dq - cc - 32 < 0) p1[r] = NEG; }
}
__device__ __forceinline__ void bias_mask_tile(f32x16& p0, f32x16& p1, int dq, const float* lut) {
    const float NEG = -__builtin_inff(); const float* lp = lut + (dq + 128 - 63);
    float b0[16], b1[16];
#pragma unroll
    for (int r = 0; r < 16; ++r) { const int cc = (r & 3) + 8 * (r >> 2); b0[r] = lp[63 - cc]; b1[r] = lp[63 - cc - 32]; }
#pragma unroll
    for (int r = 0; r < 16; ++r) { const int cc = (r & 3) + 8 * (r >> 2); p0[r] = (dq - cc < 0) ? NEG : p0[r] + b0[r]; p1[r] = (dq - cc - 32 < 0) ? NEG : p1[r] + b1[r]; }
}
#define PK4(P, B_, OUT) do { unsigned a0 = pk2(P[B_+0], P[B_+1]), a1 = pk2(P[B_+2], P[B_+3]);                          \
        unsigned b0 = pk2(P[B_+4], P[B_+5]), b1 = pk2(P[B_+6], P[B_+7]);                                             \
        auto r0 = __builtin_amdgcn_permlane32_swap(a0, b0, false, false); auto r1 = __builtin_amdgcn_permlane32_swap(a1, b1, false, false); \
        u32x4 w = {r0[0], r1[0], r0[1], r1[1]}; OUT = __builtin_bit_cast(f16x8, w); } while (0)
__device__ __forceinline__ void partialSM(f32x16& p0, f32x16& p1, float& m_reg, float& alpha, float& ps0, f16x8& pa0, f16x8& pa1) {
    float pmax = p0[0];
#pragma unroll
    for (int r = 1; r < 16; ++r) pmax = fmaxf(pmax, p0[r]);
#pragma unroll
    for (int r = 0; r < 16; ++r) pmax = fmaxf(pmax, p1[r]);
    { auto rr = __builtin_amdgcn_permlane32_swap(__float_as_uint(pmax), __float_as_uint(pmax), false, false);
      pmax = fmaxf(__uint_as_float(rr[0]), __uint_as_float(rr[1])); }
    constexpr float C2 = 1.4426950408889634f * SCALE;
    float mn;
    if (__builtin_expect(__all((pmax - m_reg) * SCALE <= THR), 1)) { mn = m_reg; alpha = 1.f; }
    else { mn = fmaxf(m_reg, pmax); alpha = __builtin_amdgcn_exp2f((m_reg - mn) * C2); m_reg = mn; }
    const float mnL = -mn * C2;
#pragma unroll
    for (int r = 0; r < 16; ++r) p0[r] = fmaf(p0[r], C2, mnL);
#pragma unroll
    for (int r = 0; r < 16; ++r) p1[r] = fmaf(p1[r], C2, mnL);
#pragma unroll
    for (int r = 0; r < 16; ++r) p0[r] = __builtin_amdgcn_exp2f(p0[r]);
    float ps = 0;
#pragma unroll
    for (int r = 0; r < 16; ++r) ps += p0[r];
    ps0 = ps;
    PK4(p0, 0, pa0); PK4(p0, 8, pa1);
}
__device__ __forceinline__ void finishSM(f32x16& p1, float alpha, float ps0, float& l_reg, f16x8& pa2, f16x8& pa3) {
#pragma unroll
    for (int r = 0; r < 16; ++r) p1[r] = __builtin_amdgcn_exp2f(p1[r]);
    float ps = ps0;
#pragma unroll
    for (int r = 0; r < 16; ++r) ps += p1[r];
    { auto rr = __builtin_amdgcn_permlane32_swap(__float_as_uint(ps), __float_as_uint(ps), false, false);
      ps = __uint_as_float(rr[0]) + __uint_as_float(rr[1]); }
    l_reg = l_reg * alpha + ps;
    PK4(p1, 0, pa2); PK4(p1, 8, pa3);
}
#undef PK4
template <int KB, int NCOMP>
__device__ __forceinline__ void qkt(f32x16& p0, f32x16& p1, const char* Kc_lds, int kswz0, const f16x8* qr) {
    int kb_ = kswz0; asm volatile("" : "+v"(kb_));
#pragma unroll
    for (int d0 = 0; d0 < 8; ++d0) { const char* a = Kc_lds + KB * (NCOMP * SHM) + (kb_ ^ ((d0 & 3) << 5)) + (d0 >> 2) * 128;
        const f16x8 b0 = *reinterpret_cast<const f16x8*>(a);
        const f16x8 b1 = *reinterpret_cast<const f16x8*>(a + 32 * 256);
        p0 = __builtin_amdgcn_mfma_f32_32x32x16_f16(b0, qr[d0], p0, 0, 0, 0);
        p1 = __builtin_amdgcn_mfma_f32_32x32x16_f16(b1, qr[d0], p1, 0, 0, 0); }
}
template <int VB>
__device__ __forceinline__ void pv_tile(f32x16* o, int vb0, f16x8 pa0, f16x8 pa1, f16x8 pa2, f16x8 pa3) {
#define TRRD(dst, off) asm volatile("ds_read_b64_tr_b16 %0, %1 offset:%2" : "=&v"(dst) : "v"(vb0), "i"(off) : "memory")
#define PKV(l, h) __builtin_bit_cast(f16x8, (short __attribute__((ext_vector_type(8)))){l[0], l[1], l[2], l[3], h[0], h[1], h[2], h[3]})
#define PV_D0(d0) do { s16x4 l0, l1, l2, l3, h0, h1, h2, h3; constexpr int b_ = L_V + VB * SHM + v_rd_off(d0, 0, 0); \
        TRRD(l0, b_); TRRD(h0, b_ + 2048); TRRD(l1, b_ + 4096); TRRD(h1, b_ + 6144); TRRD(l2, b_ + 8192); TRRD(h2, b_ + 10240); TRRD(l3, b_ + 12288); TRRD(h3, b_ + 14336); \
        asm volatile("s_waitcnt lgkmcnt(0)" ::: "memory"); SBAR();   \
        o[d0] = __builtin_amdgcn_mfma_f32_32x32x16_f16(pa0, PKV(l0, h0), o[d0], 0, 0, 0);   \
        o[d0] = __builtin_amdgcn_mfma_f32_32x32x16_f16(pa1, PKV(l1, h1), o[d0], 0, 0, 0);   \
        o[d0] = __builtin_amdgcn_mfma_f32_32x32x16_f16(pa2, PKV(l2, h2), o[d0], 0, 0, 0);   \
        o[d0] = __builtin_amdgcn_mfma_f32_32x32x16_f16(pa3, PKV(l3, h3), o[d0], 0, 0, 0); } while (0)
    PV_D0(0); PV_D0(1); PV_D0(2); PV_D0(3);
#undef PV_D0
#undef PKV
#undef TRRD
}

struct BlockRef { unsigned qoff, koff, voff; int P0; int b, h, half, x; };
template <int NCOMP> struct Seam { f16x8 qr[8]; };
struct BlkCtx { unsigned selbits; int own; };
struct EpiArgs { const h16_t* Zb; h16_t* G; const float* subg; float lam_init; };

constexpr size_t HSTR = (size_t)S * HD;
#define ROW(p, k0, rr) ((p) + (size_t)((k0) + (rr)) * HD + sc)
#define VMW() asm volatile("s_waitcnt vmcnt(0)" ::: "memory")
#define VMWN(n) asm volatile("s_waitcnt vmcnt(%0)" :: "i"(n) : "memory")

__device__ __forceinline__ f16x8 ldg8(const void* ubase, unsigned off) { return *reinterpret_cast<const f16x8*>((const char*)ubase + off); }
__device__ __forceinline__ void glds16(const void* ubase, unsigned voff, unsigned lds_dst) { unsigned keep;
    asm volatile("s_mov_b32 %0, m0\n\ts_mov_b32 m0, %3\n\ts_nop 0\n\tglobal_load_lds_dwordx4 %1, %2\n\ts_mov_b32 m0, %0" : "=&s"(keep) : "v"(voff), "s"(ubase), "s"(lds_dst) : "memory"); }
__device__ __forceinline__ unsigned dma_offk(int wid, int lane) { const int row = 4 * wid + (lane >> 4), chunk = (lane & 15) ^ (row & 7); return (unsigned)(row * 256 + chunk * 16); }
__device__ __forceinline__ unsigned dma_offv(int wid, int lane) { const int kk = (wid >> 1) * 8 + ((lane & 31) >> 2), cc = ((2 * (wid & 1) + (lane >> 5)) & 3) * 32 + (lane & 3) * 8;
    const int kx = (kk & ~0xC) | ((kk & 4) << 1) | ((kk & 8) >> 1); return (unsigned)(kx * 256 + cc * 2); }
template <int NCOMP>
__device__ __forceinline__ void dma_k(const h16_t* Kp, int k0, unsigned offk, unsigned lds_base, int bf, int wid) {
    const char* kb_ = (const char*)Kp + (size_t)k0 * (HD * 2);
#pragma unroll
    for (int cc = 0; cc < NCOMP; ++cc)
#pragma unroll
        for (int hf = 0; hf < 2; ++hf) glds16(kb_ + cc * (HSTR * 2) + hf * 8192, offk, (unsigned)__builtin_amdgcn_readfirstlane((int)(lds_base + L_K + (bf * NCOMP + cc) * SHM + wid * 1024 + hf * 8192)));
}
__device__ __forceinline__ void dma_v(const h16_t* Vp, int k0, unsigned offv, unsigned lds_base, int bf, int wid) {
    const char* vb_ = (const char*)Vp + (size_t)k0 * (HD * 2);
#pragma unroll
    for (int hf = 0; hf < 2; ++hf) glds16(vb_ + hf * 8192, offv, (unsigned)__builtin_amdgcn_readfirstlane((int)(lds_base + L_V + bf * SHM + wid * 1024 + hf * 8192)));
}
template <int NCOMP>
__device__ __forceinline__ void att_prime(const BlockRef& cur, const h16_t* Qb, const h16_t* Kb, const h16_t* Vb, char* lds, Seam<NCOMP>& S_, int tid) {
    const int wid = __builtin_amdgcn_readfirstlane(tid >> 6), lane = tid & 63, r32 = lane & 31, hi = lane >> 5;
    const int comp = NCOMP == 2 ? (wid >> 2) : 0, wq = NCOMP == 2 ? (wid & 3) : wid;
    const unsigned lds_base = (unsigned)(uintptr_t)lds;
    dma_k<NCOMP>(Kb + cur.koff, 0, dma_offk(wid, lane), lds_base, 0, wid); dma_v(Vb + cur.voff, 0, dma_offv(wid, lane), lds_base, 0, wid);
    { const char* qb_ = (const char*)(Qb + cur.qoff + comp * HSTR + (size_t)(wq * QBLK) * HD); const unsigned qo_ = (unsigned)(r32 * HD + hi * 8) * 2u;
#pragma unroll
      for (int d0 = 0; d0 < 8; ++d0) S_.qr[d0] = ldg8(qb_ + d0 * 32, qo_); }
    VMW();
    __syncthreads();
}

template <int MODE>
__device__ __forceinline__ void epilogue_part(const BlockRef& cur, char* lds, f32x16 (&o)[4], float l_reg, const EpiArgs& ea, int tid_in) {
    constexpr int NCOMP = MODE == 0 ? 2 : 1;
    typedef Lay<NCOMP> L;
    int tid = tid_in; asm volatile("" : "+v"(tid));
    const int wid = __builtin_amdgcn_readfirstlane(tid >> 6), lane = tid & 63, r32 = lane & 31, hi = lane >> 5;
    const int comp = NCOMP == 2 ? (wid >> 2) : 0, wq = NCOMP == 2 ? (wid & 3) : wid;
    float* ws = (float*)(lds + L::WS) + wid * 128; float* li_l = ws;
    if (hi == 0) li_l[r32] = l_reg; asm volatile("s_waitcnt lgkmcnt(0)" ::: "memory");
    float rli[16];
#pragma unroll
    for (int r = 0; r < 16; ++r) rli[r] = __builtin_amdgcn_rcpf(li_l[crow(r, hi)]);
    if (MODE != 0) {
        h16_t* stg = (h16_t*)(lds + L::OST) + wid * 4096;
#pragma unroll
        for (int r = 0; r < 16; ++r) { const int orow = crow(r, hi);
#pragma unroll
            for (int d0 = 0; d0 < 4; ++d0) stg[orow * 128 + d0 * 32 + r32] = f2h(o[d0][r] * rli[r]); }
        asm volatile("s_waitcnt lgkmcnt(0)" ::: "memory");
        const size_t gbase = ((size_t)(cur.b * S + cur.P0 + wq * QBLK) * E + cur.h * HD) * 2;
        const unsigned go_ = (unsigned)((lane >> 4) * E + (lane & 15) * 8) * 2u;
#pragma unroll
        for (int i = 0; i < 8; ++i) { const int row = i * 4 + (lane >> 4), ch = lane & 15;
            const u32x4 ov = *(const u32x4*)(stg + row * 128 + ch * 8);
            const u32x4 zv = *(const u32x4*)((const char*)ea.Zb + gbase + (size_t)i * (4 * E * 2) + go_); u32x4 w;
#pragma unroll
            for (int e = 0; e < 4; ++e) w[e] = pk2(lo16(ov[e]) * siluf(lo16(zv[e])), hi16(ov[e]) * siluf(hi16(zv[e])));
            *(u32x4*)((char*)ea.G + gbase + (size_t)i * (4 * E * 2) + go_) = w; SBAR(); }
    } else {
        unsigned* xch = (unsigned*)(lds + L::OST) + wq * 2048;
        if (comp == 1) { const float lam_ = ((const float*)(lds + L::MISC))[0];
#pragma unroll
            for (int d0 = 0; d0 < 4; ++d0)
#pragma unroll
                for (int r = 0; r < 16; r += 2) xch[(d0 * 8 + (r >> 1)) * 64 + lane] = pk2(o[d0][r] * rli[r] * lam_, o[d0][r + 1] * rli[r + 1] * lam_);
        }
        asm volatile("s_waitcnt lgkmcnt(0)" ::: "memory");
        __syncthreads();
        if (comp == 0) {
            float ssq[16];
#pragma unroll
            for (int r = 0; r < 16; ++r) ssq[r] = 0.f;
#pragma unroll
            for (int d0 = 0; d0 < 4; ++d0)
#pragma unroll
                for (int r = 0; r < 16; r += 2) { const unsigned w = xch[(d0 * 8 + (r >> 1)) * 64 + lane];
                    o[d0][r] = o[d0][r] * rli[r] - lo16(w); o[d0][r + 1] = o[d0][r + 1] * rli[r + 1] - hi16(w);
                    ssq[r] += o[d0][r] * o[d0][r]; ssq[r + 1] += o[d0][r + 1] * o[d0][r + 1]; }
#pragma unroll
            for (int r = 0; r < 16; ++r) ssq[r] = hsum32(ssq[r]);
            float* ssq_l = ws + 64;
            asm volatile("s_waitcnt lgkmcnt(0)" ::: "memory");
            h16_t* stg = (h16_t*)xch;
#pragma unroll
            for (int r = 0; r < 16; ++r) { const int orow = crow(r, hi);
#pragma unroll
                for (int d0 = 0; d0 < 4; ++d0) stg[orow * 128 + d0 * 32 + r32] = f2h(o[d0][r]); }
            const size_t gbase = ((size_t)(cur.b * S + cur.P0 + wq * QBLK) * E + cur.h * 256) * 2;
            const unsigned go_ = (unsigned)((lane >> 4) * E + (lane & 15) * 8) * 2u;
            if (cur.half == 0) {
                if (r32 == 0) {
#pragma unroll
                    for (int r = 0; r < 16; ++r) ssq_l[crow(r, hi)] = ssq[r]; }
                asm volatile("s_waitcnt lgkmcnt(0)" ::: "memory");
#pragma unroll
                for (int i = 0; i < 8; ++i) { const int row = i * 4 + (lane >> 4), ch = lane & 15;
                    *(u32x4*)((char*)ea.G + gbase + (size_t)i * (4 * E * 2) + go_) = *(const u32x4*)(stg + row * 128 + ch * 8); }
            } else {
                if (r32 == 0) {
#pragma unroll
                    for (int r = 0; r < 16; ++r) { const int orow = crow(r, hi); ssq_l[orow] = rsqrtf((ssq_l[orow] + ssq[r]) * (1.f / 256.f) + RMS_EPS) * (1.f - ea.lam_init); } }
                asm volatile("s_waitcnt vmcnt(0) lgkmcnt(0)" ::: "memory");
#pragma unroll
                for (int i = 0; i < 8; ++i) { const int row = i * 4 + (lane >> 4), ch = lane & 15; const float rs = ssq_l[row];
                    const size_t g0 = gbase + (size_t)i * (4 * E * 2), g1 = g0 + 256;
                    const u32x4 u1 = *(const u32x4*)(stg + row * 128 + ch * 8), u0 = *(const u32x4*)((const char*)ea.G + g0 + go_);
                    const u32x4 z0 = *(const u32x4*)((const char*)ea.Zb + g0 + go_), z1 = *(const u32x4*)((const char*)ea.Zb + g1 + go_);
                    const f32x4 ga = *(const f32x4*)(ea.subg + ch * 8), gb = *(const f32x4*)(ea.subg + ch * 8 + 4), gc = *(const f32x4*)(ea.subg + 128 + ch * 8), gd = *(const f32x4*)(ea.subg + 128 + ch * 8 + 4);
                    const float g0v[8] = {ga[0], ga[1], ga[2], ga[3], gb[0], gb[1], gb[2], gb[3]}, g1v[8] = {gc[0], gc[1], gc[2], gc[3], gd[0], gd[1], gd[2], gd[3]};
                    u32x4 w0, w1;
#pragma unroll
                    for (int e = 0; e < 4; ++e) {
                        w0[e] = pk2(lo16(u0[e]) * rs * g0v[2 * e] * siluf(lo16(z0[e])), hi16(u0[e]) * rs * g0v[2 * e + 1] * siluf(hi16(z0[e])));
                        w1[e] = pk2(lo16(u1[e]) * rs * g1v[2 * e] * siluf(lo16(z1[e])), hi16(u1[e]) * rs * g1v[2 * e + 1] * siluf(hi16(z1[e]))); }
                    *(u32x4*)((char*)ea.G + g0 + go_) = w0; *(u32x4*)((char*)ea.G + g1 + go_) = w1; SBAR(); }
            }
        }
    }
}

template <int MODE>
__device__ __forceinline__ void att_block(const BlockRef& cur, const BlockRef& nxt, const h16_t* Qb, const h16_t* Kb, const h16_t* Vb, char* lds, Seam<(MODE == 0 ? 2 : 1)>& S_, const BlkCtx& bc, const EpiArgs& ea, int tid_in) {
    constexpr int NCOMP = MODE == 0 ? 2 : 1, QROWS = 256 / NCOMP;
    typedef Lay<NCOMP> L;
    int tid = tid_in; asm volatile("" : "+v"(tid));
    const int wid = __builtin_amdgcn_readfirstlane(tid >> 6), lane = tid & 63, r32 = lane & 31, hi = lane >> 5;
    const int comp = NCOMP == 2 ? (wid >> 2) : 0, wq = NCOMP == 2 ? (wid & 3) : wid;
    const int NT = (cur.P0 + QROWS) / KVBLK;
    const int qlo = cur.P0 + wq * QBLK, qm = qlo + r32 - 4 * hi;
    const char* Kc_lds = lds + L_K + comp * SHM;
    float* ws = (float*)(lds + L::WS) + wid * 128; float* li_l = ws; float* al_l = ws + 32;
    const float* lut = (const float*)(lds + L::LUT) + comp * 352;
    const float* cumS = (const float*)(lds + L::BIG);
    float m_reg = -1e30f, l_reg = 0; f32x16 o[4] = {};
    const int kswz0 = KSWZ(r32, hi * 16);
    const unsigned offk = dma_offk(wid, lane), offv = dma_offv(wid, lane), lds_base = (unsigned)(uintptr_t)lds;
    const int vb0 = (int)(uintptr_t)lds + v_rd_base(lane);
    const h16_t* Kh = Kb + cur.koff; const h16_t* Vh = Vb + cur.voff;
#define RESC(a) do { if (__any((a) < 1.f)) { if (hi == 0) al_l[r32] = (a); asm volatile("s_waitcnt lgkmcnt(0)" ::: "memory");              \
                     _Pragma("unroll") for (int d_ = 0; d_ < 4; ++d_) _Pragma("unroll") for (int r = 0; r < 16; ++r) o[d_][r] *= al_l[crow(r, hi)]; } } while (0)
#define KBASE(t) ((t) * KVBLK)
#define T_ABOVE(t) (KBASE(t) > qlo + QBLK - 1)
#define T_NEAR(t) (KBASE(t) + KVBLK - 1 >= qlo - 112)
#define MKINIT(i0, i1, t) do { const int kb_ = KBASE(t);                                                                                  \
        if (MODE == 2) { const float* cp_ = cumS + kb_ + 4 * hi; const float cq_ = cumS[qlo + r32];                                                                \
            _Pragma("unroll") for (int g_ = 0; g_ < 4; ++g_) { const f32x4 c0_ = *(const f32x4*)(cp_ + 8 * g_), c1_ = *(const f32x4*)(cp_ + 32 + 8 * g_); \
                _Pragma("unroll") for (int e_ = 0; e_ < 4; ++e_) { i0[4 * g_ + e_] = cq_ - c0_[e_]; i1[4 * g_ + e_] = cq_ - c1_[e_]; } } }          \
        else { float v_ = T_NEAR(t) ? 0.f : lut[328];                                                                               \
            if (MODE == 1) { const int blk_ = kb_ >> 8; if (blk_ != bc.own && !((bc.selbits >> blk_) & 1u)) v_ = -__builtin_inff(); } \
            _Pragma("unroll") for (int r = 0; r < 16; ++r) { i0[r] = v_; i1[r] = v_; } } } while (0)
#define MASKT(P0_, P1_, t) do { const int kb_ = KBASE(t);                                                                         \
        if (T_ABOVE(t)) { const float NEG_ = -__builtin_inff(); _Pragma("unroll") for (int r = 0; r < 16; ++r) { P0_[r] = NEG_; P1_[r] = NEG_; } } \
        else if (MODE == 2) { if (kb_ + KVBLK - 1 > qlo) mask_tile(P0_, P1_, qm - kb_); }                                          \
        else if (T_NEAR(t)) bias_mask_tile(P0_, P1_, qm - kb_, lut); } while (0)
    f32x16 pA0, pA1, pB0, pB1; float alA, alB, psA, psB; f16x8 pa0, pa1, pa2, pa3;
    dma_k<NCOMP>(Kh, KBASE(1), offk, lds_base, 1, wid); dma_v(Vh, KBASE(1), offv, lds_base, 1, wid);
    MKINIT(pA0, pA1, 0);
    SBAR(); qkt<0, NCOMP>(pA0, pA1, Kc_lds, kswz0, S_.qr);
    MASKT(pA0, pA1, 0); partialSM(pA0, pA1, m_reg, alA, psA, pa0, pa1);
    VMW();
    __syncthreads();
#define HALF_STEP(PX0, PX1, alX, psX, PY1, alY, psY, t, KB, VB, SB) do {                                                      \
        dma_k<NCOMP>(Kh, KBASE((t) + 1), offk, lds_base, SB, wid);                                                            \
        MKINIT(PX0, PX1, t);                                                                                                  \
        SBAR(); qkt<KB, NCOMP>(PX0, PX1, Kc_lds, kswz0, S_.qr);                                                               \
        finishSM(PY1, alY, psY, l_reg, pa2, pa3); SBAR();                                                                     \
        pv_tile<VB>(o, vb0, pa0, pa1, pa2, pa3); MASKT(PX0, PX1, (t)); partialSM(PX0, PX1, m_reg, alX, psX, pa0, pa1);        \
        __syncthreads();                                                                                                      \
        dma_v(Vh, KBASE((t) + 1), offv, lds_base, SB, wid);                                                                   \
        RESC(alX); VMWN(2); __syncthreads(); } while (0)
    for (int t = 1; t + 1 < NT; t += 2) {
        HALF_STEP(pB0, pB1, alB, psB, pA1, alA, psA, t, 1, 0, 0);
        HALF_STEP(pA0, pA1, alA, psA, pB1, alB, psB, t + 1, 0, 1, 1);
    }
    MKINIT(pB0, pB1, NT - 1);
    SBAR(); qkt<1, NCOMP>(pB0, pB1, Kc_lds, kswz0, S_.qr); SBAR();
    dma_k<NCOMP>(Kb + nxt.koff, 0, offk, lds_base, 0, wid);
    { const char* qb_ = (const char*)(Qb + nxt.qoff + comp * HSTR + (size_t)(wq * QBLK) * HD); const unsigned qo_ = (unsigned)(r32 * HD + hi * 8) * 2u;
#pragma unroll
        for (int d0 = 0; d0 < 8; ++d0) S_.qr[d0] = ldg8(qb_ + d0 * 32, qo_); }
    SBAR();
    finishSM(pA1, alA, psA, l_reg, pa2, pa3); SBAR();
    pv_tile<0>(o, vb0, pa0, pa1, pa2, pa3);
    MASKT(pB0, pB1, NT - 1); partialSM(pB0, pB1, m_reg, alB, psB, pa0, pa1);
    VMW();
    __syncthreads();
    dma_v(Vb + nxt.voff, 0, offv, lds_base, 0, wid);
    RESC(alB);
    finishSM(pB1, alB, psB, l_reg, pa2, pa3); SBAR(); pv_tile<1>(o, vb0, pa0, pa1, pa2, pa3);
    SBAR();
    epilogue_part<MODE>(cur, lds, o, l_reg, ea, tid_in);
    VMW();
    __syncthreads();
#undef RESC
#undef KBASE
#undef T_ABOVE
#undef T_NEAR
#undef MKINIT
#undef MASKT
#undef HALF_STEP
}

template <int MODE>
__device__ __forceinline__ BlockRef att_ref(int item, int j) {
    BlockRef r;
    if (MODE == 0) { const int bh = item >> 3, y = item & 7, x = (j < 2) ? y : 15 - y; r.b = bh >> 3; r.h = bh & 7; r.half = j & 1; r.x = x; r.P0 = x * 128;
        const unsigned hb = (unsigned)(r.b * NH + 2 * r.h) * (unsigned)HSTR; r.qoff = hb + (unsigned)r.P0 * HD; r.koff = hb; r.voff = hb + r.half * (unsigned)HSTR; }
    else { const int bh = item >> 2, y = item & 3, x = (j == 0) ? y : 7 - y; r.b = bh >> 4; r.h = bh & 15; r.half = 0; r.x = x; r.P0 = x * 256;
        const unsigned hb = (unsigned)(r.b * NH + r.h) * (unsigned)HSTR; r.qoff = hb + (unsigned)r.P0 * HD; r.koff = hb; r.voff = hb; }
    return r;
}
template <int MODE>
__device__ __forceinline__ void attn_phase(const Ctx& c, const AttnArgs& A) {
    constexpr int NCOMP = MODE == 0 ? 2 : 1, NBLK = MODE == 0 ? 4 : 2, NITEMS = 256;
    typedef Lay<NCOMP> L;
    char* lds = (char*)c.lds;
    const int tid = c.tid, wid = c.wave, lane = c.lane, r32 = lane & 31, hi = lane >> 5;
    const int comp = NCOMP == 2 ? (wid >> 2) : 0, wq = NCOMP == 2 ? (wid & 3) : wid;
    const int vcu = (c.G % 8 == 0) ? (c.bid % 8) * (c.G / 8) + c.bid / 8 : c.bid;
    float* misc = (float*)(lds + L::MISC); float* lutw = (float*)(lds + L::LUT); float* big = (float*)(lds + L::BIG);
    EpiArgs ea{A.Zb, A.G, A.subg, A.lam_init};
    if (MODE == 0) {
        if (tid < 64) { float a = A.lq1[tid] * A.lk1[tid] + A.lq1[tid + 64] * A.lk1[tid + 64], cc = A.lq2[tid] * A.lk2[tid] + A.lq2[tid + 64] * A.lk2[tid + 64];
            a = wave_sum(a); cc = wave_sum(cc); if (tid == 0) misc[0] = __expf(a) - __expf(cc) + A.lam_init; }
        __syncthreads();
    }
    Seam<NCOMP> S_;
    int item = vcu; if (item >= NITEMS) return;
    int j = 0; BlockRef cur = att_ref<MODE>(item, 0);
    att_prime<NCOMP>(cur, A.Qb, A.Kb, A.Vb, lds, S_, tid);
    bool new_item = true;
    for (;;) {
        if (new_item) {
            int tid = c.tid; asm volatile("" : "+v"(tid)); const int lane = tid & 63;
            if (MODE != 2) { for (int i = tid; i < NCOMP * 352; i += NTHREADS) { const int cc = i / 352, ii = i % 352, dist = ii - 128; const int hq = MODE == 0 ? 2 * cur.h + cc : cur.h;
                    lutw[i] = A.rel[t5_bucket(dist > 0 ? dist : 0) * 16 + hq] * (1.f / SCALE); } }
            if (MODE == 1) { for (int i = tid; i < 8 * 128; i += NTHREADS) { const float* k0 = A.kpart + (size_t)(cur.b * NH + cur.h) * 8 * HD + i; big[i] = (k0[0] + k0[(size_t)NB * NH * 8 * HD]) * (1.f / 256.f); } }
            if (MODE == 2) {
                float v[4];
#pragma unroll
                for (int e = 0; e < 4; ++e) v[e] = A.logf[(size_t)(cur.b * S + 4 * tid + e) * NH + cur.h];
                v[1] += v[0]; v[2] += v[1]; v[3] += v[2];
                float incl = v[3];
#pragma unroll
                for (int o = 1; o < 64; o <<= 1) { const float t = __int_as_float(__builtin_amdgcn_ds_bpermute(((lane - o) & 63) << 2, __float_as_int(incl))); if (lane >= o) incl += t; }
                if (lane == 63) misc[8 + wid] = incl;
                __syncthreads();
                float off = incl - v[3];
                for (int w = 0; w < wid; ++w) off += misc[8 + w];
                const f32x4 o4 = {(v[0] + off) * (1.f / SCALE), (v[1] + off) * (1.f / SCALE), (v[2] + off) * (1.f / SCALE), (v[3] + off) * (1.f / SCALE)};
                *(f32x4*)(big + 4 * tid) = o4;
            }
            __syncthreads();
            new_item = false;
        }
        BlkCtx bc; bc.selbits = 0u; bc.own = cur.x;
        if (MODE == 1) {
            float gate[8];
#pragma unroll
            for (int n = 0; n < 8; ++n) { float gs = 0.f;
                if (n < cur.x) {
#pragma unroll
                    for (int d0 = 0; d0 < 8; ++d0) { const float* kp = big + n * 128 + d0 * 16 + hi * 8; const f32x4 k0 = *(const f32x4*)kp, k1 = *(const f32x4*)(kp + 4); const f16x8 q = S_.qr[d0];
                        gs += (float)q[0] * k0[0] + (float)q[1] * k0[1] + (float)q[2] * k0[2] + (float)q[3] * k0[3] + (float)q[4] * k1[0] + (float)q[5] * k1[1] + (float)q[6] * k1[2] + (float)q[7] * k1[3]; }
                    gs = xadd32(gs); }
                gate[n] = n < cur.x ? gs : NEGF; SBAR(); }
            unsigned sb = 0u;
#pragma unroll
            for (int k = 0; k < 3; ++k) { int best = -1; float bv = 0.f;
#pragma unroll
                for (int n = 0; n < 8; ++n) if (!((sb >> n) & 1u) && (best < 0 || gate[n] > bv)) { best = n; bv = gate[n]; }
                sb |= 1u << best; }
            bc.selbits = sb & ((1u << cur.x) - 1u);
        }
        int itemn = item, jn = j + 1; bool last = false;
        if (jn == NBLK) { jn = 0; itemn = item + c.G; if (itemn >= NITEMS) { last = true; itemn = item; jn = j; } }
        const BlockRef nxt = att_ref<MODE>(itemn, jn);
        att_block<MODE>(cur, nxt, A.Qb, A.Kb, A.Vb, lds, S_, bc, ea, tid);
        if (last) break;
        new_item = itemn != item; cur = nxt; item = itemn; j = jn;
    }
    VMW();
}
#undef ROW
#undef VMW
#undef VMWN
#undef KSWZ
#undef SBAR
}

#define XB_TMO      128
#define XB_XCNT(j)  (256  + 64 * (j))
#define XB_XSUB(j)  (1280 + 64 * (j))
#define XB_XGEN(j)  (2304 + 64 * (j))
#define XB_TOP      3328
#define XB_TOPGEN   3392
#define XCD_BAR_WORDS 3456
#define XB_SPIN_CAP (1u << 18)
__device__ __forceinline__ unsigned xb_ld(unsigned* p)              { return __hip_atomic_load(p, __ATOMIC_RELAXED, __HIP_MEMORY_SCOPE_AGENT); }
__device__ __forceinline__ unsigned xb_add(unsigned* p, unsigned v) { return __hip_atomic_fetch_add(p, v, __ATOMIC_RELAXED, __HIP_MEMORY_SCOPE_AGENT); }
__device__ __forceinline__ unsigned xb_xcc_id() { return (unsigned)__builtin_amdgcn_s_getreg((3 << 11) | 20) & 0xFu; }
#define XB_SPIN(cond, bar) do { unsigned _sp = 0; while (cond) { __builtin_amdgcn_s_sleep(1); \
    if ((++_sp & 255u) == 0u) { if (xb_ld(&(bar)[XB_TMO])) break; if (_sp > XB_SPIN_CAP) { atomicAdd(&(bar)[XB_TMO], 1u); break; } } } } while (0)
struct XcdBarrier { unsigned* bar; unsigned x; volatile LAS unsigned* st; };
__device__ __forceinline__ void xcd_barrier_complete(unsigned* bar, unsigned x, unsigned& nloc, unsigned& nx) {
    const unsigned G = gridDim.x * gridDim.y * gridDim.z;
    unsigned sum, cnt, mine, sp = 0u;
    for (;;) {
        sum = 0u; cnt = 0u; mine = 0u;
#pragma unroll
        for (unsigned j = 0; j < 16; ++j) { const unsigned c = xb_ld(&bar[XB_XCNT(j)]); sum += c; cnt += (c > 0u) ? 1u : 0u; mine = (j == x) ? c : mine; }
        if (sum == G) break;
        __builtin_amdgcn_s_sleep(1);
        if ((++sp & 255u) == 0u) { if (xb_ld(&bar[XB_TMO])) break; if (sp > XB_SPIN_CAP) { atomicAdd(&bar[XB_TMO], 1u); break; } }
    }
    nloc = mine > 0u ? mine : 1u; nx = cnt > 0u ? cnt : 1u;
}
__device__ __forceinline__ void xcd_barrier(const XcdBarrier& b, bool leader_thread) {
    asm volatile("s_waitcnt vmcnt(0)" ::: "memory");
    __syncthreads();
    if (leader_thread) {
        unsigned* bar = b.bar;
        __builtin_amdgcn_s_waitcnt(0);
        unsigned nloc = b.st[0], nx = b.st[1];
        if (nloc == 0u) { xcd_barrier_complete(bar, b.x, nloc, nx); b.st[0] = nloc; b.st[1] = nx; }
        const unsigned old = xb_add(&bar[XB_XSUB(b.x)], 1u);
        const unsigned gen = old / nloc;
        if (old + 1u == (gen + 1u) * nloc) {
            __builtin_amdgcn_fence(__ATOMIC_RELEASE, "agent");
            asm volatile("s_waitcnt vmcnt(0)" ::: "memory");
            const unsigned og = xb_add(&bar[XB_TOP], 1u);
            const unsigned tg = og / nx;
            if (og + 1u == (tg + 1u) * nx) xb_add(&bar[XB_TOPGEN], 1u);
            else XB_SPIN(xb_ld(&bar[XB_TOPGEN]) == tg, bar);
            __builtin_amdgcn_fence(__ATOMIC_ACQUIRE, "agent");
            xb_add(&bar[XB_XGEN(b.x)], 1u);
            asm volatile("s_waitcnt vmcnt(0)" ::: "memory");
        } else {
            XB_SPIN(xb_ld(&bar[XB_XGEN(b.x)]) == gen, bar);
            __builtin_amdgcn_fence(__ATOMIC_ACQUIRE, "agent");
            asm volatile("s_waitcnt vmcnt(0)" ::: "memory");
        }
    }
    __syncthreads();
}

struct Args { const float* in[29]; float* out; unsigned char* ws; int ph_lo, ph_hi; };
static_assert(sizeof(Args) == 31 * 8 + 8, "Args has no padding");

__global__ void __launch_bounds__(NTHREADS, 2) mega_fwd(Args args) {
    extern __shared__ __attribute__((aligned(16))) unsigned char lds[];
    cg::grid_group grid = cg::this_grid();
    const int wave_id = __builtin_amdgcn_readfirstlane(threadIdx.x >> 6);
    volatile LAS unsigned* xst = (volatile LAS unsigned*)((LAS unsigned char*)lds + XB_LDS_OFF);
    if (threadIdx.x < 4) xst[threadIdx.x] = 0u;
    __syncthreads();
    XcdBarrier xbar; xbar.bar = (unsigned*)(args.ws + WS_CTL) + 1024; xbar.x = xb_xcc_id(); xbar.st = xst;
    if (threadIdx.x == 0) (void)xb_add(&xbar.bar[XB_XCNT(xbar.x)], 1u);
#define W_X (args.in[0])
#define W_REL (args.in[1])
#define W_HB ((h16_t*)(ws + WS_HB))
#define W_Q ((h16_t*)(ws + WS_Q))
#define W_K ((h16_t*)(ws + WS_K))
#define W_V ((h16_t*)(ws + WS_V))
#define W_Z ((h16_t*)(ws + WS_Z))
#define W_G ((h16_t*)(ws + WS_G))
#define W_STATS ((float*)(ws + WS_STATS))
#define W_KPART ((float*)(ws + WS_KPART))
#define W_LOGF ((float*)(ws + WS_LOGF))
#define W_CUM ((float*)(ws + WS_CUM))
#define W_WF ((h16_t*)(ws + WS_WF))
#define W_T (args.out)
#define PHASE_BEGIN { Ctx c; c.lane = (int)__builtin_amdgcn_mbcnt_hi(~0u, __builtin_amdgcn_mbcnt_lo(~0u, 0u)); c.tid = wave_id * 64 + c.lane; asm volatile("" : "+v"(c.tid)); c.lane = c.tid & 63; c.wave = wave_id; c.G = gridDim.x; c.bid = blockIdx.x; c.lds = lds; __attribute__((address_space(1))) unsigned char* wsg_ = (__attribute__((address_space(1))) unsigned char*)args.ws; asm volatile("" : "+s"(wsg_)); unsigned char* ws = (unsigned char*)wsg_;
#define PHASE_END(dosync_) if (dosync_) { if (USE_CG_SYNC) grid.sync(); else xcd_barrier(xbar, c.tid == 0); } }

    for (int rep_ = 0; rep_ < REP_P0; ++rep_) {
    PHASE_BEGIN
    {
        LAS float* scr = (LAS float*)((LAS unsigned char*)lds + c.wave * 16640);
        const int gw = c.bid * NWAVES + c.wave, NGW = c.G * NWAVES;
        constexpr int I_IN = (D / 64) * (NPROJ / 64), I_OUT = (E / 64) * (D / 64), I_F = D / 64, NITEMS = 4 * (I_IN + I_OUT) + I_F;
        for (int it = gw; it < NITEMS; it += NGW) {
            int r = it;
            if (r < 4 * I_IN) { const int l = r / I_IN; r -= l * I_IN; const int wi = l == 0 ? 2 : (l == 1 ? 11 : (l == 2 ? 15 : 20));
                p0_transpose_item(args.in[wi], (l == 2) ? NPROJ + 16 : NPROJ, 0, NPROJ, (h16_t*)(ws + WS_WIN + (size_t)l * 32 * MiB), scr, r, c.lane); continue; }
            r -= 4 * I_IN;
            if (r < 4 * I_OUT) { const int l = r / I_OUT; r -= l * I_OUT; const int wi = l == 0 ? 8 : (l == 1 ? 12 : (l == 2 ? 17 : 26));
                p0_transpose_item(args.in[wi], D, 0, D, (h16_t*)(ws + WS_WOUT + (size_t)l * 8 * MiB), scr, r, c.lane); continue; }
            r -= 4 * I_OUT;
            p0_transpose_item(args.in[15], NPROJ + 16, NPROJ, 16, W_WF, scr, r, c.lane);
        }
        cvt_phase(c, W_X, W_HB, (size_t)M * D);
    }
    if (rep_ + 1 < REP_P0) { xcd_barrier(xbar, c.tid == 0); } else
    grid.sync(); } }

#ifdef DBG_ONLY
    for (int l = DBG_LAYER; l <= DBG_LAYER; ++l) {
#else
#pragma unroll 1
    for (int l = 0; l < 4; ++l) {
#endif
        const int i_g[4] = {9, 13, 18, 27}, i_b[4] = {10, 14, 19, 28};
#define W_WIN ((const h16_t*)(ws + WS_WIN + (size_t)l * 32 * MiB))
#define W_WOUT ((const h16_t*)(ws + WS_WOUT + (size_t)l * 8 * MiB))
        for (int rep_ = 0; rep_ < REP_IN; ++rep_) {
        PHASE_BEGIN
        {
            if (l == 2) logf_phase(c, W_HB, W_WF, args.in[16], W_LOGF);
            pg8::Gemm g{W_HB, W_WIN, M, NPROJ, D}; pg8::StaticOrder So; So.init(M, NPROJ, c.G, c.bid);
            EpiQKVZ Ep{W_Q, W_K, W_V, W_Z, l == 1 ? W_KPART : nullptr};
            pg8::gemm_phase<EpiQKVZ, pg8::StaticOrder, true, true>((LAS unsigned char*)lds, g, So, Ep, c.tid);
        }
        PHASE_END(true)
        }
#ifdef DBG_LAYER
        if (l == DBG_LAYER) {
            h16_t* G2 = (h16_t*)args.out; unsigned* ctl = (unsigned*)args.ws;
            PHASE_BEGIN if (l == 2) cum_phase(c, W_LOGF, W_CUM); PHASE_END(true)
            for (int pass = 0; pass < 2; ++pass) {
            PHASE_BEGIN
            {
                AttnArgs A{W_Q, W_K, W_V, W_Z, pass ? G2 : W_G, W_REL, W_KPART, W_CUM, W_LOGF, nullptr, nullptr, nullptr, nullptr, nullptr, 0.f};
                if (l == 0 || l == 3) { const int base = (l == 0) ? 3 : 21; A.lq1 = args.in[base]; A.lk1 = args.in[base + 1]; A.lq2 = args.in[base + 2]; A.lk2 = args.in[base + 3]; A.subg = args.in[base + 4];
                    A.lam_init = (l == 0) ? 0.2f : (0.8f - 0.6f * 0.40656965974059917f);
                    if (pass) att::attn_phase<0>(c, A); else attn_naive_phase<0>(c, A); }
                else if (l == 1) { if (pass) att::attn_phase<1>(c, A); else attn_naive_phase<1>(c, A); }
                else { if (pass) att::attn_phase<2>(c, A); else attn_naive_phase<2>(c, A); }
            }
            PHASE_END(true)
            }
            PHASE_BEGIN
            {
                float best = 0.f; unsigned nbad = 0u;
                for (int sl = c.bid * NWAVES + c.wave; sl < M * 16; sl += c.G * NWAVES) {
                    const size_t idx = (size_t)(sl >> 4) * E + (sl & 15) * 128 + c.lane * 2;
                    const unsigned a = *(const unsigned*)(W_G + idx), b = *(const unsigned*)(G2 + idx);
                    float md = fmaxf(fabsf(lo16(a) - lo16(b)), fabsf(hi16(a) - hi16(b))), ma = fmaxf(fabsf(lo16(a)), fabsf(hi16(a)));
                    for (int o = 1; o < 64; o <<= 1) { md = fmaxf(md, __shfl_xor(md, o)); ma = fmaxf(ma, __shfl_xor(ma, o)); }
                    const float r = (md == md) ? md / fmaxf(ma, 1e-20f) : 1e9f;
                    best = fmaxf(best, r); nbad += (r > 0.05f) ? 1u : 0u;
                }
                if (c.lane == 0) { atomicMax(ctl + 0, __float_as_uint(best)); atomicAdd(ctl + 1, nbad); }
            }
            PHASE_END(true)
            PHASE_BEGIN
            for (size_t i = ((size_t)c.bid * NTHREADS + c.tid) * 4; i < (size_t)M * D; i += (size_t)c.G * NTHREADS * 4) *(f32x4*)(args.out + i) = (f32x4){0.f, 0.f, 0.f, 0.f};
            PHASE_END(true)
            if (blockIdx.x == 0 && threadIdx.x == 0) {
#if DBG_WHAT == 0
                args.out[0] = 1e6f * __uint_as_float(__hip_atomic_load(ctl + 0, __ATOMIC_RELAXED, __HIP_MEMORY_SCOPE_AGENT));
#else
                args.out[0] = 1e3f * (float)__hip_atomic_load(ctl + 1, __ATOMIC_RELAXED, __HIP_MEMORY_SCOPE_AGENT);
#endif
            }
            return;
        }
#endif
        if (!FAST2) {
        PHASE_BEGIN
        if (l == 2) cum_phase(c, W_LOGF, W_CUM);
        PHASE_END(l == 2)
        }
        for (int rep_ = 0; rep_ < ((REP_ATT_L < 0 || REP_ATT_L == l) ? REP_ATT : 1); ++rep_) {
        PHASE_BEGIN
        {
            AttnArgs A{W_Q, W_K, W_V, W_Z, W_G, W_REL, W_KPART, W_CUM, W_LOGF, nullptr, nullptr, nullptr, nullptr, nullptr, 0.f};
            if (l == 0 || l == 3) { const int base = (l == 0) ? 3 : 21; A.lq1 = args.in[base]; A.lk1 = args.in[base + 1]; A.lq2 = args.in[base + 2]; A.lk2 = args.in[base + 3]; A.subg = args.in[base + 4];
                A.lam_init = (l == 0) ? 0.2f : (0.8f - 0.6f * 0.40656965974059917f);
                if (FAST0) att::attn_phase<0>(c, A); else attn_naive_phase<0>(c, A); }
            else if (l == 1) { if (FAST1) att::attn_phase<1>(c, A); else attn_naive_phase<1>(c, A); }
            else { if (FAST2) att::attn_phase<2>(c, A); else attn_naive_phase<2>(c, A); }
        }
        PHASE_END(true)
        }
        PHASE_BEGIN
        {
            pg8::Gemm g{W_G, W_WOUT, M, D, E}; pg8::StaticOrder So; So.init(M, D, c.G, c.bid);
            EpiResid Ep{W_T, W_X, W_STATS, l ? args.in[i_g[l - 1]] : nullptr, l ? args.in[i_b[l - 1]] : nullptr, l};
            pg8::gemm_phase<EpiResid, pg8::StaticOrder, false, true>((LAS unsigned char*)lds, g, So, Ep, c.tid);
        }
        PHASE_END(true)
        for (int rep_ = 0; rep_ < (l == 3 ? 1 : REP_LN); ++rep_) {
        PHASE_BEGIN
        ln_phase(c, W_T, args.in[i_g[l]], args.in[i_b[l]], W_STATS, W_HB, l == 3);
        PHASE_END(true)
        }
    }
}

extern "C" void kernel_launch(void* const* d_in, const int* in_sizes, int n_in, void* d_out, int out_size, void* d_ws, size_t ws_size, hipStream_t stream) {
    static int grid = 0;
    if (grid == 0) {
        if (n_in != 29 || ws_size < WS_END || out_size != M * D) { fprintf(stderr, "kernel_launch: unexpected shapes n_in=%d ws=%zu out=%d\n", n_in, ws_size, out_size); grid = -1; return; }
        int dev = 0, cus = 0, per_cu = 0;
        (void)hipGetDevice(&dev); (void)hipDeviceGetAttribute(&cus, hipDeviceAttributeMultiprocessorCount, dev);
        if (hipFuncSetAttribute((const void*)mega_fwd, hipFuncAttributeMaxDynamicSharedMemorySize, LDS_BYTES) != hipSuccess) { fprintf(stderr, "kernel_launch: hipFuncSetAttribute failed\n"); grid = -1; return; }
        if (hipOccupancyMaxActiveBlocksPerMultiprocessor(&per_cu, (const void*)mega_fwd, NTHREADS, LDS_BYTES) != hipSuccess || per_cu < 1) { fprintf(stderr, "kernel_launch: occupancy query says %d\n", per_cu); per_cu = 1; }
        (void)hipGetLastError();
        grid = cus > 0 ? cus : 256;
    }
    if (grid < 0) return;
    (void)hipMemsetAsync(d_ws, 0, 32768, stream);
    Args a{};
    for (int i = 0; i < 29; ++i) a.in[i] = (const float*)d_in[i];
    a.out = (float*)d_out; a.ws = (unsigned char*)d_ws; a.ph_lo = 0; a.ph_hi = 1000;
    void* kargs[] = {&a};
    hipError_t e = hipLaunchCooperativeKernel((const void*)mega_fwd, dim3(grid), dim3(NTHREADS), kargs, LDS_BYTES, stream);
    if (e != hipSuccess) fprintf(stderr, "kernel_launch: cooperative launch failed: %s (grid %d)\n", hipGetErrorString(e), grid);
}
```

```cpp
#include <hip/hip_runtime.h>
#include <hip/hip_cooperative_groups.h>
#include <cstdint>
#include <cstdio>
namespace cg = cooperative_groups;

typedef unsigned short h16_t;
typedef float f32x4 __attribute__((ext_vector_type(4)));
typedef float f32x2 __attribute__((ext_vector_type(2)));
typedef unsigned u32x4 __attribute__((ext_vector_type(4)));
typedef _Float16 f16x8 __attribute__((ext_vector_type(8)));
typedef _Float16 f16x2 __attribute__((ext_vector_type(2)));
#define LAS __attribute__((address_space(3)))

constexpr int NB = 4, S = 2048, D = 2048, M = NB * S, E = 2048, NH = 16, HD = 128;
constexpr int NPROJ = 4 * E;
constexpr float SCALE = 0.08838834764831845f;
constexpr float LN_EPS = 1e-5f, RMS_EPS = 1e-5f;
constexpr float DN_ALPHA = 1.681792830507429f;
constexpr float NEGF = -1e30f;
constexpr int NTHREADS = 512, NWAVES = 8;
constexpr int LDS_BYTES = 147456;
constexpr int XB_LDS_OFF = LDS_BYTES - 64;
#ifndef ATT_PRIO
#define ATT_PRIO 1
#endif
#ifndef REP_EPI
#define REP_EPI 1
#endif
#ifndef IN_ALIGN
#define IN_ALIGN true
#endif
#ifndef IN_SP2
#define IN_SP2 true
#endif
#ifndef OUT_SP2
#define OUT_SP2 true
#endif
#ifndef REP_P0
#define REP_P0 1
#endif
#ifndef REP_IN
#define REP_IN 1
#endif
#ifndef REP_ATT
#define REP_ATT 1
#endif
#ifndef REP_ATT_L
#define REP_ATT_L -1
#endif
#ifndef REP_LN
#define REP_LN 1
#endif
#ifndef USE_COOP
#define USE_COOP 0
#endif
#ifndef USE_CG_SYNC
#define USE_CG_SYNC 0
#endif

constexpr size_t MiB = 1u << 20;
constexpr size_t WS_CTL = 0;
constexpr size_t WS_WIN = 1 * MiB;
constexpr size_t WS_WOUT = WS_WIN + 128 * MiB;
constexpr size_t WS_HB = WS_WOUT + 32 * MiB;
constexpr size_t WS_Q = WS_HB + 32 * MiB;
constexpr size_t WS_K = WS_Q + 32 * MiB;
constexpr size_t WS_V = WS_K + 32 * MiB;
constexpr size_t WS_Z = WS_V + 32 * MiB;
constexpr size_t WS_G = WS_Z + 32 * MiB;
constexpr size_t WS_SMALL = WS_G + 32 * MiB;
constexpr size_t WS_STATS = WS_SMALL;
constexpr size_t WS_KPART = WS_STATS + 64 * 1024;
constexpr size_t WS_LOGF = WS_KPART + 512 * 1024;
constexpr size_t WS_CUM = WS_LOGF + 512 * 1024;
constexpr size_t WS_WF = WS_CUM + 512 * 1024;
constexpr size_t WS_END = WS_WF + 64 * 1024;

__device__ __forceinline__ float h2f(h16_t v) { return (float)__builtin_bit_cast(_Float16, v); }
__device__ __forceinline__ h16_t f2h(float f) { return __builtin_bit_cast(h16_t, (_Float16)f); }
__device__ __forceinline__ float lo16(unsigned u) { return h2f((h16_t)(u & 0xffffu)); }
__device__ __forceinline__ float hi16(unsigned u) { return h2f((h16_t)(u >> 16)); }
__device__ __forceinline__ unsigned pk2(float lo, float hi) { f32x2 v = {lo, hi}; return __builtin_bit_cast(unsigned, __builtin_convertvector(v, f16x2)); }
template <int MASK> __device__ __forceinline__ float xsw(float v) { return __int_as_float(__builtin_amdgcn_ds_swizzle(__float_as_int(v), (MASK << 10) | 0x1F)); }
__device__ __forceinline__ float xadd32(float v) { auto rr = __builtin_amdgcn_permlane32_swap(__float_as_uint(v), __float_as_uint(v), false, false); return __uint_as_float(rr[0]) + __uint_as_float(rr[1]); }
__device__ __forceinline__ float hsum32(float v) { v += xsw<1>(v); v += xsw<2>(v); v += xsw<4>(v); v += xsw<8>(v); v += xsw<16>(v); return v; }
__device__ __forceinline__ float siluf(float z) { return z / (1.f + __expf(-z)); }

__device__ __forceinline__ int t5_bucket(int d) {
    if (d < 16) return d;
    if (d >= 113) return 31;
    int b = 16;
    b += (d >= 19); b += (d >= 21); b += (d >= 24); b += (d >= 27); b += (d >= 31); b += (d >= 35); b += (d >= 40); b += (d >= 46);
    b += (d >= 52); b += (d >= 59); b += (d >= 67); b += (d >= 77); b += (d >= 87); b += (d >= 99);
    return b;
}

namespace pg8 {
constexpr int BM = 256, BK = 64, HALF = 128, HTB = HALF * BK * 2, STAGE_BYTES = 8 * HTB, NXCD = 8, WGM = 8;
__host__ __device__ __forceinline__ int lds_byte(int r, int c) { const int st = (r >> 4) * 2 + (c >> 5), rr = r & 15, cc = c & 31, ob = rr * 64 + cc * 2; return st * 1024 + (ob ^ (((ob >> 9) & 1) << 5)); }
__host__ __device__ __forceinline__ void stage_rc(int b, int& R, int& C) { const int st = b / 1024, sb = b % 1024, swz = sb ^ (((sb >> 9) & 1) << 5); R = (st >> 1) * 16 + swz / 64; C = (st & 1) * 32 + (swz % 64) / 2; }
__host__ __device__ __forceinline__ int perm32(int rho) { const int n = rho >> 4, i = rho & 15; return 8 * (i >> 2) + 4 * n + (i & 3); }
struct Unit { int pm, pn; };
struct Gemm { const h16_t* A; const h16_t* Bt; int M, N, K; };
struct StaticOrder {
    int nM, nN, nwg, G, c;
    __host__ __device__ void init(int M_, int N_, int G_, int c_) { nM = M_ / BM; nN = N_ / BM; nwg = nM * nN; G = G_; c = c_; }
    __host__ __device__ bool next(int i, Unit& u) const {
        const long L = (long)i * G + c; if (L >= nwg) return false;
        int wgid = (int)L; { const int q = nwg / NXCD, r = nwg % NXCD, xcd = wgid % NXCD, off = wgid / NXCD; wgid = (xcd < r ? xcd * (q + 1) : r * (q + 1) + (xcd - r) * q) + off; }
        const int nig = WGM * nN, gid = wgid / nig, fm = gid * WGM, gsz = (nM - fm) < WGM ? (nM - fm) : WGM;
        u.pm = fm + ((wgid % nig) % gsz); u.pn = (wgid % nig) / gsz; return true;
    }
    __device__ __forceinline__ void a_ready(const Unit&) const {}
    __device__ __forceinline__ void done(const Unit&) const {}
};

template <class Epi, class Sched, bool ALIGN_EPI = false, bool SP2 = false>
__device__ __forceinline__ void gemm_phase(LAS unsigned char* lds, const Gemm g, const Sched& S, const Epi& E, const int tid) {
    const int wid = __builtin_amdgcn_readfirstlane(tid >> 6), lane = tid & 63, wr = wid >> 2, wc = wid & 3, fr = lane & 15, fq = lane >> 4;
    const int K = g.K, nt = K / BK;
    unsigned voffA[2], voffB[2];
#pragma unroll
    for (int i = 0; i < 2; ++i) { int R, C; stage_rc(tid * 16 + i * 8192, R, C); const int Rb = Epi::PERM ? ((R & ~31) + perm32(R & 31)) : R;
        voffA[i] = (unsigned)(R * K + C) * 2u; voffB[i] = (unsigned)(Rb * K + C) * 2u; }
    const size_t kstep = (size_t)(BK * 2);
    const size_t hstep = (size_t)HALF * K * 2;
    const size_t tstep = 2 * hstep;
    const unsigned ldsw = (unsigned)wid * 1024u;
    const int aoff = lds_byte(wr * 64 + fr, fq * 8), boff = lds_byte(wc * 32 + fr, fq * 8);
#define PG8_SA(b, h) (((b) * 2 + (h)) * HTB)
#define PG8_SB(b, h) ((4 + (b) * 2 + (h)) * HTB)
#define PG8_STAGE(bufoff, gbase, voff) do { _Pragma("unroll") for (int _i = 0; _i < 2; ++_i) \
        __builtin_amdgcn_global_load_lds((const unsigned*)((const char*)(gbase) + (voff)[_i]), (LAS unsigned*)(lds + (bufoff) + ldsw + _i * 8192), 16, 0, 0); } while (0)
#define PG8_LDA(dst, b, h) do { _Pragma("unroll") for (int m = 0; m < 4; ++m) _Pragma("unroll") for (int k = 0; k < 2; ++k) dst[m][k] = *(const LAS f16x8*)(lds + PG8_SA(b, h) + aoff + m * 2048 + k * 1024); } while (0)
#define PG8_LDB(dst, b, h) do { _Pragma("unroll") for (int n = 0; n < 2; ++n) _Pragma("unroll") for (int k = 0; k < 2; ++k) dst[n][k] = *(const LAS f16x8*)(lds + PG8_SB(b, h) + boff + n * 2048 + k * 1024); } while (0)
#define PG8_MMA(ai, bj, At, Bt) do { __builtin_amdgcn_s_setprio(1); _Pragma("unroll") for (int m = 0; m < 4; ++m) _Pragma("unroll") for (int n = 0; n < 2; ++n) _Pragma("unroll") for (int k = 0; k < 2; ++k) \
        acc[ai][bj][m][n] = __builtin_amdgcn_mfma_f32_16x16x32_f16(Bt[n][k], At[m][k], acc[ai][bj][m][n], 0, 0, 0); __builtin_amdgcn_s_setprio(0); } while (0)
#define PG8_WAIT_V(n) asm volatile("s_waitcnt vmcnt(" #n ")" ::: "memory")
#define PG8_WAIT_L(n) asm volatile("s_waitcnt lgkmcnt(" #n ")" ::: "memory")
#define PG8_BAR __builtin_amdgcn_s_barrier()
#define PG8_SCHED __builtin_amdgcn_sched_barrier(0)
    Unit cur, nxt; int ui = 0;
    if (!S.next(0, cur)) return;
    f32x4 acc[2][2][4][2];
#pragma unroll
    for (int a = 0; a < 2; ++a)
#pragma unroll
        for (int b = 0; b < 2; ++b)
#pragma unroll
            for (int m = 0; m < 4; ++m)
#pragma unroll
                for (int n = 0; n < 2; ++n) acc[a][b][m][n] = (f32x4){0.f, 0.f, 0.f, 0.f};
    f16x8 At[4][2], B0[2][2], B1[2][2];
    const char* cA = (const char*)g.A + (size_t)cur.pm * tstep; const char* cB = (const char*)g.Bt + (size_t)cur.pn * tstep;
    S.a_ready(cur);
    if constexpr (SP2) {
        PG8_STAGE(PG8_SB(0, 0), cB, voffB); PG8_STAGE(PG8_SB(0, 1), cB + hstep, voffB); PG8_STAGE(PG8_SA(0, 0), cA, voffA); PG8_STAGE(PG8_SA(0, 1), cA + hstep, voffA);
        if (wr == 1) PG8_BAR;
        PG8_WAIT_V(2); PG8_BAR;
        PG8_STAGE(PG8_SB(1, 0), cB + kstep, voffB); PG8_STAGE(PG8_SA(1, 0), cA + kstep, voffA); PG8_STAGE(PG8_SB(1, 1), cB + hstep + kstep, voffB);
        PG8_WAIT_V(6); PG8_BAR;
    } else {
        PG8_STAGE(PG8_SB(0, 0), cB, voffB); PG8_STAGE(PG8_SA(0, 0), cA, voffA); PG8_STAGE(PG8_SB(0, 1), cB + hstep, voffB); PG8_STAGE(PG8_SA(0, 1), cA + hstep, voffA);
        if (wr == 1) PG8_BAR;
        PG8_WAIT_V(4); PG8_BAR;
        PG8_STAGE(PG8_SB(1, 0), cB + kstep, voffB); PG8_STAGE(PG8_SA(1, 0), cA + kstep, voffA); PG8_STAGE(PG8_SB(1, 1), cB + hstep + kstep, voffB);
        PG8_WAIT_V(6); PG8_BAR;
    }
    for (;;) {
        const bool has_next = S.next(ui + 1, nxt);
        const char* nA = has_next ? (const char*)g.A + (size_t)nxt.pm * tstep : cA; const char* nB = has_next ? (const char*)g.Bt + (size_t)nxt.pn * tstep : cB;
        for (int t = 0; t < nt; t += 2) {
            const bool last = (t == nt - 2);
            const char* a1 = cA + (size_t)(t + 1) * kstep;
            const char* a2 = last ? nA : cA + (size_t)(t + 2) * kstep; const char* b2 = last ? nB : cB + (size_t)(t + 2) * kstep;
            const char* a3 = a2 + kstep; const char* b3 = b2 + kstep;
            if (last && has_next) S.a_ready(nxt);
            if constexpr (SP2) {
            PG8_LDB(B0, 0, 0); PG8_LDB(B1, 0, 1); PG8_SCHED; PG8_LDA(At, 0, 0); PG8_STAGE(PG8_SA(1, 1), a1 + hstep, voffA);
            PG8_WAIT_V(8); PG8_WAIT_L(0); PG8_BAR; PG8_MMA(0, 0, At, B0); PG8_MMA(0, 1, At, B1); PG8_BAR; PG8_SCHED;
            PG8_LDA(At, 0, 1); PG8_STAGE(PG8_SB(0, 0), b2, voffB); PG8_STAGE(PG8_SB(0, 1), b2 + hstep, voffB); PG8_STAGE(PG8_SA(0, 0), a2, voffA);
            PG8_WAIT_V(8); PG8_WAIT_L(0); PG8_BAR; PG8_MMA(1, 0, At, B0); PG8_MMA(1, 1, At, B1); PG8_BAR; PG8_SCHED;
            PG8_LDB(B0, 1, 0); PG8_LDB(B1, 1, 1); PG8_SCHED; PG8_LDA(At, 1, 0); PG8_STAGE(PG8_SA(0, 1), a2 + hstep, voffA);
            PG8_WAIT_V(8); PG8_WAIT_L(0); PG8_BAR; PG8_MMA(0, 0, At, B0); PG8_MMA(0, 1, At, B1); PG8_BAR; PG8_SCHED;
            PG8_LDA(At, 1, 1); PG8_STAGE(PG8_SB(1, 0), b3, voffB); PG8_STAGE(PG8_SB(1, 1), b3 + hstep, voffB); PG8_STAGE(PG8_SA(1, 0), a3, voffA);
            PG8_WAIT_V(8); PG8_WAIT_L(0); PG8_BAR; PG8_MMA(1, 0, At, B0); PG8_MMA(1, 1, At, B1); PG8_BAR; PG8_SCHED;
            } else {
            PG8_LDB(B0, 0, 0); PG8_SCHED; PG8_LDA(At, 0, 0); PG8_STAGE(PG8_SA(1, 1), a1 + hstep, voffA);
            PG8_WAIT_L(8); PG8_BAR; PG8_WAIT_L(0); PG8_MMA(0, 0, At, B0); PG8_BAR; PG8_SCHED;
            PG8_LDB(B1, 0, 1); PG8_STAGE(PG8_SB(0, 0), b2, voffB);
            PG8_BAR; PG8_WAIT_L(0); PG8_MMA(0, 1, At, B1); PG8_BAR;
            PG8_LDA(At, 0, 1); PG8_STAGE(PG8_SA(0, 0), a2, voffA);
            PG8_BAR; PG8_WAIT_L(0); PG8_MMA(1, 0, At, B0); PG8_BAR; PG8_SCHED;
            PG8_STAGE(PG8_SB(0, 1), b2 + hstep, voffB);
            PG8_WAIT_V(6); PG8_BAR; PG8_MMA(1, 1, At, B1); PG8_BAR;
            PG8_LDB(B0, 1, 0); PG8_SCHED; PG8_LDA(At, 1, 0); PG8_STAGE(PG8_SA(0, 1), a2 + hstep, voffA);
            PG8_WAIT_L(8); PG8_BAR; PG8_WAIT_L(0); PG8_MMA(0, 0, At, B0); PG8_BAR; PG8_SCHED;
            PG8_LDB(B1, 1, 1); PG8_STAGE(PG8_SB(1, 0), b3, voffB);
            PG8_BAR; PG8_WAIT_L(0); PG8_MMA(0, 1, At, B1); PG8_BAR;
            PG8_LDA(At, 1, 1); PG8_STAGE(PG8_SA(1, 0), a3, voffA);
            PG8_BAR; PG8_WAIT_L(0); PG8_MMA(1, 0, At, B0); PG8_BAR; PG8_SCHED;
            PG8_STAGE(PG8_SB(1, 1), b3 + hstep, voffB);
            PG8_WAIT_V(6); PG8_BAR; PG8_MMA(1, 1, At, B1); PG8_BAR;
            }
        }
        if constexpr (ALIGN_EPI) { if (wr == 0) PG8_BAR; }
        E(acc, cur, wr, wc, fr, fq); if (REP_EPI > 1 && Epi::PERM) { asm volatile("" ::: "memory"); E(acc, cur, wr, wc, fr, fq); } S.done(cur);
        if (!has_next) break;
#pragma unroll
        for (int a = 0; a < 2; ++a)
#pragma unroll
            for (int b = 0; b < 2; ++b)
#pragma unroll
                for (int m = 0; m < 4; ++m)
#pragma unroll
                    for (int n = 0; n < 2; ++n) acc[a][b][m][n] = (f32x4){0.f, 0.f, 0.f, 0.f};
        cur = nxt; cA = nA; cB = nB; ++ui;
        if constexpr (ALIGN_EPI) { if (wr == 1) PG8_BAR; }
    }
    PG8_WAIT_V(0);
    if constexpr (!ALIGN_EPI) { if (wr == 0) PG8_BAR; }
    PG8_BAR;
#undef PG8_SA
#undef PG8_SB
#undef PG8_STAGE
#undef PG8_LDA
#undef PG8_LDB
#undef PG8_MMA
#undef PG8_WAIT_V
#undef PG8_WAIT_L
#undef PG8_BAR
#undef PG8_SCHED
}
}

struct EpiQKVZ {
    static constexpr bool PERM = true;
    h16_t *Q, *K, *V, *Z; float* kpart;
    __device__ __forceinline__ void operator()(const f32x4 (&acc)[2][2][4][2], const pg8::Unit& u, int wr, int wc, int fr, int fq) const {
        const int colt = u.pn * 256, sec = colt >> 11, cbase = colt & 2047;
        const int row0 = u.pm * 256 + wr * 64 + fr;
        h16_t* dst = sec == 0 ? Q : (sec == 1 ? K : (sec == 2 ? V : Z));
#pragma unroll
        for (int ai = 0; ai < 2; ++ai)
#pragma unroll
            for (int m = 0; m < 4; ++m) { const int r = row0 + ai * 128 + m * 16, b = r >> 11, s = r & 2047;
#pragma unroll
                for (int bj = 0; bj < 2; ++bj) { const f32x4 v0 = acc[ai][bj][m][0], v1 = acc[ai][bj][m][1];
                    u32x4 w; w.x = pk2(v0[0], v0[1]); w.y = pk2(v0[2], v0[3]); w.z = pk2(v1[0], v1[1]); w.w = pk2(v1[2], v1[3]);
                    const int c = cbase + bj * 128 + wc * 32 + 8 * fq;
                    h16_t* p = (sec == 3) ? dst + (size_t)r * E + c : dst + ((size_t)(b * NH + (c >> 7)) * S + s) * HD + (c & 127);
                    *(u32x4*)p = w; } }
        if (kpart != nullptr && sec == 1) {
            const int b = u.pm >> 3, nblk = u.pm & 7;
#pragma unroll
            for (int bj = 0; bj < 2; ++bj) { f32x4 s0 = {0.f, 0.f, 0.f, 0.f}, s1 = {0.f, 0.f, 0.f, 0.f};
#pragma unroll
                for (int ai = 0; ai < 2; ++ai)
#pragma unroll
                    for (int m = 0; m < 4; ++m) { s0 += acc[ai][bj][m][0]; s1 += acc[ai][bj][m][1]; }
#pragma unroll
                for (int e = 0; e < 4; ++e) { s0[e] += xsw<1>(s0[e]); s1[e] += xsw<1>(s1[e]); s0[e] += xsw<2>(s0[e]); s1[e] += xsw<2>(s1[e]);
                                              s0[e] += xsw<4>(s0[e]); s1[e] += xsw<4>(s1[e]); s0[e] += xsw<8>(s0[e]); s1[e] += xsw<8>(s1[e]); }
                if (fr == 0) { const int c = cbase + bj * 128 + wc * 32 + 8 * fq;
                    float* p = kpart + (size_t)wr * NB * NH * 8 * HD + ((size_t)(b * NH + (c >> 7)) * 8 + nblk) * HD + (c & 127);
                    *(f32x4*)p = s0; *(f32x4*)(p + 4) = s1; } }
        }
    }
};
struct EpiResid {
    static constexpr bool PERM = false;
    float* T; const float* x; const float* stats; const float* g; const float* bta; int layer;
    __device__ __forceinline__ void operator()(const f32x4 (&acc)[2][2][4][2], const pg8::Unit& u, int wr, int wc, int fr, int fq) const {
        const int col0 = u.pn * 256 + wc * 32 + 4 * fq, row0 = u.pm * 256 + wr * 64 + fr;
        f32x4 gv[2][2], bv[2][2];
        if (layer) {
#pragma unroll
            for (int bj = 0; bj < 2; ++bj)
#pragma unroll
                for (int n = 0; n < 2; ++n) { gv[bj][n] = *(const f32x4*)(g + col0 + bj * 128 + n * 16); bv[bj][n] = *(const f32x4*)(bta + col0 + bj * 128 + n * 16); } }
#pragma unroll
        for (int ai = 0; ai < 2; ++ai)
#pragma unroll
            for (int m = 0; m < 4; ++m) { const int r = row0 + ai * 128 + m * 16; float mean = 0.f, rstd = 1.f;
                if (layer) { const f32x2 st = *(const f32x2*)(stats + 2 * r); mean = st.x; rstd = st.y; }
#pragma unroll
                for (int bj = 0; bj < 2; ++bj)
#pragma unroll
                    for (int n = 0; n < 2; ++n) { const size_t idx = (size_t)r * D + col0 + bj * 128 + n * 16; f32x4 h;
                        if (layer) h = (*(const f32x4*)(T + idx) - mean) * rstd * gv[bj][n] + bv[bj][n]; else h = *(const f32x4*)(x + idx);
                        *(f32x4*)(T + idx) = DN_ALPHA * h + acc[ai][bj][m][n]; }
                asm volatile("" ::: "memory"); }
    }
};

struct Ctx { int tid, lane, wave, G, bid; unsigned char* lds; };

__device__ __forceinline__ void p0_transpose_item(const float* __restrict__ W, int ldw, int c0, int ncols, h16_t* __restrict__ WT, LAS float* scr, int item, int lane) {
    const int nblk = (ncols + 63) / 64, kb = item / nblk, nb = item % nblk, k0 = 64 * kb, n0 = 64 * nb;
    const int r = lane >> 4, cq = (lane & 15) * 4; const bool nok = n0 + cq < ncols;
    const float* src = W + (size_t)(k0 + r) * ldw + c0 + n0 + cq;
    f32x4 v[16];
#pragma unroll
    for (int i = 0; i < 16; ++i) v[i] = nok ? *(const f32x4*)(src + (size_t)(4 * i) * ldw) : (f32x4){0.f, 0.f, 0.f, 0.f};
#pragma unroll
    for (int i = 0; i < 16; ++i) { LAS float* d = scr + (4 * i + r) * 65 + cq; d[0] = v[i][0]; d[1] = v[i][1]; d[2] = v[i][2]; d[3] = v[i][3]; }
    asm volatile("s_waitcnt lgkmcnt(0)" ::: "memory");
    const int cc = lane & 7;
#pragma unroll
    for (int j = 0; j < 8; ++j) { const int n = (lane >> 3) + 8 * j; const LAS float* s = scr + (8 * cc) * 65 + n;
        u32x4 o; o.x = pk2(s[0 * 65], s[1 * 65]); o.y = pk2(s[2 * 65], s[3 * 65]); o.z = pk2(s[4 * 65], s[5 * 65]); o.w = pk2(s[6 * 65], s[7 * 65]);
        if (n0 + n < ncols) *(u32x4*)(WT + (size_t)(n0 + n) * D + k0 + 8 * cc) = o; }
    asm volatile("s_waitcnt lgkmcnt(0)" ::: "memory");
}
__device__ __forceinline__ void transpose_phase(const Ctx& c, const float* __restrict__ W, int ldw, int c0, int ncols, h16_t* __restrict__ WT) {
    float (*tile)[65] = (float (*)[65])(c.lds + (c.tid >> 8) * (64 * 65 * 4));
    const int nb = (ncols + 63) / 64, ntiles = (D / 64) * nb, t2 = c.tid & 255, tx = t2 & 63, ty = t2 >> 6;
    for (int it = c.bid * 2; it < ntiles; it += c.G * 2) {
        const int tl = it + (c.tid >> 8); const bool act = tl < ntiles;
        const int kb = tl / nb, cb = tl % nb, k0 = kb * 64, n0 = cb * 64;
        if (act) for (int i = ty; i < 64; i += 4) { const int n = n0 + tx; tile[i][tx] = (n < ncols) ? W[(size_t)(k0 + i) * ldw + c0 + n] : 0.f; }
        __syncthreads();
        if (act) for (int i = ty; i < 64; i += 4) { const int n = n0 + i; if (n < ncols) WT[(size_t)n * D + k0 + tx] = f2h(tile[tx][i]); }
        __syncthreads();
    }
}
__device__ __forceinline__ void cvt_phase(const Ctx& c, const float* __restrict__ x, h16_t* __restrict__ o, size_t n) {
    const size_t stride = (size_t)c.G * NTHREADS * 4;
    for (size_t i = ((size_t)c.bid * NTHREADS + c.tid) * 4; i < n; i += 8 * stride) { f32x4 v[8];
#pragma unroll
        for (int j = 0; j < 8; ++j) v[j] = *(const f32x4*)(x + i + j * stride);
#pragma unroll
        for (int j = 0; j < 8; ++j) *(uint2*)(o + i + j * stride) = make_uint2(pk2(v[j].x, v[j].y), pk2(v[j].z, v[j].w)); }
}
__device__ __forceinline__ float wave_sum(float v) { return xadd32(hsum32(v)); }
__device__ __forceinline__ void ln_phase(const Ctx& c, float* T, const float* __restrict__ g, const float* __restrict__ bta, float* stats, h16_t* HB, bool final_layer) {
    const int gw = c.bid * NWAVES + c.wave, NGW = c.G * NWAVES;
    for (int m = gw; m < M; m += NGW) {
        float* row = T + (size_t)m * D; f32x4 v[8]; float s = 0.f;
#pragma unroll
        for (int j = 0; j < 8; ++j) { v[j] = *(const f32x4*)(row + (64 * j + c.lane) * 4); s += (v[j].x + v[j].y) + (v[j].z + v[j].w); }
        const float mean = wave_sum(s) * (1.f / D); float q = 0.f;
#pragma unroll
        for (int j = 0; j < 8; ++j) { v[j] = v[j] - mean; q += (v[j].x * v[j].x + v[j].y * v[j].y) + (v[j].z * v[j].z + v[j].w * v[j].w); }
        const float rstd = rsqrtf(wave_sum(q) * (1.f / D) + LN_EPS);
        if (c.lane == 0) { stats[2 * m] = mean; stats[2 * m + 1] = rstd; }
#pragma unroll
        for (int j = 0; j < 8; ++j) { const int col = (64 * j + c.lane) * 4; const f32x4 o = v[j] * rstd * *(const f32x4*)(g + col) + *(const f32x4*)(bta + col);
            if (final_layer) *(f32x4*)(row + col) = o; else *(uint2*)(HB + (size_t)m * D + col) = make_uint2(pk2(o.x, o.y), pk2(o.z, o.w)); }
    }
}
__device__ __forceinline__ void logf_phase(const Ctx& c, const h16_t* __restrict__ HB, const h16_t* __restrict__ WfT, const float* __restrict__ bf, float* logf) {
    for (int rb = c.bid; rb < M / 32; rb += c.G) {
        const int m = rb * 32 + (c.tid >> 4), j = c.tid & 15;
        const h16_t* a = HB + (size_t)m * D; const h16_t* w = WfT + (size_t)j * D; float s = 0.f;
        for (int k = 0; k < D; k += 8) { const u32x4 av = *(const u32x4*)(a + k), wv = *(const u32x4*)(w + k);
#pragma unroll
            for (int e = 0; e < 4; ++e) { s = fmaf(lo16(av[e]), lo16(wv[e]), s); s = fmaf(hi16(av[e]), hi16(wv[e]), s); } }
        const float xx = s + bf[j];
        logf[(size_t)m * 16 + j] = fminf(xx, 0.f) - log1pf(__expf(-fabsf(xx)));
    }
}
__device__ __forceinline__ void cum_phase(const Ctx& c, const float* __restrict__ logf, float* cum) {
    float* wtot = (float*)c.lds;
    for (int bh = c.bid; bh < NB * NH; bh += c.G) {
        const int b = bh / NH, h = bh % NH; float v[4];
#pragma unroll
        for (int e = 0; e < 4; ++e) v[e] = logf[(size_t)(b * S + 4 * c.tid + e) * NH + h];
        v[1] += v[0]; v[2] += v[1]; v[3] += v[2];
        float incl = v[3];
#pragma unroll
        for (int o = 1; o < 64; o <<= 1) { const float t = __int_as_float(__builtin_amdgcn_ds_bpermute(((c.lane - o) & 63) << 2, __float_as_int(incl))); if (c.lane >= o) incl += t; }
        if (c.lane == 63) wtot[c.wave] = incl;
        __syncthreads();
        float off = incl - v[3];
        for (int w = 0; w < c.wave; ++w) off += wtot[w];
        f32x4 o4 = {v[0] + off, v[1] + off, v[2] + off, v[3] + off};
        *(f32x4*)(cum + (size_t)bh * S + 4 * c.tid) = o4;
        __syncthreads();
    }
}

#ifndef FAST0
#define FAST0 1
#endif
#ifndef FAST1
#define FAST1 1
#endif
#ifndef FAST2
#define FAST2 1
#endif
constexpr int SC_LD = 2064;
struct AttnArgs { const h16_t *Qb, *Kb, *Vb, *Zb; h16_t* G; const float *rel, *kpart, *cum, *logf, *lq1, *lk1, *lq2, *lk2, *subg; float lam_init; };
template <int MODE>
__device__ __forceinline__ void attn_naive_phase(const Ctx& c, const AttnArgs& A) {
    float* sc = (float*)c.lds; float* qs = sc + 16 * SC_LD; float* misc = qs + 16 * 128;
    const int tid = c.tid; const bool act = tid < 256; const int row = (tid >> 4) & 15, sub = tid & 15;
    constexpr int QPB = MODE == 0 ? 8 : 16, NHB = MODE == 0 ? 8 : 16;
    const int nqt = S / QPB, nvb = NB * NHB * nqt;
    for (int vb = c.bid; vb < nvb; vb += c.G) {
        const int qt = vb % nqt, hh = (vb / nqt) % NHB, b = vb / (nqt * NHB);
        const int t0 = qt * QPB, nkeys = t0 + QPB;
        const int qi = MODE == 0 ? (row & 7) : row, comp = MODE == 0 ? (row >> 3) : 0;
        const int hq = MODE == 0 ? 2 * hh + comp : hh;
        const int t = t0 + qi;
        if (act) for (int i = tid; i < 16 * 128; i += 256) { const int r = i >> 7, d = i & 127; const int rq = MODE == 0 ? (r & 7) : r, rh = MODE == 0 ? 2 * hh + (r >> 3) : hh;
            qs[i] = h2f(A.Qb[((size_t)(b * NH + rh) * S + t0 + rq) * HD + d]); }
        float lam = 0.f;
        if (MODE == 0) { if (tid < 64) { float a = A.lq1[tid] * A.lk1[tid] + A.lq1[tid + 64] * A.lk1[tid + 64], cc = A.lq2[tid] * A.lk2[tid] + A.lq2[tid + 64] * A.lk2[tid + 64];
                for (int o = 32; o; o >>= 1) { a += __shfl_xor(a, o); cc += __shfl_xor(cc, o); }
                if (tid == 0) misc[0] = __expf(a) - __expf(cc) + A.lam_init; } }
        __syncthreads();
        if (MODE == 0) lam = misc[0];
        unsigned selbits = 0u; const int own = t0 >> 8;
        if (MODE == 1) {
            if (tid < 16) { float gate[8]; unsigned sb = 0u;
#pragma unroll
                for (int n = 0; n < 8; ++n) { float gsum = 0.f;
                    if (n < own) { const float* k0 = A.kpart + (size_t)((b * NH + hh) * 8 + n) * HD; const float* k1 = k0 + (size_t)NB * NH * 8 * HD;
                        for (int d = 0; d < 128; ++d) gsum = fmaf(qs[tid * 128 + d], (k0[d] + k1[d]) * (1.f / 256.f), gsum); }
                    gate[n] = n < own ? gsum : NEGF; }
#pragma unroll
                for (int k = 0; k < 3; ++k) { int best = -1; float bv = 0.f;
#pragma unroll
                    for (int n = 0; n < 8; ++n) if (!((sb >> n) & 1u) && (best < 0 || gate[n] > bv)) { best = n; bv = gate[n]; }
                    sb |= 1u << best; }
                misc[16 + tid] = __uint_as_float(sb & ((1u << own) - 1u)); }
            __syncthreads();
            selbits = __float_as_uint(misc[16 + row]);
        }
        if (act) {
            const float cq = MODE == 2 ? A.cum[(size_t)(b * NH + hh) * S + t] : 0.f;
            for (int s = sub; s < nkeys; s += 16) {
                const h16_t* kr = A.Kb + ((size_t)(b * NH + hq) * S + s) * HD; float dot = 0.f;
                for (int d = 0; d < 128; d += 8) { const u32x4 kv = *(const u32x4*)(kr + d); const float* qq = qs + row * 128 + d;
#pragma unroll
                    for (int j = 0; j < 4; ++j) { dot = fmaf(qq[2 * j], lo16(kv[j]), dot); dot = fmaf(qq[2 * j + 1], hi16(kv[j]), dot); } }
                float lg = dot * SCALE; bool ok = s <= t;
                if (MODE == 0 || MODE == 1) lg += A.rel[t5_bucket(t - s > 0 ? t - s : 0) * 16 + hq];
                if (MODE == 1) { const int blk = s >> 8; if (blk != own) ok = (selbits >> blk) & 1u; }
                if (MODE == 2) lg += cq - A.cum[(size_t)(b * NH + hh) * S + s];
                sc[row * SC_LD + s] = ok ? lg : NEGF;
            }
        }
        __syncthreads();
        if (act) {
            float mx = NEGF;
            for (int s = sub; s < nkeys; s += 16) mx = fmaxf(mx, sc[row * SC_LD + s]);
            for (int o = 8; o; o >>= 1) mx = fmaxf(mx, __shfl_xor(mx, o));
            float sum = 0.f;
            for (int s = sub; s < nkeys; s += 16) { const float p = __expf(sc[row * SC_LD + s] - mx); sc[row * SC_LD + s] = p; sum += p; }
            for (int o = 8; o; o >>= 1) sum += __shfl_xor(sum, o);
            const float inv = 1.f / sum;
            for (int s = sub; s < nkeys; s += 16) sc[row * SC_LD + s] *= inv;
        }
        __syncthreads();
        if (act) {
            if (MODE == 0) {
                const int q2 = tid >> 5, dl = tid & 31, d0 = dl * 8;
                const int vh = 2 * hh + (d0 >> 7), dd = d0 & 127;
                float o[8];
#pragma unroll
                for (int j = 0; j < 8; ++j) o[j] = 0.f;
                for (int s = 0; s < nkeys; ++s) { const float a = sc[q2 * SC_LD + s] - lam * sc[(8 + q2) * SC_LD + s];
                    const u32x4 vv = *(const u32x4*)(A.Vb + ((size_t)(b * NH + vh) * S + s) * HD + dd);
#pragma unroll
                    for (int j = 0; j < 4; ++j) { o[2 * j] = fmaf(a, lo16(vv[j]), o[2 * j]); o[2 * j + 1] = fmaf(a, hi16(vv[j]), o[2 * j + 1]); } }
                float ss = 0.f;
#pragma unroll
                for (int j = 0; j < 8; ++j) ss += o[j] * o[j];
                for (int off = 16; off; off >>= 1) ss += __shfl_xor(ss, off);
                const float r = rsqrtf(ss * (1.f / 256.f) + RMS_EPS) * (1.f - A.lam_init);
                const size_t gi = (size_t)(b * S + t0 + q2) * E + hh * 256 + d0;
                const u32x4 zv = *(const u32x4*)(A.Zb + gi); u32x4 ov;
#pragma unroll
                for (int j = 0; j < 4; ++j) { const float a0 = o[2 * j] * r * A.subg[d0 + 2 * j] * siluf(lo16(zv[j])), a1 = o[2 * j + 1] * r * A.subg[d0 + 2 * j + 1] * siluf(hi16(zv[j]));
                    ov[j] = pk2(a0, a1); }
                *(u32x4*)(A.G + gi) = ov;
            } else {
                const int d0 = sub * 8; float o[8];
#pragma unroll
                for (int j = 0; j < 8; ++j) o[j] = 0.f;
                for (int s = 0; s < nkeys; ++s) { const float a = sc[row * SC_LD + s];
                    const u32x4 vv = *(const u32x4*)(A.Vb + ((size_t)(b * NH + hh) * S + s) * HD + d0);
#pragma unroll
                    for (int j = 0; j < 4; ++j) { o[2 * j] = fmaf(a, lo16(vv[j]), o[2 * j]); o[2 * j + 1] = fmaf(a, hi16(vv[j]), o[2 * j + 1]); } }
                const size_t gi = (size_t)(b * S + t) * E + hh * 128 + d0;
                const u32x4 zv = *(const u32x4*)(A.Zb + gi); u32x4 ov;
#pragma unroll
                for (int j = 0; j < 4; ++j) ov[j] = pk2(o[2 * j] * siluf(lo16(zv[j])), o[2 * j + 1] * siluf(hi16(zv[j])));
                *(u32x4*)(A.G + gi) = ov;
            }
        }
        __syncthreads();
    }
}

namespace att {
typedef short s16x4 __attribute__((ext_vector_type(4)));
typedef float f32x16 __attribute__((ext_vector_type(16)));
constexpr int QBLK = 32, KVBLK = 64, SHM = KVBLK * HD * 2;
constexpr float THR = 8.f;
constexpr int L_V = 0, L_K = 2 * SHM;
#define KSWZ(row, colB) ((row) * 256 + ((colB) ^ (((row) & 15) << 4)))
#define SBAR() __builtin_amdgcn_sched_barrier(0)
__device__ __forceinline__ int v_st(int k, int c) { const int kk = (k & ~0xC) | ((k & 4) << 1) | ((k & 8) >> 1); return ((kk >> 3) * 4 + (c >> 5)) * 512 + ((kk & 7) * 32 + (c & 31)) * 2; }
__device__ __forceinline__ int v_rd_base(int lane) { return ((lane & 3) << 3) | (((lane >> 2) & 3) << 6) | (((lane >> 4) & 1) << 5) | (((lane >> 5) & 1) << 8); }
constexpr int v_rd_off(int d0, int ks, int half) { return d0 * 512 + ks * 4096 + half * 2048; }
__device__ __forceinline__ int crow(int r, int hi) { return (r & 3) + 8 * (r >> 2) + 4 * hi; }
__device__ __forceinline__ f16x8 ld8(const h16_t* p) { return *reinterpret_cast<const f16x8*>(p); }

template <int NCOMP> struct Lay {
    static constexpr int WS = L_K + 2 * NCOMP * SHM;
    static constexpr int OST = WS + NWAVES * 512;
    static constexpr int TAB = OST + (NCOMP == 1 ? 8 : 4) * 8192;
    static constexpr int MISC = TAB, LUT = TAB + 256, BIG = LUT + 2 * 352 * 4, END = BIG + 8192;
};
static_assert(Lay<1>::END <= XB_LDS_OFF && Lay<2>::END <= XB_LDS_OFF, "attention LDS map");

__device__ __forceinline__ void mask_tile(f32x16& p0, f32x16& p1, int dq) {
    const float NEG = -__builtin_inff();
#pragma unroll
    for (int r = 0; r < 16; ++r) { const int cc = (r & 3) + 8 * (r >> 2); if (dq - cc < 0) p0[r] = NEG; if (dq - cc - 32 < 0) p1[r] = NEG; }
}
__device__ __forceinline__ void bias_mask_tile(f32x16& p0, f32x16& p1, int dq, const float* lut) {
    const float NEG = -__builtin_inff(); const float* lp = lut + (dq + 128 - 63);
    float b0[16], b1[16];
#pragma unroll
    for (int r = 0; r < 16; ++r) { const int cc = (r & 3) + 8 * (r >> 2); b0[r] = lp[63 - cc]; b1[r] = lp[63 - cc - 32]; }
#pragma unroll
    for (int r = 0; r < 16; ++r) { const int cc = (r & 3) + 8 * (r >> 2); p0[r] = (dq - cc < 0) ? NEG : p0[r] + b0[r]; p1[r] = (dq - cc - 32 < 0) ? NEG : p1[r] + b1[r]; }
}
#define PK4(P, B_, OUT) do { unsigned a0 = pk2(P[B_+0], P[B_+1]), a1 = pk2(P[B_+2], P[B_+3]);                          \
        unsigned b0 = pk2(P[B_+4], P[B_+5]), b1 = pk2(P[B_+6], P[B_+7]);                                             \
        auto r0 = __builtin_amdgcn_permlane32_swap(a0, b0, false, false); auto r1 = __builtin_amdgcn_permlane32_swap(a1, b1, false, false); \
        u32x4 w = {r0[0], r1[0], r0[1], r1[1]}; OUT = __builtin_bit_cast(f16x8, w); } while (0)
__device__ __forceinline__ void partialSM(f32x16& p0, f32x16& p1, float& m_reg, float& alpha, float& ps0, f16x8& pa0, f16x8& pa1) {
    float pmax = p0[0];
#pragma unroll
    for (int r = 1; r < 16; ++r) pmax = fmaxf(pmax, p0[r]);
#pragma unroll
    for (int r = 0; r < 16; ++r) pmax = fmaxf(pmax, p1[r]);
    { auto rr = __builtin_amdgcn_permlane32_swap(__float_as_uint(pmax), __float_as_uint(pmax), false, false);
      pmax = fmaxf(__uint_as_float(rr[0]), __uint_as_float(rr[1])); }
    constexpr float C2 = 1.4426950408889634f * SCALE;
    float mn;
    if (__builtin_expect(__all((pmax - m_reg) * SCALE <= THR), 1)) { mn = m_reg; alpha = 1.f; }
    else { mn = fmaxf(m_reg, pmax); alpha = __builtin_amdgcn_exp2f((m_reg - mn) * C2); m_reg = mn; }
    const float mnL = -mn * C2;
#pragma unroll
    for (int r = 0; r < 16; ++r) p0[r] = fmaf(p0[r], C2, mnL);
#pragma unroll
    for (int r = 0; r < 16; ++r) p1[r] = fmaf(p1[r], C2, mnL);
#pragma unroll
    for (int r = 0; r < 16; ++r) p0[r] = __builtin_amdgcn_exp2f(p0[r]);
    float ps = 0;
#pragma unroll
    for (int r = 0; r < 16; ++r) ps += p0[r];
    ps0 = ps;
    PK4(p0, 0, pa0); PK4(p0, 8, pa1);
}
__device__ __forceinline__ void finishSM(f32x16& p1, float alpha, float ps0, float& l_reg, f16x8& pa2, f16x8& pa3) {
#pragma unroll
    for (int r = 0; r < 16; ++r) p1[r] = __builtin_amdgcn_exp2f(p1[r]);
    float ps = ps0;
#pragma unroll
    for (int r = 0; r < 16; ++r) ps += p1[r];
    { auto rr = __builtin_amdgcn_permlane32_swap(__float_as_uint(ps), __float_as_uint(ps), false, false);
      ps = __uint_as_float(rr[0]) + __uint_as_float(rr[1]); }
    l_reg = l_reg * alpha + ps;
    PK4(p1, 0, pa2); PK4(p1, 8, pa3);
}
#undef PK4
template <int KB, int NCOMP>
__device__ __forceinline__ void qkt(f32x16& p0, f32x16& p1, const char* Kc_lds, int kswz0, const f16x8* qr) {
    int kb_ = kswz0; asm volatile("" : "+v"(kb_));
    if (ATT_PRIO) __builtin_amdgcn_s_setprio(1);
#pragma unroll
    for (int d0 = 0; d0 < 8; ++d0) { const char* a = Kc_lds + KB * (NCOMP * SHM) + (kb_ ^ (d0 << 5));
        const f16x8 b0 = *reinterpret_cast<const f16x8*>(a);
        const f16x8 b1 = *reinterpret_cast<const f16x8*>(a + 32 * 256);
        p0 = __builtin_amdgcn_mfma_f32_32x32x16_f16(b0, qr[d0], p0, 0, 0, 0);
        p1 = __builtin_amdgcn_mfma_f32_32x32x16_f16(b1, qr[d0], p1, 0, 0, 0); }
    if (ATT_PRIO) __builtin_amdgcn_s_setprio(0);
}
template <int VB>
__device__ __forceinline__ void pv_tile(f32x16* o, int vb0, f16x8 pa0, f16x8 pa1, f16x8 pa2, f16x8 pa3) {
#define TRRD(dst, off) asm volatile("ds_read_b64_tr_b16 %0, %1 offset:%2" : "=&v"(dst) : "v"(vb0), "i"(off) : "memory")
#define PKV(l, h) __builtin_bit_cast(f16x8, (short __attribute__((ext_vector_type(8)))){l[0], l[1], l[2], l[3], h[0], h[1], h[2], h[3]})
#define PV_D0(d0) do { s16x4 l0, l1, l2, l3, h0, h1, h2, h3; constexpr int b_ = L_V + VB * SHM + v_rd_off(d0, 0, 0); \
        TRRD(l0, b_); TRRD(h0, b_ + 2048); TRRD(l1, b_ + 4096); TRRD(h1, b_ + 6144); TRRD(l2, b_ + 8192); TRRD(h2, b_ + 10240); TRRD(l3, b_ + 12288); TRRD(h3, b_ + 14336); \
        asm volatile("s_waitcnt lgkmcnt(0)" ::: "memory"); SBAR(); if (ATT_PRIO) __builtin_amdgcn_s_setprio(1);  \
        o[d0] = __builtin_amdgcn_mfma_f32_32x32x16_f16(pa0, PKV(l0, h0), o[d0], 0, 0, 0);   \
        o[d0] = __builtin_amdgcn_mfma_f32_32x32x16_f16(pa1, PKV(l1, h1), o[d0], 0, 0, 0);   \
        o[d0] = __builtin_amdgcn_mfma_f32_32x32x16_f16(pa2, PKV(l2, h2), o[d0], 0, 0, 0);   \
        o[d0] = __builtin_amdgcn_mfma_f32_32x32x16_f16(pa3, PKV(l3, h3), o[d0], 0, 0, 0); if (ATT_PRIO) __builtin_amdgcn_s_setprio(0); } while (0)
    PV_D0(0); PV_D0(1); PV_D0(2); PV_D0(3);
#undef PV_D0
#undef PKV
#undef TRRD
}

struct BlockRef { unsigned qoff, koff, voff; int P0; int b, h, half, x; };
template <int NCOMP> struct Seam { f16x8 qr[8]; };
struct BlkCtx { unsigned selbits; int own; };
struct EpiArgs { const h16_t* Zb; h16_t* G; const float* subg; float lam_init; };

constexpr size_t HSTR = (size_t)S * HD;
#define ROW(p, k0, rr) ((p) + (size_t)((k0) + (rr)) * HD + sc)
#define VMW() asm volatile("s_waitcnt vmcnt(0)" ::: "memory")
#define VMWN(n) asm volatile("s_waitcnt vmcnt(%0)" :: "i"(n) : "memory")

__device__ __forceinline__ f16x8 ldg8(const void* ubase, unsigned off) { return *reinterpret_cast<const f16x8*>((const char*)ubase + off); }
__device__ __forceinline__ void glds16(const void* ubase, unsigned voff, unsigned lds_dst) { unsigned keep;
    asm volatile("s_mov_b32 %0, m0\n\ts_mov_b32 m0, %3\n\ts_nop 0\n\tglobal_load_lds_dwordx4 %1, %2\n\ts_mov_b32 m0, %0" : "=&s"(keep) : "v"(voff), "s"(ubase), "s"(lds_dst) : "memory"); }
__device__ __forceinline__ unsigned dma_offk(int wid, int lane) { const int row = 4 * wid + (lane >> 4), chunk = (lane & 15) ^ (row & 15); return (unsigned)(row * 256 + chunk * 16); }
__device__ __forceinline__ unsigned dma_offv(int wid, int lane) { const int kk = (wid >> 1) * 8 + ((lane & 31) >> 2), cc = ((2 * (wid & 1) + (lane >> 5)) & 3) * 32 + (lane & 3) * 8;
    const int kx = (kk & ~0xC) | ((kk & 4) << 1) | ((kk & 8) >> 1); return (unsigned)(kx * 256 + cc * 2); }
template <int NCOMP>
__device__ __forceinline__ void dma_k(const h16_t* Kp, int k0, unsigned offk, unsigned lds_base, int bf, int wid) {
    const char* kb_ = (const char*)Kp + (size_t)k0 * (HD * 2);
#pragma unroll
    for (int cc = 0; cc < NCOMP; ++cc)
#pragma unroll
        for (int hf = 0; hf < 2; ++hf) glds16(kb_ + cc * (HSTR * 2) + hf * 8192, offk, (unsigned)__builtin_amdgcn_readfirstlane((int)(lds_base + L_K + (bf * NCOMP + cc) * SHM + wid * 1024 + hf * 8192)));
}
__device__ __forceinline__ void dma_v(const h16_t* Vp, int k0, unsigned offv, unsigned lds_base, int bf, int wid) {
    const char* vb_ = (const char*)Vp + (size_t)k0 * (HD * 2);
#pragma unroll
    for (int hf = 0; hf < 2; ++hf) glds16(vb_ + hf * 8192, offv, (unsigned)__builtin_amdgcn_readfirstlane((int)(lds_base + L_V + bf * SHM + wid * 1024 + hf * 8192)));
}
template <int NCOMP>
__device__ __forceinline__ void att_prime(const BlockRef& cur, const h16_t* Qb, const h16_t* Kb, const h16_t* Vb, char* lds, Seam<NCOMP>& S_, int tid) {
    const int wid = __builtin_amdgcn_readfirstlane(tid >> 6), lane = tid & 63, r32 = lane & 31, hi = lane >> 5;
    const int comp = NCOMP == 2 ? (wid >> 2) : 0, wq = NCOMP == 2 ? (wid & 3) : wid;
    const unsigned lds_base = (unsigned)(uintptr_t)lds;
    dma_k<NCOMP>(Kb + cur.koff, 0, dma_offk(wid, lane), lds_base, 0, wid); dma_v(Vb + cur.voff, 0, dma_offv(wid, lane), lds_base, 0, wid);
    { const char* qb_ = (const char*)(Qb + cur.qoff + comp * HSTR + (size_t)(wq * QBLK) * HD); const unsigned qo_ = (unsigned)(r32 * HD + hi * 8) * 2u;
#pragma unroll
      for (int d0 = 0; d0 < 8; ++d0) S_.qr[d0] = ldg8(qb_ + d0 * 32, qo_); }
    VMW();
    __syncthreads();
}

template <int MODE>
__device__ __forceinline__ void epilogue_part(const BlockRef& cur, char* lds, f32x16 (&o)[4], float l_reg, const EpiArgs& ea, int tid_in) {
    constexpr int NCOMP = MODE == 0 ? 2 : 1;
    typedef Lay<NCOMP> L;
    int tid = tid_in; asm volatile("" : "+v"(tid));
    const int wid = __builtin_amdgcn_readfirstlane(tid >> 6), lane = tid & 63, r32 = lane & 31, hi = lane >> 5;
    const int comp = NCOMP == 2 ? (wid >> 2) : 0, wq = NCOMP == 2 ? (wid & 3) : wid;
    float* ws = (float*)(lds + L::WS) + wid * 128; float* li_l = ws;
    const size_t gbase = ((size_t)(cur.b * S + cur.P0 + wq * QBLK) * E + cur.h * (MODE == 0 ? 256 : HD)) * 2;
    const unsigned go_ = (unsigned)((lane >> 4) * E + (lane & 15) * 8) * 2u;
    constexpr int NPF = MODE == 0 ? 4 : 8;
    u32x4 zv0[NPF], zv1[NPF], u0v[NPF];
#define EPI_LOADS(i0_) do { _Pragma("unroll") for (int i = 0; i < NPF; ++i) { const size_t gi_ = gbase + (size_t)(i + (i0_)) * (4 * E * 2) + go_; zv0[i] = *(const u32x4*)((const char*)ea.Zb + gi_); \
            if (MODE == 0) { zv1[i] = *(const u32x4*)((const char*)ea.Zb + gi_ + 256); u0v[i] = *(const u32x4*)((const char*)ea.G + gi_); } } } while (0)
    if (MODE != 0 || (comp == 0 && cur.half == 1)) EPI_LOADS(0);
    if (hi == 0) li_l[r32] = l_reg; asm volatile("s_waitcnt lgkmcnt(0)" ::: "memory");
    float rli[16];
#pragma unroll
    for (int r = 0; r < 16; ++r) rli[r] = __builtin_amdgcn_rcpf(li_l[crow(r, hi)]);
    if (MODE != 0) {
        h16_t* stg = (h16_t*)(lds + L::OST) + wid * 4096;
#pragma unroll
        for (int r = 0; r < 16; ++r) { const int orow = crow(r, hi);
#pragma unroll
            for (int d0 = 0; d0 < 4; ++d0) stg[orow * 128 + d0 * 32 + r32] = f2h(o[d0][r] * rli[r]); }
        asm volatile("s_waitcnt lgkmcnt(0)" ::: "memory");
#pragma unroll
        for (int i = 0; i < 8; ++i) { const int row = i * 4 + (lane >> 4), ch = lane & 15;
            const u32x4 ov = *(const u32x4*)(stg + row * 128 + ch * 8);
            const u32x4 zv = zv0[i]; u32x4 w;
#pragma unroll
            for (int e = 0; e < 4; ++e) w[e] = pk2(lo16(ov[e]) * siluf(lo16(zv[e])), hi16(ov[e]) * siluf(hi16(zv[e])));
            *(u32x4*)((char*)ea.G + gbase + (size_t)i * (4 * E * 2) + go_) = w; SBAR(); }
#undef EPI_LOADS_DUMMY
    } else {
        unsigned* xch = (unsigned*)(lds + L::OST) + wq * 2048;
        if (comp == 1) { const float lam_ = ((const float*)(lds + L::MISC))[0];
#pragma unroll
            for (int d0 = 0; d0 < 4; ++d0)
#pragma unroll
                for (int r = 0; r < 16; r += 2) xch[(d0 * 8 + (r >> 1)) * 64 + lane] = pk2(o[d0][r] * rli[r] * lam_, o[d0][r + 1] * rli[r + 1] * lam_);
        }
        asm volatile("s_waitcnt lgkmcnt(0)" ::: "memory");
        __syncthreads();
        if (comp == 0) {
            float ssq[16];
#pragma unroll
            for (int r = 0; r < 16; ++r) ssq[r] = 0.f;
#pragma unroll
            for (int d0 = 0; d0 < 4; ++d0)
#pragma unroll
                for (int r = 0; r < 16; r += 2) { const unsigned w = xch[(d0 * 8 + (r >> 1)) * 64 + lane];
                    o[d0][r] = o[d0][r] * rli[r] - lo16(w); o[d0][r + 1] = o[d0][r + 1] * rli[r + 1] - hi16(w);
                    ssq[r] += o[d0][r] * o[d0][r]; ssq[r + 1] += o[d0][r + 1] * o[d0][r + 1]; }
#pragma unroll
            for (int r = 0; r < 16; ++r) ssq[r] = hsum32(ssq[r]);
            float* ssq_l = ws + 64;
            asm volatile("s_waitcnt lgkmcnt(0)" ::: "memory");
            h16_t* stg = (h16_t*)xch;
#pragma unroll
            for (int r = 0; r < 16; ++r) { const int orow = crow(r, hi);
#pragma unroll
                for (int d0 = 0; d0 < 4; ++d0) stg[orow * 128 + d0 * 32 + r32] = f2h(o[d0][r]); }
            if (cur.half == 0) {
                if (r32 == 0) {
#pragma unroll
                    for (int r = 0; r < 16; ++r) ssq_l[crow(r, hi)] = ssq[r]; }
                asm volatile("s_waitcnt lgkmcnt(0)" ::: "memory");
#pragma unroll
                for (int i = 0; i < 8; ++i) { const int row = i * 4 + (lane >> 4), ch = lane & 15;
                    *(u32x4*)((char*)ea.G + gbase + (size_t)i * (4 * E * 2) + go_) = *(const u32x4*)(stg + row * 128 + ch * 8); }
            } else {
                if (r32 == 0) {
#pragma unroll
                    for (int r = 0; r < 16; ++r) { const int orow = crow(r, hi); ssq_l[orow] = rsqrtf((ssq_l[orow] + ssq[r]) * (1.f / 256.f) + RMS_EPS) * (1.f - ea.lam_init); } }
                asm volatile("s_waitcnt lgkmcnt(0)" ::: "memory");
                const int chg = lane & 15;
                const f32x4 ga = *(const f32x4*)(ea.subg + chg * 8), gb = *(const f32x4*)(ea.subg + chg * 8 + 4), gc = *(const f32x4*)(ea.subg + 128 + chg * 8), gd = *(const f32x4*)(ea.subg + 128 + chg * 8 + 4);
                const float g0v[8] = {ga[0], ga[1], ga[2], ga[3], gb[0], gb[1], gb[2], gb[3]}, g1v[8] = {gc[0], gc[1], gc[2], gc[3], gd[0], gd[1], gd[2], gd[3]};
#pragma unroll
                for (int i = 0; i < 8; ++i) { const int row = i * 4 + (lane >> 4), ch = lane & 15; const float rs = ssq_l[row];
                    if (i == 4) { SBAR(); EPI_LOADS(4); }
                    const size_t g0 = gbase + (size_t)i * (4 * E * 2), g1 = g0 + 256;
                    const u32x4 u1 = *(const u32x4*)(stg + row * 128 + ch * 8), u0 = u0v[i & 3];
                    const u32x4 z0 = zv0[i & 3], z1 = zv1[i & 3];
                    u32x4 w0, w1;
#pragma unroll
                    for (int e = 0; e < 4; ++e) {
                        w0[e] = pk2(lo16(u0[e]) * rs * g0v[2 * e] * siluf(lo16(z0[e])), hi16(u0[e]) * rs * g0v[2 * e + 1] * siluf(hi16(z0[e])));
                        w1[e] = pk2(lo16(u1[e]) * rs * g1v[2 * e] * siluf(lo16(z1[e])), hi16(u1[e]) * rs * g1v[2 * e + 1] * siluf(hi16(z1[e]))); }
                    *(u32x4*)((char*)ea.G + g0 + go_) = w0; *(u32x4*)((char*)ea.G + g1 + go_) = w1; SBAR(); }
            }
        }
    }
}

template <int MODE>
__device__ __forceinline__ void att_block(const BlockRef& cur, const BlockRef& nxt, const h16_t* Qb, const h16_t* Kb, const h16_t* Vb, char* lds, Seam<(MODE == 0 ? 2 : 1)>& S_, const BlkCtx& bc, const EpiArgs& ea, int tid_in) {
    constexpr int NCOMP = MODE == 0 ? 2 : 1, QROWS = 256 / NCOMP;
    typedef Lay<NCOMP> L;
    int tid = tid_in; asm volatile("" : "+v"(tid));
    const int wid = __builtin_amdgcn_readfirstlane(tid >> 6), lane = tid & 63, r32 = lane & 31, hi = lane >> 5;
    const int comp = NCOMP == 2 ? (wid >> 2) : 0, wq = NCOMP == 2 ? (wid & 3) : wid;
    const int NT = (cur.P0 + QROWS) / KVBLK;
    const int qlo = cur.P0 + wq * QBLK, qm = qlo + r32 - 4 * hi;
    const char* Kc_lds = lds + L_K + comp * SHM;
    float* ws = (float*)(lds + L::WS) + wid * 128; float* li_l = ws; float* al_l = ws + 32;
    const float* lut = (const float*)(lds + L::LUT) + comp * 352;
    const float* cumS = (const float*)(lds + L::BIG);
    float m_reg = -1e30f, l_reg = 0; f32x16 o[4] = {};
    const int kswz0 = KSWZ(r32, hi * 16);
    const unsigned offk = dma_offk(wid, lane), offv = dma_offv(wid, lane), lds_base = (unsigned)(uintptr_t)lds;
    const int vb0 = (int)(uintptr_t)lds + v_rd_base(lane);
    const h16_t* Kh = Kb + cur.koff; const h16_t* Vh = Vb + cur.voff;
#define RESC(a) do { if (__any((a) < 1.f)) { if (hi == 0) al_l[r32] = (a); asm volatile("s_waitcnt lgkmcnt(0)" ::: "memory");              \
                     _Pragma("unroll") for (int d_ = 0; d_ < 4; ++d_) _Pragma("unroll") for (int r = 0; r < 16; ++r) o[d_][r] *= al_l[crow(r, hi)]; } } while (0)
#define KBASE(t) ((t) * KVBLK)
#define T_ABOVE(t) (KBASE(t) > qlo + QBLK - 1)
#define T_NEAR(t) (KBASE(t) + KVBLK - 1 >= qlo - 112)
#define MKINIT(i0, i1, t) do { const int kb_ = KBASE(t);                                                                                  \
        if (MODE == 2) { const float* cp_ = cumS + kb_ + 4 * hi; const float cq_ = cumS[qlo + r32];                                                                \
            _Pragma("unroll") for (int g_ = 0; g_ < 4; ++g_) { const f32x4 c0_ = *(const f32x4*)(cp_ + 8 * g_), c1_ = *(const f32x4*)(cp_ + 32 + 8 * g_); \
                _Pragma("unroll") for (int e_ = 0; e_ < 4; ++e_) { i0[4 * g_ + e_] = cq_ - c0_[e_]; i1[4 * g_ + e_] = cq_ - c1_[e_]; } } }          \
        else { float v_ = T_NEAR(t) ? 0.f : lut[328];                                                                               \
            if (MODE == 1) { const int blk_ = kb_ >> 8; if (blk_ != bc.own && !((bc.selbits >> blk_) & 1u)) v_ = -__builtin_inff(); } \
            _Pragma("unroll") for (int r = 0; r < 16; ++r) { i0[r] = v_; i1[r] = v_; } } } while (0)
#define MASKT(P0_, P1_, t) do { const int kb_ = KBASE(t);                                                                         \
        if (T_ABOVE(t)) { const float NEG_ = -__builtin_inff(); _Pragma("unroll") for (int r = 0; r < 16; ++r) { P0_[r] = NEG_; P1_[r] = NEG_; } } \
        else if (MODE == 2) { if (kb_ + KVBLK - 1 > qlo) mask_tile(P0_, P1_, qm - kb_); }                                          \
        else if (T_NEAR(t)) bias_mask_tile(P0_, P1_, qm - kb_, lut); } while (0)
    f32x16 pA0, pA1, pB0, pB1; float alA, alB, psA, psB; f16x8 pa0, pa1, pa2, pa3;
    dma_k<NCOMP>(Kh, KBASE(1), offk, lds_base, 1, wid); dma_v(Vh, KBASE(1), offv, lds_base, 1, wid);
    MKINIT(pA0, pA1, 0);
    SBAR(); qkt<0, NCOMP>(pA0, pA1, Kc_lds, kswz0, S_.qr);
    MASKT(pA0, pA1, 0); partialSM(pA0, pA1, m_reg, alA, psA, pa0, pa1);
    VMW();
    __syncthreads();
#define HALF_STEP(PX0, PX1, alX, psX, PY1, alY, psY, t, KB, VB, SB) do {                                                      \
        dma_k<NCOMP>(Kh, KBASE((t) + 1), offk, lds_base, SB, wid);                                                            \
        MKINIT(PX0, PX1, t);                                                                                                  \
        SBAR(); qkt<KB, NCOMP>(PX0, PX1, Kc_lds, kswz0, S_.qr);                                                               \
        finishSM(PY1, alY, psY, l_reg, pa2, pa3); SBAR();                                                                     \
        pv_tile<VB>(o, vb0, pa0, pa1, pa2, pa3); MASKT(PX0, PX1, (t)); partialSM(PX0, PX1, m_reg, alX, psX, pa0, pa1);        \
        __syncthreads();                                                                                                      \
        dma_v(Vh, KBASE((t) + 1), offv, lds_base, SB, wid);                                                                   \
        RESC(alX); VMWN(2); __syncthreads(); } while (0)
    for (int t = 1; t + 1 < NT; t += 2) {
        HALF_STEP(pB0, pB1, alB, psB, pA1, alA, psA, t, 1, 0, 0);
        HALF_STEP(pA0, pA1, alA, psA, pB1, alB, psB, t + 1, 0, 1, 1);
    }
    MKINIT(pB0, pB1, NT - 1);
    SBAR(); qkt<1, NCOMP>(pB0, pB1, Kc_lds, kswz0, S_.qr); SBAR();
    dma_k<NCOMP>(Kb + nxt.koff, 0, offk, lds_base, 0, wid);
    { const char* qb_ = (const char*)(Qb + nxt.qoff + comp * HSTR + (size_t)(wq * QBLK) * HD); const unsigned qo_ = (unsigned)(r32 * HD + hi * 8) * 2u;
#pragma unroll
        for (int d0 = 0; d0 < 8; ++d0) S_.qr[d0] = ldg8(qb_ + d0 * 32, qo_); }
    SBAR();
    finishSM(pA1, alA, psA, l_reg, pa2, pa3); SBAR();
    pv_tile<0>(o, vb0, pa0, pa1, pa2, pa3);
    MASKT(pB0, pB1, NT - 1); partialSM(pB0, pB1, m_reg, alB, psB, pa0, pa1);
    VMW();
    __syncthreads();
    dma_v(Vb + nxt.voff, 0, offv, lds_base, 0, wid);
    RESC(alB);
    finishSM(pB1, alB, psB, l_reg, pa2, pa3); SBAR(); pv_tile<1>(o, vb0, pa0, pa1, pa2, pa3);
    SBAR();
    epilogue_part<MODE>(cur, lds, o, l_reg, ea, tid_in);
    VMW();
    __syncthreads();
#undef RESC
#undef KBASE
#undef T_ABOVE
#undef T_NEAR
#undef MKINIT
#undef MASKT
#undef HALF_STEP
}

template <int MODE>
__device__ __forceinline__ BlockRef att_ref(int item, int j) {
    BlockRef r;
    if (MODE == 0) { const int bh = item >> 3, y = item & 7, x = (j < 2) ? y : 15 - y; r.b = bh >> 3; r.h = bh & 7; r.half = j & 1; r.x = x; r.P0 = x * 128;
        const unsigned hb = (unsigned)(r.b * NH + 2 * r.h) * (unsigned)HSTR; r.qoff = hb + (unsigned)r.P0 * HD; r.koff = hb; r.voff = hb + r.half * (unsigned)HSTR; }
    else { const int bh = item >> 2, y = item & 3, x = (j == 0) ? y : 7 - y; r.b = bh >> 4; r.h = bh & 15; r.half = 0; r.x = x; r.P0 = x * 256;
        const unsigned hb = (unsigned)(r.b * NH + r.h) * (unsigned)HSTR; r.qoff = hb + (unsigned)r.P0 * HD; r.koff = hb; r.voff = hb; }
    return r;
}
template <int MODE>
__device__ __forceinline__ void attn_phase(const Ctx& c, const AttnArgs& A) {
    constexpr int NCOMP = MODE == 0 ? 2 : 1, NBLK = MODE == 0 ? 4 : 2, NITEMS = 256;
    typedef Lay<NCOMP> L;
    char* lds = (char*)c.lds;
    const int tid = c.tid, wid = c.wave, lane = c.lane, r32 = lane & 31, hi = lane >> 5;
    const int comp = NCOMP == 2 ? (wid >> 2) : 0, wq = NCOMP == 2 ? (wid & 3) : wid;
    const int vcu = (c.G % 8 == 0) ? (c.bid % 8) * (c.G / 8) + c.bid / 8 : c.bid;
    float* misc = (float*)(lds + L::MISC); float* lutw = (float*)(lds + L::LUT); float* big = (float*)(lds + L::BIG);
    EpiArgs ea{A.Zb, A.G, A.subg, A.lam_init};
    if (MODE == 0) {
        if (tid < 64) { float a = A.lq1[tid] * A.lk1[tid] + A.lq1[tid + 64] * A.lk1[tid + 64], cc = A.lq2[tid] * A.lk2[tid] + A.lq2[tid + 64] * A.lk2[tid + 64];
            a = wave_sum(a); cc = wave_sum(cc); if (tid == 0) misc[0] = __expf(a) - __expf(cc) + A.lam_init; }
        __syncthreads();
    }
    Seam<NCOMP> S_;
    int item = vcu; if (item >= NITEMS) return;
    int j = 0; BlockRef cur = att_ref<MODE>(item, 0);
    att_prime<NCOMP>(cur, A.Qb, A.Kb, A.Vb, lds, S_, tid);
    bool new_item = true;
    for (;;) {
        if (new_item) {
            int tid = c.tid; asm volatile("" : "+v"(tid)); const int lane = tid & 63;
            if (MODE != 2) { for (int i = tid; i < NCOMP * 352; i += NTHREADS) { const int cc = i / 352, ii = i % 352, dist = ii - 128; const int hq = MODE == 0 ? 2 * cur.h + cc : cur.h;
                    lutw[i] = A.rel[t5_bucket(dist > 0 ? dist : 0) * 16 + hq] * (1.f / SCALE); } }
            if (MODE == 1) { for (int i = tid; i < 8 * 128; i += NTHREADS) { const float* k0 = A.kpart + (size_t)(cur.b * NH + cur.h) * 8 * HD + i; big[i] = (k0[0] + k0[(size_t)NB * NH * 8 * HD]) * (1.f / 256.f); } }
            if (MODE == 2) {
                float v[4];
#pragma unroll
                for (int e = 0; e < 4; ++e) v[e] = A.logf[(size_t)(cur.b * S + 4 * tid + e) * NH + cur.h];
                v[1] += v[0]; v[2] += v[1]; v[3] += v[2];
                float incl = v[3];
#pragma unroll
                for (int o = 1; o < 64; o <<= 1) { const float t = __int_as_float(__builtin_amdgcn_ds_bpermute(((lane - o) & 63) << 2, __float_as_int(incl))); if (lane >= o) incl += t; }
                if (lane == 63) misc[8 + wid] = incl;
                __syncthreads();
                float off = incl - v[3];
                for (int w = 0; w < wid; ++w) off += misc[8 + w];
                const f32x4 o4 = {(v[0] + off) * (1.f / SCALE), (v[1] + off) * (1.f / SCALE), (v[2] + off) * (1.f / SCALE), (v[3] + off) * (1.f / SCALE)};
                *(f32x4*)(big + 4 * tid) = o4;
            }
            __syncthreads();
            new_item = false;
        }
        BlkCtx bc; bc.selbits = 0u; bc.own = cur.x;
        if (MODE == 1) {
            float gate[8];
#pragma unroll
            for (int n = 0; n < 8; ++n) { float gs = 0.f;
                if (n < cur.x) {
#pragma unroll
                    for (int d0 = 0; d0 < 8; ++d0) { const float* kp = big + n * 128 + d0 * 16 + hi * 8; const f32x4 k0 = *(const f32x4*)kp, k1 = *(const f32x4*)(kp + 4); const f16x8 q = S_.qr[d0];
                        gs += (float)q[0] * k0[0] + (float)q[1] * k0[1] + (float)q[2] * k0[2] + (float)q[3] * k0[3] + (float)q[4] * k1[0] + (float)q[5] * k1[1] + (float)q[6] * k1[2] + (float)q[7] * k1[3]; }
                    gs = xadd32(gs); }
                gate[n] = n < cur.x ? gs : NEGF; SBAR(); }
            unsigned sb = 0u;
#pragma unroll
            for (int k = 0; k < 3; ++k) { int best = -1; float bv = 0.f;
#pragma unroll
                for (int n = 0; n < 8; ++n) if (!((sb >> n) & 1u) && (best < 0 || gate[n] > bv)) { best = n; bv = gate[n]; }
                sb |= 1u << best; }
            bc.selbits = sb & ((1u << cur.x) - 1u);
        }
        int itemn = item, jn = j + 1; bool last = false;
        if (jn == NBLK) { jn = 0; itemn = item + c.G; if (itemn >= NITEMS) { last = true; itemn = item; jn = j; } }
        const BlockRef nxt = att_ref<MODE>(itemn, jn);
        att_block<MODE>(cur, nxt, A.Qb, A.Kb, A.Vb, lds, S_, bc, ea, tid);
        if (last) break;
        new_item = itemn != item; cur = nxt; item = itemn; j = jn;
    }
    VMW();
}
#undef ROW
#undef VMW
#undef VMWN
#undef KSWZ
#undef SBAR
}

#define XB_TMO      128
#define XB_XCNT(j)  (256  + 64 * (j))
#define XB_XSUB(j)  (1280 + 64 * (j))
#define XB_XGEN(j)  (2304 + 64 * (j))
#define XB_TOP      3328
#define XB_TOPGEN   3392
#define XCD_BAR_WORDS 3456
#define XB_SPIN_CAP (1u << 18)
__device__ __forceinline__ unsigned xb_ld(unsigned* p)              { return __hip_atomic_load(p, __ATOMIC_RELAXED, __HIP_MEMORY_SCOPE_AGENT); }
__device__ __forceinline__ unsigned xb_add(unsigned* p, unsigned v) { return __hip_atomic_fetch_add(p, v, __ATOMIC_RELAXED, __HIP_MEMORY_SCOPE_AGENT); }
__device__ __forceinline__ unsigned xb_xcc_id() { return (unsigned)__builtin_amdgcn_s_getreg((3 << 11) | 20) & 0xFu; }
#define XB_SPIN(cond, bar) do { unsigned _sp = 0; while (cond) { __builtin_amdgcn_s_sleep(1); \
    if ((++_sp & 255u) == 0u) { if (xb_ld(&(bar)[XB_TMO])) break; if (_sp > XB_SPIN_CAP) { atomicAdd(&(bar)[XB_TMO], 1u); break; } } } } while (0)
struct XcdBarrier { unsigned* bar; unsigned x; volatile LAS unsigned* st; };
__device__ __forceinline__ void xcd_barrier_complete(unsigned* bar, unsigned x, unsigned& nloc, unsigned& nx) {
    const unsigned G = gridDim.x * gridDim.y * gridDim.z;
    unsigned sum, cnt, mine, sp = 0u;
    for (;;) {
        sum = 0u; cnt = 0u; mine = 0u;
#pragma unroll
        for (unsigned j = 0; j < 16; ++j) { const unsigned c = xb_ld(&bar[XB_XCNT(j)]); sum += c; cnt += (c > 0u) ? 1u : 0u; mine = (j == x) ? c : mine; }
        if (sum == G) break;
        __builtin_amdgcn_s_sleep(1);
        if ((++sp & 255u) == 0u) { if (xb_ld(&bar[XB_TMO])) break; if (sp > XB_SPIN_CAP) { atomicAdd(&bar[XB_TMO], 1u); break; } }
    }
    nloc = mine > 0u ? mine : 1u; nx = cnt > 0u ? cnt : 1u;
}
__device__ __forceinline__ void xcd_barrier(const XcdBarrier& b, bool leader_thread) {
    asm volatile("s_waitcnt vmcnt(0)" ::: "memory");
    __syncthreads();
    if (leader_thread) {
        unsigned* bar = b.bar;
        __builtin_amdgcn_s_waitcnt(0);
        unsigned nloc = b.st[0], nx = b.st[1];
        if (nloc == 0u) { xcd_barrier_complete(bar, b.x, nloc, nx); b.st[0] = nloc; b.st[1] = nx; }
        const unsigned old = xb_add(&bar[XB_XSUB(b.x)], 1u);
        const unsigned gen = old / nloc;
        if (old + 1u == (gen + 1u) * nloc) {
            __builtin_amdgcn_fence(__ATOMIC_RELEASE, "agent");
            asm volatile("s_waitcnt vmcnt(0)" ::: "memory");
            const unsigned og = xb_add(&bar[XB_TOP], 1u);
            const unsigned tg = og / nx;
            if (og + 1u == (tg + 1u) * nx) xb_add(&bar[XB_TOPGEN], 1u);
            else XB_SPIN(xb_ld(&bar[XB_TOPGEN]) == tg, bar);
            __builtin_amdgcn_fence(__ATOMIC_ACQUIRE, "agent");
            xb_add(&bar[XB_XGEN(b.x)], 1u);
            asm volatile("s_waitcnt vmcnt(0)" ::: "memory");
        } else {
            XB_SPIN(xb_ld(&bar[XB_XGEN(b.x)]) == gen, bar);
            __builtin_amdgcn_fence(__ATOMIC_ACQUIRE, "agent");
            asm volatile("s_waitcnt vmcnt(0)" ::: "memory");
        }
    }
    __syncthreads();
}

struct Args { const float* in[29]; float* out; unsigned char* ws; int ph_lo, ph_hi; };
static_assert(sizeof(Args) == 31 * 8 + 8, "Args has no padding");

__global__ void __launch_bounds__(NTHREADS, 2) mega_fwd(Args args) {
    extern __shared__ __attribute__((aligned(16))) unsigned char lds[];
#if USE_COOP
    cg::grid_group grid = cg::this_grid();
#endif
    const int wave_id = __builtin_amdgcn_readfirstlane(threadIdx.x >> 6);
    volatile LAS unsigned* xst = (volatile LAS unsigned*)((LAS unsigned char*)lds + XB_LDS_OFF);
    if (threadIdx.x < 4) xst[threadIdx.x] = 0u;
    __syncthreads();
    XcdBarrier xbar; xbar.bar = (unsigned*)(args.ws + WS_CTL) + 1024; xbar.x = xb_xcc_id(); xbar.st = xst;
    if (threadIdx.x == 0) (void)xb_add(&xbar.bar[XB_XCNT(xbar.x)], 1u);
#define W_X (args.in[0])
#define W_REL (args.in[1])
#define W_HB ((h16_t*)(ws + WS_HB))
#define W_Q ((h16_t*)(ws + WS_Q))
#define W_K ((h16_t*)(ws + WS_K))
#define W_V ((h16_t*)(ws + WS_V))
#define W_Z ((h16_t*)(ws + WS_Z))
#define W_G ((h16_t*)(ws + WS_G))
#define W_STATS ((float*)(ws + WS_STATS))
#define W_KPART ((float*)(ws + WS_KPART))
#define W_LOGF ((float*)(ws + WS_LOGF))
#define W_CUM ((float*)(ws + WS_CUM))
#define W_WF ((h16_t*)(ws + WS_WF))
#define W_T (args.out)
#define PHASE_BEGIN { Ctx c; c.lane = (int)__builtin_amdgcn_mbcnt_hi(~0u, __builtin_amdgcn_mbcnt_lo(~0u, 0u)); c.tid = wave_id * 64 + c.lane; asm volatile("" : "+v"(c.tid)); c.lane = c.tid & 63; c.wave = wave_id; c.G = gridDim.x; c.bid = blockIdx.x; c.lds = lds; __attribute__((address_space(1))) unsigned char* wsg_ = (__attribute__((address_space(1))) unsigned char*)args.ws; asm volatile("" : "+s"(wsg_)); unsigned char* ws = (unsigned char*)wsg_;
#if USE_COOP
#define PHASE_END(dosync_) if (dosync_) { if (USE_CG_SYNC) grid.sync(); else xcd_barrier(xbar, c.tid == 0); } }
#else
#define PHASE_END(dosync_) if (dosync_) { xcd_barrier(xbar, c.tid == 0); } }
#endif

    for (int rep_ = 0; rep_ < REP_P0; ++rep_) {
    PHASE_BEGIN
    {
        LAS float* scr = (LAS float*)((LAS unsigned char*)lds + c.wave * 16640);
        const int gw = c.bid * NWAVES + c.wave, NGW = c.G * NWAVES;
        constexpr int I_IN = (D / 64) * (NPROJ / 64), I_OUT = (E / 64) * (D / 64), I_F = D / 64, NITEMS = 4 * (I_IN + I_OUT) + I_F;
        for (int it = gw; it < NITEMS; it += NGW) {
            int r = it;
            if (r < 4 * I_IN) { const int l = r / I_IN; r -= l * I_IN; const int wi = l == 0 ? 2 : (l == 1 ? 11 : (l == 2 ? 15 : 20));
                p0_transpose_item(args.in[wi], (l == 2) ? NPROJ + 16 : NPROJ, 0, NPROJ, (h16_t*)(ws + WS_WIN + (size_t)l * 32 * MiB), scr, r, c.lane); continue; }
            r -= 4 * I_IN;
            if (r < 4 * I_OUT) { const int l = r / I_OUT; r -= l * I_OUT; const int wi = l == 0 ? 8 : (l == 1 ? 12 : (l == 2 ? 17 : 26));
                p0_transpose_item(args.in[wi], D, 0, D, (h16_t*)(ws + WS_WOUT + (size_t)l * 8 * MiB), scr, r, c.lane); continue; }
            r -= 4 * I_OUT;
            p0_transpose_item(args.in[15], NPROJ + 16, NPROJ, 16, W_WF, scr, r, c.lane);
        }
        cvt_phase(c, W_X, W_HB, (size_t)M * D);
    }
#if USE_COOP
    if (rep_ + 1 < REP_P0) { xcd_barrier(xbar, c.tid == 0); } else grid.sync(); } }
#else
    xcd_barrier(xbar, c.tid == 0); } }
#endif

#ifdef DBG_ONLY
    for (int l = DBG_LAYER; l <= DBG_LAYER; ++l) {
#else
#pragma unroll 1
    for (int l = 0; l < 4; ++l) {
#endif
        const int i_g[4] = {9, 13, 18, 27}, i_b[4] = {10, 14, 19, 28};
#define W_WIN ((const h16_t*)(ws + WS_WIN + (size_t)l * 32 * MiB))
#define W_WOUT ((const h16_t*)(ws + WS_WOUT + (size_t)l * 8 * MiB))
        for (int rep_ = 0; rep_ < REP_IN; ++rep_) {
        PHASE_BEGIN
        {
            if (l == 2) logf_phase(c, W_HB, W_WF, args.in[16], W_LOGF);
            pg8::Gemm g{W_HB, W_WIN, M, NPROJ, D}; pg8::StaticOrder So; So.init(M, NPROJ, c.G, c.bid);
            EpiQKVZ Ep{W_Q, W_K, W_V, W_Z, l == 1 ? W_KPART : nullptr};
            pg8::gemm_phase<EpiQKVZ, pg8::StaticOrder, IN_ALIGN, IN_SP2>((LAS unsigned char*)lds, g, So, Ep, c.tid);
        }
        PHASE_END(true)
        }
#ifdef DBG_LAYER
        if (l == DBG_LAYER) {
            h16_t* G2 = (h16_t*)args.out; unsigned* ctl = (unsigned*)args.ws;
            PHASE_BEGIN if (l == 2) cum_phase(c, W_LOGF, W_CUM); PHASE_END(true)
            for (int pass = 0; pass < 2; ++pass) {
            PHASE_BEGIN
            {
                AttnArgs A{W_Q, W_K, W_V, W_Z, pass ? G2 : W_G, W_REL, W_KPART, W_CUM, W_LOGF, nullptr, nullptr, nullptr, nullptr, nullptr, 0.f};
                if (l == 0 || l == 3) { const int base = (l == 0) ? 3 : 21; A.lq1 = args.in[base]; A.lk1 = args.in[base + 1]; A.lq2 = args.in[base + 2]; A.lk2 = args.in[base + 3]; A.subg = args.in[base + 4];
                    A.lam_init = (l == 0) ? 0.2f : (0.8f - 0.6f * 0.40656965974059917f);
                    if (pass) att::attn_phase<0>(c, A); else attn_naive_phase<0>(c, A); }
                else if (l == 1) { if (pass) att::attn_phase<1>(c, A); else attn_naive_phase<1>(c, A); }
                else { if (pass) att::attn_phase<2>(c, A); else attn_naive_phase<2>(c, A); }
            }
            PHASE_END(true)
            }
            PHASE_BEGIN
            {
                float best = 0.f; unsigned nbad = 0u;
                for (int sl = c.bid * NWAVES + c.wave; sl < M * 16; sl += c.G * NWAVES) {
                    const size_t idx = (size_t)(sl >> 4) * E + (sl & 15) * 128 + c.lane * 2;
                    const unsigned a = *(const unsigned*)(W_G + idx), b = *(const unsigned*)(G2 + idx);
                    float md = fmaxf(fabsf(lo16(a) - lo16(b)), fabsf(hi16(a) - hi16(b))), ma = fmaxf(fabsf(lo16(a)), fabsf(hi16(a)));
                    for (int o = 1; o < 64; o <<= 1) { md = fmaxf(md, __shfl_xor(md, o)); ma = fmaxf(ma, __shfl_xor(ma, o)); }
                    const float r = (md == md) ? md / fmaxf(ma, 1e-20f) : 1e9f;
                    best = fmaxf(best, r); nbad += (r > 0.05f) ? 1u : 0u;
                }
                if (c.lane == 0) { atomicMax(ctl + 0, __float_as_uint(best)); atomicAdd(ctl + 1, nbad); }
            }
            PHASE_END(true)
            PHASE_BEGIN
            for (size_t i = ((size_t)c.bid * NTHREADS + c.tid) * 4; i < (size_t)M * D; i += (size_t)c.G * NTHREADS * 4) *(f32x4*)(args.out + i) = (f32x4){0.f, 0.f, 0.f, 0.f};
            PHASE_END(true)
            if (blockIdx.x == 0 && threadIdx.x == 0) {
#if DBG_WHAT == 0
                args.out[0] = 1e6f * __uint_as_float(__hip_atomic_load(ctl + 0, __ATOMIC_RELAXED, __HIP_MEMORY_SCOPE_AGENT));
#else
                args.out[0] = 1e3f * (float)__hip_atomic_load(ctl + 1, __ATOMIC_RELAXED, __HIP_MEMORY_SCOPE_AGENT);
#endif
            }
            return;
        }
#endif
        if (!FAST2) {
        PHASE_BEGIN
        if (l == 2) cum_phase(c, W_LOGF, W_CUM);
        PHASE_END(l == 2)
        }
        for (int rep_ = 0; rep_ < ((REP_ATT_L < 0 || REP_ATT_L == l) ? REP_ATT : 1); ++rep_) {
        PHASE_BEGIN
        {
            AttnArgs A{W_Q, W_K, W_V, W_Z, W_G, W_REL, W_KPART, W_CUM, W_LOGF, nullptr, nullptr, nullptr, nullptr, nullptr, 0.f};
            if (l == 0 || l == 3) { const int base = (l == 0) ? 3 : 21; A.lq1 = args.in[base]; A.lk1 = args.in[base + 1]; A.lq2 = args.in[base + 2]; A.lk2 = args.in[base + 3]; A.subg = args.in[base + 4];
                A.lam_init = (l == 0) ? 0.2f : (0.8f - 0.6f * 0.40656965974059917f);
                if (FAST0) att::attn_phase<0>(c, A); else attn_naive_phase<0>(c, A); }
            else if (l == 1) { if (FAST1) att::attn_phase<1>(c, A); else attn_naive_phase<1>(c, A); }
            else { if (FAST2) att::attn_phase<2>(c, A); else attn_naive_phase<2>(c, A); }
        }
        PHASE_END(true)
        }
        PHASE_BEGIN
        {
            pg8::Gemm g{W_G, W_WOUT, M, D, E}; pg8::StaticOrder So; So.init(M, D, c.G, c.bid);
            EpiResid Ep{W_T, W_X, W_STATS, l ? args.in[i_g[l - 1]] : nullptr, l ? args.in[i_b[l - 1]] : nullptr, l};
            pg8::gemm_phase<EpiResid, pg8::StaticOrder, false, OUT_SP2>((LAS unsigned char*)lds, g, So, Ep, c.tid);
        }
        PHASE_END(true)
        for (int rep_ = 0; rep_ < (l == 3 ? 1 : REP_LN); ++rep_) {
        PHASE_BEGIN
        ln_phase(c, W_T, args.in[i_g[l]], args.in[i_b[l]], W_STATS, W_HB, l == 3);
        PHASE_END(true)
        }
    }
}

extern "C" void kernel_launch(void* const* d_in, const int* in_sizes, int n_in, void* d_out, int out_size, void* d_ws, size_t ws_size, hipStream_t stream) {
    static int grid = 0;
    if (grid == 0) {
        if (n_in != 29 || ws_size < WS_END || out_size != M * D) { fprintf(stderr, "kernel_launch: unexpected shapes n_in=%d ws=%zu out=%d\n", n_in, ws_size, out_size); grid = -1; return; }
        int dev = 0, cus = 0, per_cu = 0;
        (void)hipGetDevice(&dev); (void)hipDeviceGetAttribute(&cus, hipDeviceAttributeMultiprocessorCount, dev);
        if (hipFuncSetAttribute((const void*)mega_fwd, hipFuncAttributeMaxDynamicSharedMemorySize, LDS_BYTES) != hipSuccess) { fprintf(stderr, "kernel_launch: hipFuncSetAttribute failed\n"); grid = -1; return; }
        if (hipOccupancyMaxActiveBlocksPerMultiprocessor(&per_cu, (const void*)mega_fwd, NTHREADS, LDS_BYTES) != hipSuccess || per_cu < 1) { fprintf(stderr, "kernel_launch: occupancy query says %d\n", per_cu); per_cu = 1; }
        (void)hipGetLastError();
        grid = cus > 0 ? cus : 256;
    }
    if (grid < 0) return;
    (void)hipMemsetAsync(d_ws, 0, 32768, stream);
    Args a{};
    for (int i = 0; i < 29; ++i) a.in[i] = (const float*)d_in[i];
    a.out = (float*)d_out; a.ws = (unsigned char*)d_ws; a.ph_lo = 0; a.ph_hi = 1000;
    void* kargs[] = {&a};
#if USE_COOP
    hipError_t e = hipLaunchCooperativeKernel((const void*)mega_fwd, dim3(grid), dim3(NTHREADS), kargs, LDS_BYTES, stream);
    if (e != hipSuccess) fprintf(stderr, "kernel_launch: cooperative launch failed: %s (grid %d)\n", hipGetErrorString(e), grid);
#else
    (void)kargs;
    hipLaunchKernelGGL(mega_fwd, dim3(grid), dim3(NTHREADS), LDS_BYTES, stream, a);
    const hipError_t e = hipPeekAtLastError();
    if (e != hipSuccess) fprintf(stderr, "kernel_launch: launch failed: %s (grid %d)\n", hipGetErrorString(e), grid);
#endif
}
```
